# Optimizing an MI355X kernel written in HIP

```python
import math
import jax, jax.numpy as jnp
from jax import lax
import numpy as np

D_MODEL = 1024
BATCH = 4
SEQ = 4096
DEPTH = 4

GRID_W = 64
CTX_LEN = 256
N_MIXERS = 3
D_FF = 4 * D_MODEL
EPS = 1e-6
ROPE_THETA = 10000.0

MLA_HEADS = 8
MLA_NOPE = 128
MLA_ROPE = 64
MLA_V = 128
MLA_Q_LORA = 384
MLA_KV_LORA = 256
MLA_SCALE = 1.0 / math.sqrt(MLA_NOPE + MLA_ROPE)
Q_BLOCK = 128

S5_GROUP = 16
S5_GROUPS = D_MODEL // S5_GROUP
S5_STATE = 64
S5_DT_MIN = 1e-3
S5_DT_MAX = 1e-1

LRU_WIDTH = 5 * D_MODEL // 4
LRU_BLOCKS = 10
LRU_BW = LRU_WIDTH // LRU_BLOCKS
LRU_C = 8.0
CONV_W = 4
CONV_LEFT = 1

N_A = (DEPTH + 2) // 3
N_B = (DEPTH + 1) // 3
N_C = DEPTH // 3

kernel_name = 'hybrid_mla_s5_rglru_dit_block'


def rmsnorm(x, g):
    xf = x.astype(jnp.float32)
    inv = lax.rsqrt(jnp.mean(xf * xf, axis=-1, keepdims=True) + EPS)
    return (xf * inv * g.astype(jnp.float32)).astype(x.dtype)


def modulate(x, shift, scale):
    return x * (1 + scale) + shift


def sq_relu_mlp(h, w1, w2):
    return jnp.square(jax.nn.relu(h @ w1)) @ w2


def axial_rope_tables(n_tokens):
    rows = n_tokens // GRID_W
    row = jnp.repeat(jnp.arange(rows, dtype=jnp.float32), GRID_W)
    col = jnp.tile(jnp.arange(GRID_W, dtype=jnp.float32), rows)
    n_freq = MLA_ROPE // 4
    freqs = ROPE_THETA ** (-jnp.arange(n_freq, dtype=jnp.float32) / n_freq)
    ang_r = row[:, None] * freqs[None, :]
    ang_c = col[:, None] * freqs[None, :]
    ang = jnp.concatenate([ang_r, ang_r, ang_c, ang_c], axis=-1)
    return jnp.cos(ang), jnp.sin(ang)


def apply_axial_rope(x, cos, sin):
    x1, x2, x3, x4 = jnp.split(x, 4, axis=-1)
    rot = jnp.concatenate([-x2, x1, -x4, x3], axis=-1)
    return x * cos + rot * sin


def mla_queries(h, w_dq, g_q, w_uq, g_qk):
    bsz, n, _ = h.shape
    q = (rmsnorm(h @ w_dq, g_q) @ w_uq).reshape(bsz, n, MLA_HEADS, MLA_NOPE + MLA_ROPE)
    q_nope = rmsnorm(q[..., :MLA_NOPE], g_qk[0, :MLA_NOPE])
    q_rope = rmsnorm(q[..., MLA_NOPE:], g_qk[0, MLA_NOPE:])
    return q_nope, q_rope


def mla_keys(h, w_dkv, g_kv, w_ukv, g_qk):
    bsz, n, _ = h.shape
    kv = h @ w_dkv
    c_kv = rmsnorm(kv[..., :MLA_KV_LORA], g_kv)
    k_rope = rmsnorm(kv[..., MLA_KV_LORA:], g_qk[1, MLA_NOPE:])
    kvu = (c_kv @ w_ukv).reshape(bsz, n, MLA_HEADS, MLA_NOPE + MLA_V)
    k_nope = rmsnorm(kvu[..., :MLA_NOPE], g_qk[1, :MLA_NOPE])
    v = kvu[..., MLA_NOPE:]
    return k_nope, k_rope, v


def mla_attend(q_nope, q_rope, k_nope, k_rope, v):
    s = (jnp.einsum('bqhd,bkhd->bhqk', q_nope, k_nope)
         + jnp.einsum('bqhr,bkr->bhqk', q_rope, k_rope))
    p = jax.nn.softmax(s.astype(jnp.float32) * MLA_SCALE, axis=-1).astype(v.dtype)
    return jnp.einsum('bhqk,bkhd->bqhd', p, v)


def mla_mixer(h, hc, cos, sin, w_dq, g_q, w_uq, w_dkv, g_kv, w_ukv, g_qk, w_o, need_ctx):
    bsz, n_tok, _ = h.shape
    n_ctx = hc.shape[1]
    qn, qr = mla_queries(h, w_dq, g_q, w_uq, g_qk)
    qr = apply_axial_rope(qr, cos[:, None, :], sin[:, None, :])
    kn, kr, v = mla_keys(h, w_dkv, g_kv, w_ukv, g_qk)
    kr = apply_axial_rope(kr, cos, sin)
    ckn, ckr, cv = mla_keys(hc, w_dkv, g_kv, w_ukv, g_qk)
    kn_all = jnp.concatenate([ckn, kn], axis=1)
    kr_all = jnp.concatenate([ckr, kr], axis=1)
    v_all = jnp.concatenate([cv, v], axis=1)
    n_blk = n_tok // Q_BLOCK

    def to_blocks(t):
        return t.reshape((bsz, n_blk, Q_BLOCK) + t.shape[2:]).swapaxes(0, 1)

    o = lax.map(lambda qs: mla_attend(qs[0], qs[1], kn_all, kr_all, v_all),
                (to_blocks(qn), to_blocks(qr)))
    o = o.swapaxes(0, 1).reshape(bsz, n_tok, MLA_HEADS * MLA_V)
    y = o @ w_o
    yc = None
    if need_ctx:
        cqn, cqr = mla_queries(hc, w_dq, g_q, w_uq, g_qk)
        yc = mla_attend(cqn, cqr, ckn, ckr, cv).reshape(bsz, n_ctx, MLA_HEADS * MLA_V) @ w_o
    return y, yc


def _affine_combine(e1, e2):
    a1, b1 = e1
    a2, b2 = e2
    return a2 * a1, a2 * b1 + b2


def linear_scan(a, b, h0, reverse):
    if h0 is not None:
        edge = b.shape[1] - 1 if reverse else 0
        b = b.at[:, edge].add(a[:, edge] * h0)
    _, h = lax.associative_scan(_affine_combine, (a, b), axis=1, reverse=reverse)
    return h


def s5_discretize(a_re, a_im, log_dt, b_re, b_im):
    lam = lax.complex(a_re.astype(jnp.float32), a_im.astype(jnp.float32))
    dt = jnp.exp(log_dt.astype(jnp.float32))[:, None]
    a_bar = jnp.exp(lam * dt)
    b_mat = lax.complex(b_re.astype(jnp.float32), b_im.astype(jnp.float32))
    b_bar = ((a_bar - 1) / lam)[..., None] * b_mat
    return a_bar, b_bar


def s5_glu(y, w_glu, dtype):
    z = jax.nn.gelu(y).astype(dtype)
    zv, zg = jnp.split(z @ w_glu, 2, axis=-1)
    return zv * jax.nn.sigmoid(zg)


def s5_mixer(h, hc, a_re, a_im, log_dt, b_re, b_im, c_re, c_im, d, w_glu, need_ctx):
    bsz, n_tok, _ = h.shape
    n_ctx = hc.shape[1]
    hf = h.astype(jnp.float32)
    hcf = hc.astype(jnp.float32)
    dd = d.astype(jnp.float32)
    u = hf.reshape(bsz, n_tok, S5_GROUPS, S5_GROUP).astype(jnp.complex64)
    uc = hcf.reshape(bsz, n_ctx, S5_GROUPS, S5_GROUP).astype(jnp.complex64)
    y = hf * dd
    yc = hcf * dd if need_ctx else None
    for direction, reverse in enumerate((False, True)):
        a_bar, b_bar = s5_discretize(a_re[direction], a_im[direction], log_dt[direction],
                                     b_re[direction], b_im[direction])
        c_mat = lax.complex(c_re[direction].astype(jnp.float32), c_im[direction].astype(jnp.float32))
        sc = linear_scan(jnp.broadcast_to(a_bar, (1, n_ctx) + a_bar.shape),
                         jnp.einsum('blgi,gpi->blgp', uc, b_bar), None, reverse)
        s0 = sc[:, 0] if reverse else sc[:, -1]
        s = linear_scan(jnp.broadcast_to(a_bar, (1, n_tok) + a_bar.shape),
                        jnp.einsum('blgi,gpi->blgp', u, b_bar), s0, reverse)
        y = y + jnp.real(jnp.einsum('blgp,gip->blgi', s, c_mat)).reshape(bsz, n_tok, D_MODEL)
        if need_ctx:
            yc = yc + jnp.real(jnp.einsum('blgp,gip->blgi', sc, c_mat)).reshape(bsz, n_ctx, D_MODEL)
    out = s5_glu(y, w_glu, h.dtype)
    out_c = s5_glu(yc, w_glu, h.dtype) if need_ctx else None
    return out, out_c


def depthwise_conv(x, w, b):
    out = lax.conv_general_dilated(x, w[:, None, :], window_strides=(1,),
                                   padding=[(CONV_LEFT, CONV_W - 1 - CONV_LEFT)],
                                   dimension_numbers=('NWC', 'WIO', 'NWC'),
                                   feature_group_count=x.shape[-1])
    return out + b


def rglru_coeffs(x, w_gate, b_gate, lam):
    bsz, n, _ = x.shape
    xf = x.astype(jnp.float32)
    xb = xf.reshape(bsz, n, LRU_BLOCKS, LRU_BW)
    gates = jnp.einsum('blnj,gnjk->gblnk', xb, w_gate.astype(jnp.float32)).reshape(2, bsz, n, LRU_WIDTH)
    gates = gates + b_gate.astype(jnp.float32)[:, None, None, :]
    r = jax.nn.sigmoid(gates[0])
    i_gate = jax.nn.sigmoid(gates[1])
    log_a = -LRU_C * r * jax.nn.softplus(-lam.astype(jnp.float32))
    a = jnp.exp(log_a)
    b = jnp.sqrt(-jnp.expm1(2.0 * log_a)) * (i_gate * xf)
    return a, b


def lru_mixer(h, hc, w_in, conv_w, conv_b, w_gate, b_gate, lam, w_out, need_ctx):
    w_g, w_x = w_in[:, :LRU_WIDTH], w_in[:, LRU_WIDTH:]
    xr = depthwise_conv(h @ w_x, conv_w, conv_b)
    xrc = depthwise_conv(hc @ w_x, conv_w, conv_b)
    hs = None
    hsc = None
    for direction, reverse in enumerate((False, True)):
        ac, bc = rglru_coeffs(xrc, w_gate[direction], b_gate[direction], lam[direction])
        sc = linear_scan(ac, bc, None, reverse)
        s0 = sc[:, 0] if reverse else sc[:, -1]
        a, b = rglru_coeffs(xr, w_gate[direction], b_gate[direction], lam[direction])
        s = linear_scan(a, b, s0, reverse)
        hs = s if hs is None else hs + s
        hsc = sc if hsc is None else hsc + sc
    y = (jax.nn.gelu(h @ w_g) * hs.astype(h.dtype)) @ w_out
    yc = (jax.nn.gelu(hc @ w_g) * hsc.astype(hc.dtype)) @ w_out if need_ctx else None
    return y, yc


def setup_inputs(seed: int = 0) -> dict:
    key = jax.random.key(seed)
    keys = iter(jax.random.split(key, 48))
    f32 = jnp.float32
    D = D_MODEL

    def nrm(shape, scale=1.0):
        return jax.random.normal(next(keys), shape, f32) * scale

    def gain(shape):
        return 1.0 + nrm(shape, 0.02)

    n_idx = jnp.arange(S5_STATE, dtype=f32)
    lru_u = jax.random.uniform(next(keys), (N_C, 2, LRU_WIDTH), f32, 0.9, 0.999)
    lru_a = lru_u ** (1.0 / LRU_C)
    return {
        'x': nrm((BATCH, SEQ, D)),
        'c': nrm((BATCH, D)),
        'ctx': nrm((BATCH, CTX_LEN, D)),
        'c_ctx': nrm((D,)),
        'ada_w': nrm((DEPTH, D, 6 * D), 0.5 * D ** -0.5),
        'ada_b': nrm((DEPTH, 6 * D), 0.01),
        'norm_g': gain((DEPTH, 2, D)),
        'mla_w_dq': nrm((N_A, D, MLA_Q_LORA), D ** -0.5),
        'mla_g_q': gain((N_A, MLA_Q_LORA)),
        'mla_w_uq': nrm((N_A, MLA_Q_LORA, MLA_HEADS * (MLA_NOPE + MLA_ROPE)), MLA_Q_LORA ** -0.5),
        'mla_w_dkv': nrm((N_A, D, MLA_KV_LORA + MLA_ROPE), D ** -0.5),
        'mla_g_kv': gain((N_A, MLA_KV_LORA)),
        'mla_w_ukv': nrm((N_A, MLA_KV_LORA, MLA_HEADS * (MLA_NOPE + MLA_V)), MLA_KV_LORA ** -0.5),
        'mla_g_qk': gain((N_A, 2, MLA_NOPE + MLA_ROPE)),
        'mla_w_o': nrm((N_A, MLA_HEADS * MLA_V, D), (MLA_HEADS * MLA_V) ** -0.5),
        's5_a_re': -0.5 + nrm((N_B, 2, S5_GROUPS, S5_STATE), 0.01),
        's5_a_im': math.pi * n_idx + nrm((N_B, 2, S5_GROUPS, S5_STATE), 0.01),
        's5_log_dt': jax.random.uniform(next(keys), (N_B, 2, S5_GROUPS), f32,
                                        math.log(S5_DT_MIN), math.log(S5_DT_MAX)),
        's5_b_re': nrm((N_B, 2, S5_GROUPS, S5_STATE, S5_GROUP), (2 * S5_GROUP) ** -0.5),
        's5_b_im': nrm((N_B, 2, S5_GROUPS, S5_STATE, S5_GROUP), (2 * S5_GROUP) ** -0.5),
        's5_c_re': nrm((N_B, 2, S5_GROUPS, S5_GROUP, S5_STATE), S5_STATE ** -0.5),
        's5_c_im': nrm((N_B, 2, S5_GROUPS, S5_GROUP, S5_STATE), S5_STATE ** -0.5),
        's5_d': nrm((N_B, D)),
        's5_w_glu': nrm((N_B, D, 2 * D), D ** -0.5),
        'lru_w_in': nrm((N_C, D, 2 * LRU_WIDTH), D ** -0.5),
        'lru_conv_w': nrm((N_C, CONV_W, LRU_WIDTH), CONV_W ** -0.5),
        'lru_conv_b': nrm((N_C, LRU_WIDTH), 0.01),
        'lru_w_gate': nrm((N_C, 2, 2, LRU_BLOCKS, LRU_BW, LRU_BW), LRU_BW ** -0.5),
        'lru_b_gate': nrm((N_C, 2, 2, LRU_WIDTH), 0.01),
        'lru_lambda': jnp.log(lru_a) - jnp.log1p(-lru_a),
        'lru_w_out': nrm((N_C, LRU_WIDTH, D), LRU_WIDTH ** -0.5),
        'mlp_w1': nrm((DEPTH, D, D_FF), D ** -0.5),
        'mlp_w2': nrm((DEPTH, D_FF, D), D_FF ** -0.5),
    }


def reference(x, c, ctx, c_ctx, ada_w, ada_b, norm_g,
              mla_w_dq, mla_g_q, mla_w_uq, mla_w_dkv, mla_g_kv, mla_w_ukv, mla_g_qk, mla_w_o,
              s5_a_re, s5_a_im, s5_log_dt, s5_b_re, s5_b_im, s5_c_re, s5_c_im, s5_d, s5_w_glu,
              lru_w_in, lru_conv_w, lru_conv_b, lru_w_gate, lru_b_gate, lru_lambda, lru_w_out,
              mlp_w1, mlp_w2):
    n_tok = x.shape[1]
    cos, sin = axial_rope_tables(n_tok)
    cos = cos.astype(x.dtype)
    sin = sin.astype(x.dtype)
    s_c = jax.nn.silu(c)
    s_cc = jax.nn.silu(c_ctx)
    lat, cx = x, ctx
    for i in range(DEPTH):
        need_ctx = i < DEPTH - 1
        mod = (s_c @ ada_w[i] + ada_b[i])[:, None, :]
        mod_c = (s_cc @ ada_w[i] + ada_b[i])[None, None, :]
        sh_a, sc_a, g_a, sh_m, sc_m, g_m = jnp.split(mod, 6, axis=-1)
        csh_a, csc_a, cg_a, csh_m, csc_m, cg_m = jnp.split(mod_c, 6, axis=-1)
        h = modulate(rmsnorm(lat, norm_g[i, 0]), sh_a, sc_a)
        hc = modulate(rmsnorm(cx, norm_g[i, 0]), csh_a, csc_a)
        kind, j = i % N_MIXERS, i // N_MIXERS
        if kind == 0:
            y, yc = mla_mixer(h, hc, cos, sin, mla_w_dq[j], mla_g_q[j], mla_w_uq[j], mla_w_dkv[j],
                              mla_g_kv[j], mla_w_ukv[j], mla_g_qk[j], mla_w_o[j], need_ctx)
        elif kind == 1:
            y, yc = s5_mixer(h, hc, s5_a_re[j], s5_a_im[j], s5_log_dt[j], s5_b_re[j], s5_b_im[j],
                             s5_c_re[j], s5_c_im[j], s5_d[j], s5_w_glu[j], need_ctx)
        else:
            y, yc = lru_mixer(h, hc, lru_w_in[j], lru_conv_w[j], lru_conv_b[j], lru_w_gate[j],
                              lru_b_gate[j], lru_lambda[j], lru_w_out[j], need_ctx)
        lat = lat + g_a * y
        lat = lat + g_m * sq_relu_mlp(modulate(rmsnorm(lat, norm_g[i, 1]), sh_m, sc_m), mlp_w1[i], mlp_w2[i])
        if need_ctx:
            cx = cx + cg_a * yc
            cx = cx + cg_m * sq_relu_mlp(modulate(rmsnorm(cx, norm_g[i, 1]), csh_m, csc_m),
                                         mlp_w1[i], mlp_w2[i])
    return lat
```

```cpp
#include <hip/hip_runtime.h>
#include <hip/hip_cooperative_groups.h>
#include <cstdio>
#include <cstdint>
namespace cg = cooperative_groups;

#ifndef NAIVE_GEMM
#define NAIVE_GEMM 0
#endif

#define DI __device__ __forceinline__
#define LAS __attribute__((address_space(3)))
typedef unsigned short bf16_t;
typedef short bf16x8 __attribute__((ext_vector_type(8)));
typedef short s16x4 __attribute__((ext_vector_type(4)));
typedef float f32x4 __attribute__((ext_vector_type(4)));
typedef float f32x2 __attribute__((ext_vector_type(2)));
typedef float f32x16 __attribute__((ext_vector_type(16)));
typedef unsigned u32x4 __attribute__((ext_vector_type(4)));
typedef unsigned u32x2 __attribute__((ext_vector_type(2)));

constexpr int DM = 1024, NB = 4, SEQ = 4096, CTXL = 256, RPB = SEQ + CTXL  , MROWS = NB * RPB  ;
constexpr int NTHREADS = 512, NWAVES = 8;
constexpr int LRUW = 1280;
constexpr float EPS = 1e-6f;
constexpr float QSCALE = 0.07216878364870323f * 1.4426950408889634f;

constexpr size_t MiB = 1u << 20;
constexpr size_t WS_MOD = 1 * MiB;
constexpr size_t WS_ROPE = 1 * MiB + 512 * 1024;
constexpr size_t WS_S5C = 2 * MiB;
constexpr size_t WS_CTXLAT = 4 * MiB;
constexpr size_t WS_WMIX = 8 * MiB;
constexpr size_t WS_WMLP = 19 * MiB;
constexpr size_t WS_H = 35 * MiB;
constexpr size_t WS_T = 69 * MiB;
constexpr size_t WS_END = WS_T + 270 * MiB;
constexpr size_t T_DQKV = 0, T_CQ = 51 * MiB, T_CKV = 64 * MiB, T_KR = 73 * MiB, T_QPRE = 76 * MiB, T_KVPRE = 127 * MiB;
constexpr size_t T_Z = 0, T_S5E = 40 * MiB, T_S5S = 50 * MiB;
constexpr size_t T_GX = 0  , T_LA = 43 * MiB  , T_BB = 129 * MiB, T_XPRE = 43 * MiB  ,
                 T_XR = 215 * MiB, T_GH = 215 * MiB  , T_LP = 258 * MiB, T_LE = 261 * MiB, T_LS = 264 * MiB;
constexpr size_t LRU_DIRSTRIDE = 43 * MiB;
constexpr size_t T_HID = 0;
constexpr size_t T_SLAB_M = 140 * MiB  , T_SLAB_A = 200 * MiB  , T_SLAB_A_LRU = 172 * MiB  ;
constexpr size_t WM_D = 0  , WM_UQ = 1572864  , WM_UKV = WM_UQ + 1179648  , WM_O = WM_UKV + 1048576  ;
constexpr size_t WM_GLU = 0;
constexpr size_t WM_X = 0  , WM_G = 2621440, WM_GATE = 2 * 2621440  , WM_OUT = 3 * 2621440  ;

struct KArgs {
    const float* in[33];
    float* out;
    unsigned char* ws;
};
constexpr int PTAB_OFF = 163072;
struct Params {
    float* out;
    unsigned char* ws;
    const LAS unsigned long long* tab;
};
__device__ __forceinline__ const float* IN(const Params& p, int k) {
    const unsigned long long v = p.tab[k];
    const unsigned lo = __builtin_amdgcn_readfirstlane((unsigned)v), hi = __builtin_amdgcn_readfirstlane((unsigned)(v >> 32));
    return (const float*)(const __attribute__((address_space(1))) float*)(((unsigned long long)hi << 32) | lo);
}

DI float ZF() { float z; asm volatile("v_mov_b32 %0, 0" : "=v"(z)); return z; }
DI int TIDX() { int t = threadIdx.x; asm volatile("" : "+v"(t)); return t; }
DI int BIDX() { int t = blockIdx.x; asm volatile("" : "+s"(t)); return t; }
DI int GDIM() { int t = gridDim.x; asm volatile("" : "+s"(t)); return t; }
typedef __bf16 bf16x2_t __attribute__((ext_vector_type(2)));
DI unsigned pk2(float lo, float hi) { f32x2 v = {lo, hi}; bf16x2_t b = __builtin_convertvector(v, bf16x2_t); return __builtin_bit_cast(unsigned, b); }
DI unsigned f2bf(float f) { return pk2(f, 0.f) & 0xffffu; }
DI float bflo(unsigned w) { return __uint_as_float(w << 16); }
DI float bfhi(unsigned w) { return __uint_as_float(w & 0xffff0000u); }
DI float bf2f(bf16_t h) { return __uint_as_float((unsigned)h << 16); }
DI float wave_sum(float v) {
#pragma unroll
    for (int o = 32; o; o >>= 1) v += __shfl_xor(v, o);
    return v;
}
DI float sigmoidf_(float x) { return __builtin_amdgcn_rcpf(1.f + __builtin_amdgcn_exp2f(-1.4426950408889634f * x)); }
DI float gelu_tanh(float x) {
    const float t = fmaf(x * x, 0.10294324f, 2.3022082f); return x * __builtin_amdgcn_rcpf(1.f + __builtin_amdgcn_exp2f(-x * t));
}
#define LDS_FENCE() asm volatile("s_waitcnt lgkmcnt(0)" ::: "memory")

DI float* lat_row(const Params& p, int row) {
    const int b = row / RPB, rb = row - b * RPB;
    return rb < CTXL ? (float*)(p.ws + WS_CTXLAT) + (size_t)(b * CTXL + rb) * DM : p.out + (size_t)(b * SEQ + rb - CTXL) * DM;
}

DI void mod_phase(const Params& p, char* lds, int ml, int rank, int nr) {
    float* sv = (float*)lds;
    float* red = (float*)(lds + 20480);
    const int tid = TIDX();
    __syncthreads();
    for (int i = tid; i < 5 * 1024; i += NTHREADS) { const int mi = i >> 10, k = i & 1023; const float x = mi < 4 ? IN(p, 1)[mi * 1024 + k] : IN(p, 3)[k]; sv[i] = x / (1.f + __expf(-x)); }
    __syncthreads();
    float* modv = (float*)(p.ws + WS_MOD);
    for (int grp = rank; grp < 256; grp += nr) {
        const int ks = tid / 6, cq = tid - ks * 6;
        if (ks < 64) {
            const float* w = IN(p, 4) + (size_t)ml * 1024 * 6144 + (size_t)(ks * 16) * 6144 + grp * 24 + cq * 4;
            f32x4 a0 = {0, 0, 0, 0}, a1 = a0, a2 = a0, a3 = a0, a4 = a0;
            f32x4 wv[16];
#pragma unroll
            for (int u = 0; u < 16; ++u) wv[u] = *(const f32x4*)(w + (size_t)u * 6144);
#pragma unroll
            for (int u = 0; u < 16; ++u) { const int k = ks * 16 + u; a0 += sv[k] * wv[u]; a1 += sv[1024 + k] * wv[u]; a2 += sv[2048 + k] * wv[u]; a3 += sv[3072 + k] * wv[u]; a4 += sv[4096 + k] * wv[u]; }
            f32x4* r = (f32x4*)red + (ks * 6 + cq) * 5;
            r[0] = a0; r[1] = a1; r[2] = a2; r[3] = a3; r[4] = a4;
        }
        __syncthreads();
        if (tid < 480) {
            const int o = tid >> 4, part = tid & 15, q = o / 5, mi = o - q * 5;
            f32x4 s = {0, 0, 0, 0};
#pragma unroll
            for (int k2 = 0; k2 < 4; ++k2) s += ((const f32x4*)red)[((part * 4 + k2) * 6 + q) * 5 + mi];
#pragma unroll
            for (int d = 1; d < 16; d <<= 1) { s[0] += __shfl_xor(s[0], d); s[1] += __shfl_xor(s[1], d); s[2] += __shfl_xor(s[2], d); s[3] += __shfl_xor(s[3], d); }
            if (part == 0) { const int cc = grp * 24 + q * 4; *(f32x4*)(modv + (size_t)(mi * 4 + ml) * 6144 + cc) = s + *(const f32x4*)(IN(p, 5) + ml * 6144 + cc); }
        }
        __syncthreads();
    }
}

struct PrepCtx { char* ldsw; int gw, nw, lane, tcount; };
DI void prep_T(PrepCtx& c, const float* src, int lds_, int K, int N, bf16_t* dst, int ldd, int zero_delta = 0, int hi_stride = 32, const float* kscale = nullptr) {
    const int ntn = N / 64, nt = (K / 64) * ntn;
    unsigned* T = (unsigned*)c.ldsw;
    const int lane = c.lane, c4 = (lane & 15) * 4, r = lane >> 4, rr = lane >> 3, kc = lane & 7;
    int first = (c.gw - c.tcount) % c.nw; if (first < 0) first += c.nw;
    for (int t = first; t < nt; t += c.nw) {
        const int kt = t / ntn, nn = t - kt * ntn;
        const float* s = src + (size_t)(kt * 64 + 2 * r) * lds_ + nn * 64 + c4;
        f32x4 v0[8], v1[8];
#pragma unroll
        for (int i = 0; i < 8; ++i) { v0[i] = *(const f32x4*)(s + (size_t)(8 * i) * lds_); v1[i] = *(const f32x4*)(s + (size_t)(8 * i + 1) * lds_); }
        if (kscale) {
#pragma unroll
            for (int i = 0; i < 8; ++i) { v0[i] = v0[i] * kscale[kt * 64 + 2 * r + 8 * i]; v1[i] = v1[i] * kscale[kt * 64 + 2 * r + 8 * i + 1]; }
        }
        LDS_FENCE();
#pragma unroll
        for (int i = 0; i < 8; ++i)
#pragma unroll
            for (int e = 0; e < 4; ++e) T[(c4 + e) * 33 + 4 * i + r] = pk2(v0[i][e], v1[i][e]);
        LDS_FENCE();
#pragma unroll
        for (int i = 0; i < 8; ++i) {
            const unsigned* Tr = T + (8 * i + rr) * 33 + 4 * kc;
            const u32x4 w = {Tr[0], Tr[1], Tr[2], Tr[3]};
            const int nrow = 8 * i + rr;
            bf16_t* d = dst + (size_t)(nn * 64 + (nrow >> 5) * hi_stride + (nrow & 31)) * ldd + kt * 64 + 8 * kc;
            *(u32x4*)d = w;
            if (zero_delta) { const unsigned z = __float_as_uint(ZF()); *(u32x4*)(d + zero_delta) = (u32x4){z, z, z, z}; }
        }
    }
    c.tcount += nt;
}
DI void prep_zero_rows(bf16_t* dst, size_t nelem, int first_block = 0) {
    const size_t n8 = nelem / 8; const unsigned z0 = __float_as_uint(ZF()); const u32x4 z = {z0, z0, z0, z0};
    for (size_t i = (size_t)(BIDX() - first_block) * NTHREADS + TIDX(); i < n8; i += (size_t)(GDIM() - first_block) * NTHREADS) ((u32x4*)dst)[i] = z;
}
DI PrepCtx prep_ctx(char* lds, int first_block = 0) {
    PrepCtx c; const int wave = TIDX() >> 6; c.lane = TIDX() & 63; c.ldsw = lds + wave * 8448; c.gw = (BIDX() - first_block) * NWAVES + wave; c.nw = (GDIM() - first_block) * NWAVES; c.tcount = 0; return c;
}
DI void prep_mixer(const Params& p, int layer, char* lds, int first_block = 0) {
    PrepCtx c = prep_ctx(lds, first_block);
    unsigned char* wm = p.ws + WS_WMIX;
    const int kind = layer % 3, j = layer / 3;
    if (kind == 0) {
        bf16_t* Wd = (bf16_t*)(wm + WM_D);
        prep_T(c, IN(p, 7) + (size_t)j * 1024 * 384, 384, 1024, 384, Wd, 1024);
        prep_T(c, IN(p, 10) + (size_t)j * 1024 * 320, 320, 1024, 256, Wd + (size_t)512 * 1024, 1024);
        prep_T(c, IN(p, 10) + (size_t)j * 1024 * 320 + 256, 320, 1024, 64, Wd + (size_t)384 * 1024, 1024);
        prep_zero_rows(Wd + (size_t)448 * 1024, 64 * 1024, first_block);
        for (int hh = 0; hh < 8; ++hh) {
            const float* wsrc = IN(p, 9) + (size_t)j * 384 * 1536 + hh * 192;
            prep_T(c, wsrc, 1536, 384, 128, (bf16_t*)(wm + WM_UQ) + (size_t)(256 * (hh >> 1) + 128 * (hh & 1)) * 384, 384, 0, 32, IN(p, 8) + j * 384);
            prep_T(c, wsrc + 128, 1536, 384, 64, (bf16_t*)(wm + WM_UQ) + (size_t)(256 * (4 + (hh >> 2)) + 32 * (hh & 3)) * 384, 384, 0, 128, IN(p, 8) + j * 384);
        }
        prep_T(c, IN(p, 12) + (size_t)j * 256 * 2048, 2048, 256, 2048, (bf16_t*)(wm + WM_UKV), 256);
        prep_T(c, IN(p, 14) + (size_t)j * 1024 * 1024, 1024, 1024, 1024, (bf16_t*)(wm + WM_O), 1024);
    } else if (kind == 1) {
        bf16_t* Wg = (bf16_t*)(wm + WM_GLU);
        for (int pn = 0; pn < 8; ++pn)
            for (int bj = 0; bj < 2; ++bj)
                prep_T(c, IN(p, 23) + (size_t)j * 1024 * 2048 + bj * 1024 + 128 * pn, 2048, 1024, 128, Wg + (size_t)(256 * pn + 128 * bj) * 1024, 1024);
    } else {
        const float* win = IN(p, 24) + (size_t)j * 1024 * 2560;
        prep_T(c, win + 1280, 2560, 1024, 1280, (bf16_t*)(wm + WM_X), 1024);
        prep_T(c, win, 2560, 1024, 1280, (bf16_t*)(wm + WM_G), 1024);
        bf16_t* Wt = (bf16_t*)(wm + WM_GATE);
        const float* wg = IN(p, 27) + (size_t)j * 2 * 2 * 10 * 128 * 128;
        for (int pr = 0; pr < 5; ++pr)
            for (int bip = 0; bip < 2; ++bip)
                for (int dir = 0; dir < 2; ++dir)
                    for (int gate = 0; gate < 2; ++gate)
                        prep_T(c, wg + (size_t)(((dir * 2 + gate) * 10) + 2 * pr + bip) * 128 * 128, 128, 128, 128,
                               Wt + (size_t)(1024 * pr + ((bip * 2 + dir) * 2 + gate) * 128) * 256 + 128 * bip, 256, bip ? -128 : 128);
        prep_T(c, IN(p, 30) + (size_t)j * 1280 * 1024, 1024, 1280, 1024, (bf16_t*)(wm + WM_OUT), 1280);
    }
}
constexpr size_t T_WMLP1 = 250 * MiB;
DI bf16_t* mlp_wbuf(const Params& p, int layer) { return (bf16_t*)((layer & 1) ? p.ws + WS_T + T_WMLP1 : p.ws + WS_WMLP); }
DI void prep_mlp(const Params& p, int layer, char* lds, int first_block = 0) {
    PrepCtx c = prep_ctx(lds, first_block);
    bf16_t* W1 = mlp_wbuf(p, layer); bf16_t* W2 = W1 + (size_t)4096 * 1024;
    prep_T(c, IN(p, 31) + (size_t)layer * 1024 * 4096, 4096, 1024, 4096, W1, 1024);
    prep_T(c, IN(p, 32) + (size_t)layer * 4096 * 1024, 1024, 4096, 1024, W2, 4096);
}

DI void norm_phase(const Params& p, int layer, int which, bool first, bool latonly, int nslab, const float* slab, const float* sgate, bool glu) {
    const int lane = TIDX() & 63, gw = BIDX() * NWAVES + (TIDX() >> 6), nw = GDIM() * NWAVES;
    const float* modv = (const float*)(p.ws + WS_MOD);
    const float* g = IN(p, 6) + (size_t)(layer * 2 + which) * 1024;
    bf16_t* h = (bf16_t*)(p.ws + WS_H);
    for (int qd = gw; qd < NB * SEQ / 4; qd += nw) {
        const int b = qd / (SEQ / 4), t0 = (qd - b * (SEQ / 4)) * 4;
        float* lp = p.out + (size_t)(b * SEQ + t0) * DM;
        const float* src = first ? IN(p, 0) + (size_t)(b * SEQ + t0) * DM : lp;
        const float* md = modv + (size_t)(b * 4 + layer) * 6144 + which * 3072;
        f32x4 v[4][4]; float ss[4];
#pragma unroll
        for (int r = 0; r < 4; ++r)
#pragma unroll
            for (int j = 0; j < 4; ++j) v[r][j] = *(const f32x4*)(src + (size_t)r * DM + j * 256 + lane * 4);
        f32x4 mul[4], sh[4];
#pragma unroll
        for (int j = 0; j < 4; ++j) { const int col = j * 256 + lane * 4; mul[j] = *(const f32x4*)(g + col) * (1.f + *(const f32x4*)(md + 1024 + col)); sh[j] = *(const f32x4*)(md + col); }
#pragma unroll
        for (int r = 0; r < 4; ++r) { float a = 0.f;
#pragma unroll
            for (int j = 0; j < 4; ++j) a += v[r][j][0] * v[r][j][0] + v[r][j][1] * v[r][j][1] + v[r][j][2] * v[r][j][2] + v[r][j][3] * v[r][j][3];
            ss[r] = a; }
#pragma unroll
        for (int o = 32; o; o >>= 1) {
#pragma unroll
            for (int r = 0; r < 4; ++r) ss[r] += __shfl_xor(ss[r], o);
        }
        const size_t hrow = (size_t)(b * RPB + CTXL + t0);
#pragma unroll
        for (int r = 0; r < 4; ++r) {
            const float inv = rsqrtf(ss[r] * (1.f / 1024.f) + EPS);
#pragma unroll
            for (int j = 0; j < 4; ++j) {
                const int col = j * 256 + lane * 4;
                const f32x4 o = v[r][j] * inv * mul[j] + sh[j];
                u32x2 w = {pk2(o[0], o[1]), pk2(o[2], o[3])};
                *(u32x2*)(h + (hrow + r) * DM + col) = w;
            }
        }
    }
    if (latonly) return;
    const float* md = modv + (size_t)(4 * 4 + layer) * 6144 + which * 3072;
    for (int cr = gw; cr < NB * CTXL; cr += nw) {
        const int b = cr / CTXL, rb = cr - b * CTXL;
        float* lp = (float*)(p.ws + WS_CTXLAT) + (size_t)cr * DM;
        const float* src = first ? IN(p, 2) + (size_t)cr * DM : lp;
        f32x4 v[4]; float ss = 0.f;
#pragma unroll
        for (int j = 0; j < 4; ++j) v[j] = *(const f32x4*)(src + j * 256 + lane * 4);
        if (nslab) {
#pragma unroll
            for (int j = 0; j < 4; ++j) {
                const int col = j * 256 + lane * 4; f32x4 a = {0.f, 0.f, 0.f, 0.f};
                if (glu) {
                    const float* sp = slab + (size_t)cr * 2048 + (col >> 7) * 256 + (col & 127); f32x4 gz = {0.f, 0.f, 0.f, 0.f};
                    for (int ks = 0; ks < nslab; ++ks) { a += *(const f32x4*)(sp + (size_t)ks * 1024 * 2048); gz += *(const f32x4*)(sp + (size_t)ks * 1024 * 2048 + 128); }
#pragma unroll
                    for (int e = 0; e < 4; ++e) a[e] *= sigmoidf_(gz[e]);
                } else {
                    const float* sp = slab + (size_t)cr * 1024 + col;
                    for (int ks = 0; ks < nslab; ++ks) a += *(const f32x4*)(sp + (size_t)ks * 1024 * 1024);
                }
                v[j] += *(const f32x4*)(sgate + col) * a;
                *(f32x4*)(lp + col) = v[j];
            }
        }
#pragma unroll
        for (int j = 0; j < 4; ++j) ss += v[j][0] * v[j][0] + v[j][1] * v[j][1] + v[j][2] * v[j][2] + v[j][3] * v[j][3];
        ss = wave_sum(ss);
        const float inv = rsqrtf(ss * (1.f / 1024.f) + EPS);
#pragma unroll
        for (int j = 0; j < 4; ++j) {
            const int col = j * 256 + lane * 4;
            if (first) *(f32x4*)(lp + col) = v[j];
            const f32x4 gg = *(const f32x4*)(g + col), sh = *(const f32x4*)(md + col), sc = *(const f32x4*)(md + 1024 + col);
            const f32x4 o = v[j] * inv * gg * (1.f + sc) + sh;
            u32x2 w = {pk2(o[0], o[1]), pk2(o[2], o[3])};
            *(u32x2*)(h + (size_t)(b * RPB + rb) * DM + col) = w;
        }
    }
}

constexpr int BM = 256, BK = 64, HALF = 128, HTB = HALF * BK * 2, NXCD = 8, WGM = 8;
struct Unit { int pm, pn, k0, nt, split, ks; };
enum { EPI_F32 = 0, EPI_BF16 = 1, EPI_RES = 2, EPI_RELU2 = 3, EPI_GLU = 4, EPI_GATES = 5, EPI_GELUMUL = 6, EPI_QN = 8, EPI_KVN = 9, EPI_DQKV = 10 };
struct GemmD {
    const bf16_t* A; const bf16_t* Bt; int lda, ldb, K, nN; int latonly; int koff_shift, koff_mul;
    int kind; int rev; int splitk; float* slab;
    void* out; int ldc;
    const float* gate; int gate_off;
    int layer;
    const float* res_x;
    const float* aux0; const float* aux1; const void* aux2; void* out2;
};
DI int lds_byte(int r, int c) { const int st = (r >> 4) * 2 + (c >> 5), rr = r & 15, cc = c & 31, ob = rr * 64 + cc * 2; return st * 1024 + (ob ^ (((ob >> 9) & 1) << 5)); }
DI void stage_rc(int b, int& R, int& C) { const int st = b / 1024, sb = b % 1024, swz = sb ^ (((sb >> 9) & 1) << 5); R = (st >> 1) * 16 + swz / 64; C = (st & 1) * 32 + (swz % 64) / 2; }

DI bool unit_next(const GemmD& g, int i, Unit& u) {
    const bool sk = g.splitk > 0 && !g.latonly;
    const int nM = (g.latonly || sk) ? 64 : 68, nN = g.nN, nwg = nM * nN, G = GDIM(), c = g.rev ? GDIM() - 1 - BIDX() : BIDX();
    const long L = (long)i * G + c;
    u.k0 = 0; u.nt = g.K / BK; u.split = 0; u.ks = 0;
    if (L >= nwg) {
        if (!sk) return false;
        const int tt = (int)(L - nwg); if (tt >= 4 * nN * g.splitk) return false;
        const int ks = tt / (4 * nN), r = tt - ks * 4 * nN;
        u.pm = 17 * (r & 3); u.pn = r >> 2; u.nt = g.K / BK / g.splitk; u.k0 = ks * u.nt * BK; u.split = 1; u.ks = ks; return true;
    }
    int wgid = (int)L; { const int q = nwg / NXCD, r = nwg % NXCD, xcd = wgid % NXCD, off = wgid / NXCD; wgid = (xcd < r ? xcd * (q + 1) : r * (q + 1) + (xcd - r) * q) + off; }
    const int nig = WGM * nN, gid = wgid / nig, fm = gid * WGM, gsz = (nM - fm) < WGM ? (nM - fm) : WGM;
    int pm = fm + ((wgid % nig) % gsz); u.pn = (wgid % nig) / gsz;
    if (nM == 64) pm = 17 * (pm >> 4) + 1 + (pm & 15);
    u.pm = pm; return true;
}

template <int KIND>
DI void epi_loop(const Params& p, const GemmD& g, const f32x4 (&acc)[2][2][4][2], const Unit& u, int wr, int wc, int fr, int fq) {
    const int b = u.pm / 17, tpm = u.pm - 17 * b, mi = tpm == 0 ? 4 : b;
    const float* gatep = nullptr;
    if (KIND == EPI_RES || KIND == EPI_GLU) gatep = g.gate + (size_t)(mi * 4 + g.layer) * 6144 + g.gate_off;
    f32x4 gbias[2][2], gsp[2];
    if (KIND == EPI_GATES) {
        const int dir = u.pn & 1;
#pragma unroll
        for (int n = 0; n < 2; ++n) {
            const int ch = (u.pn >> 1) * 128 + wc * 32 + n * 16 + fq * 4;
            gbias[n][0] = *(const f32x4*)(g.aux0 + (dir * 2 + 0) * LRUW + ch); gbias[n][1] = *(const f32x4*)(g.aux0 + (dir * 2 + 1) * LRUW + ch);
            const f32x4 lam = *(const f32x4*)(g.aux1 + dir * LRUW + ch);
#pragma unroll
            for (int e = 0; e < 4; ++e) gsp[n][e] = -8.f * log1pf(__expf(-lam[e]));
        }
    }
#pragma unroll
    for (int ai = 0; ai < 2; ++ai)
#pragma unroll
        for (int m = 0; m < 4; ++m) {
            const int rb = tpm * 256 + ai * 128 + wr * 64 + m * 16 + fr;
            const int row = b * RPB + rb;
            float* lp = nullptr;
            if (KIND == EPI_RES || KIND == EPI_GLU) lp = rb < CTXL ? (float*)(p.ws + WS_CTXLAT) + (size_t)(b * CTXL + rb) * DM : p.out + (size_t)(b * SEQ + rb - CTXL) * DM;
            const float* lin = lp;
            if (KIND == EPI_RES) { if (g.res_x && rb >= CTXL) lin = g.res_x + (size_t)(b * SEQ + rb - CTXL) * DM; }
#pragma unroll
            for (int n = 0; n < 2; ++n) {
                const int cw = wc * 32 + n * 16 + fq * 4;
                if (KIND == EPI_F32) {
#pragma unroll
                    for (int bj = 0; bj < 2; ++bj) *(f32x4*)((float*)g.out + (size_t)row * g.ldc + u.pn * 256 + bj * 128 + cw) = acc[ai][bj][m][n];
                } else if (KIND == EPI_BF16) {
#pragma unroll
                    for (int bj = 0; bj < 2; ++bj) { const f32x4 v = acc[ai][bj][m][n]; u32x2 w = {pk2(v[0], v[1]), pk2(v[2], v[3])};
                        *(u32x2*)((bf16_t*)g.out + (size_t)row * g.ldc + u.pn * 256 + bj * 128 + cw) = w; }
                } else if (KIND == EPI_RELU2) {
#pragma unroll
                    for (int bj = 0; bj < 2; ++bj) { f32x4 v = acc[ai][bj][m][n];
#pragma unroll
                        for (int e = 0; e < 4; ++e) { const float r = fmaxf(v[e], 0.f); v[e] = r * r; }
                        u32x2 w = {pk2(v[0], v[1]), pk2(v[2], v[3])};
                        *(u32x2*)((bf16_t*)g.out + (size_t)row * g.ldc + u.pn * 256 + bj * 128 + cw) = w; }
                } else if (KIND == EPI_RES) {
#pragma unroll
                    for (int bj = 0; bj < 2; ++bj) { const int col = u.pn * 256 + bj * 128 + cw;
                        const f32x4 gt = *(const f32x4*)(gatep + col);
                        f32x4 v = *(const f32x4*)(lin + col); v += gt * acc[ai][bj][m][n]; *(f32x4*)(lp + col) = v; }
                } else if (KIND == EPI_GLU) {
                    const int col = u.pn * 128 + cw;
                    const f32x4 zv = acc[ai][0][m][n], zg = acc[ai][1][m][n];
                    const f32x4 gt = *(const f32x4*)(gatep + col); f32x4 v = *(f32x4*)(lp + col);
#pragma unroll
                    for (int e = 0; e < 4; ++e) v[e] += gt[e] * zv[e] * sigmoidf_(zg[e]);
                    *(f32x4*)(lp + col) = v;
                } else if (KIND == EPI_GATES) {
                    const int dir = u.pn & 1;
                    const int ch = (u.pn >> 1) * 128 + cw;
                    const u32x2 xw = *(const u32x2*)((const bf16_t*)g.aux2 + (size_t)row * LRUW + ch);
                    const float xr[4] = {bflo(xw[0]), bfhi(xw[0]), bflo(xw[1]), bfhi(xw[1])};
                    float la[4], bb[4];
#pragma unroll
                    for (int e = 0; e < 4; ++e) {
                        const float r = __builtin_amdgcn_rcpf(1.f + __expf(-(acc[ai][0][m][n][e] + gbias[n][0][e]))), ig = __builtin_amdgcn_rcpf(1.f + __expf(-(acc[ai][1][m][n][e] + gbias[n][1][e])));
                        const float l = gsp[n][e] * r;
                        const float x = 2.f * l;
                        const float om = -x * (1.f + x * (0.5f + x * (0.16666667f + x * (0.041666668f + x * 0.008333334f))));
                        la[e] = l; bb[e] = __builtin_amdgcn_sqrtf(fmaxf(om, 0.f)) * (ig * xr[e]);
                    }
                    u32x2 wl = {pk2(la[0], la[1]), pk2(la[2], la[3])}, wb = {pk2(bb[0], bb[1]), pk2(bb[2], bb[3])};
                    *(u32x2*)((bf16_t*)((unsigned char*)g.out + dir * LRU_DIRSTRIDE) + (size_t)row * LRUW + ch) = wl;
                    *(u32x2*)((bf16_t*)((unsigned char*)g.out2 + dir * LRU_DIRSTRIDE) + (size_t)row * LRUW + ch) = wb;
                } else if (KIND == EPI_GELUMUL) {
#pragma unroll
                    for (int bj = 0; bj < 2; ++bj) { const int col = u.pn * 256 + bj * 128 + cw; f32x4 v = acc[ai][bj][m][n];
#pragma unroll
                        for (int e = 0; e < 4; ++e) v[e] = gelu_tanh(v[e]);
                        u32x2 w = {pk2(v[0], v[1]), pk2(v[2], v[3])};
                        *(u32x2*)((bf16_t*)g.out + (size_t)row * g.ldc + col) = w; }
                }
            }
        }
}

constexpr int XCH_OFF = 131072;
DI void epi_rowstats(const f32x4 (&acc)[2][2][4][2], float (&ps)[2][4][2]) {
#pragma unroll
    for (int ai = 0; ai < 2; ++ai)
#pragma unroll
        for (int m = 0; m < 4; ++m)
#pragma unroll
            for (int bj = 0; bj < 2; ++bj) {
                float s = 0.f;
#pragma unroll
                for (int n = 0; n < 2; ++n) { const f32x4 v = acc[ai][bj][m][n]; s += v[0] * v[0] + v[1] * v[1] + v[2] * v[2] + v[3] * v[3]; }
                s += __shfl_xor(s, 16); s += __shfl_xor(s, 32);
                ps[ai][m][bj] = s;
            }
}
DI void epi_exchange(LAS unsigned char* lds, const float (&ps)[2][4][2], float (&tot)[2][4][2], int wr, int wc, int fr, int fq) {
    LAS float* X = (LAS float*)(lds + XCH_OFF);
    if (fq == 0) {
#pragma unroll
        for (int ai = 0; ai < 2; ++ai)
#pragma unroll
            for (int m = 0; m < 4; ++m)
#pragma unroll
                for (int bj = 0; bj < 2; ++bj) X[((ai * 128 + wr * 64 + m * 16 + fr) * 2 + bj) * 4 + wc] = ps[ai][m][bj];
    }
    asm volatile("s_waitcnt lgkmcnt(0)" ::: "memory"); __builtin_amdgcn_s_barrier(); asm volatile("" ::: "memory");
#pragma unroll
    for (int ai = 0; ai < 2; ++ai)
#pragma unroll
        for (int m = 0; m < 4; ++m)
#pragma unroll
            for (int bj = 0; bj < 2; ++bj) { const f32x4 t = *(const LAS f32x4*)(X + ((ai * 128 + wr * 64 + m * 16 + fr) * 2 + bj) * 4); tot[ai][m][bj] = (t[0] + t[1]) + (t[2] + t[3]); }
}
DI void epi_qn(const Params& p, const GemmD& g, LAS unsigned char* lds, const f32x4 (&acc)[2][2][4][2], const Unit& u, int wr, int wc, int fr, int fq) {
    const int b = u.pm / 17, tpm = u.pm - 17 * b;
    float ps[2][4][2]; epi_rowstats(acc, ps);
    bf16_t* Q = (bf16_t*)g.out; const float* gqk = g.aux0;
    const float* DQSS = (const float*)(p.ws + WS_T + T_DQKV);
    if (u.pn < 4) {
        float tot[2][4][2]; epi_exchange(lds, ps, tot, wr, wc, fr, fq);
        f32x4 gn[2];
#pragma unroll
        for (int n = 0; n < 2; ++n) gn[n] = *(const f32x4*)(gqk + wc * 32 + n * 16 + fq * 4);
#pragma unroll
        for (int ai = 0; ai < 2; ++ai)
#pragma unroll
            for (int m = 0; m < 4; ++m) {
                const int row = b * RPB + tpm * 256 + ai * 128 + wr * 64 + m * 16 + fr;
                float epsq;
                { const f32x4 d0 = *(const f32x4*)(DQSS + (size_t)row * 16), d1 = *(const f32x4*)(DQSS + (size_t)row * 16 + 4), d2 = *(const f32x4*)(DQSS + (size_t)row * 16 + 8);
                  const float ms = (((d0[0] + d0[1]) + (d0[2] + d0[3])) + ((d1[0] + d1[1]) + (d1[2] + d1[3])) + ((d2[0] + d2[1]) + (d2[2] + d2[3]))) * (1.f / 384.f); epsq = EPS * (ms + EPS); }
#pragma unroll
                for (int bj = 0; bj < 2; ++bj) {
                    const float inv = rsqrtf(tot[ai][m][bj] * (1.f / 128.f) + epsq) * QSCALE;
#pragma unroll
                    for (int n = 0; n < 2; ++n) { const f32x4 v = acc[ai][bj][m][n] * inv * gn[n]; u32x2 w = {pk2(v[0], v[1]), pk2(v[2], v[3])};
                        *(u32x2*)(Q + (size_t)row * 1536 + (2 * u.pn + bj) * 192 + wc * 32 + n * 16 + fq * 4) = w; }
                }
            }
    } else {
        const int hh = 4 * (u.pn - 4) + wc; const float* tb = (const float*)(p.ws + WS_ROPE);
        f32x4 gr[2][2];
#pragma unroll
        for (int bj = 0; bj < 2; ++bj)
#pragma unroll
            for (int n = 0; n < 2; ++n) gr[bj][n] = *(const f32x4*)(gqk + 128 + bj * 32 + n * 16 + fq * 4);
#pragma unroll
        for (int ai = 0; ai < 2; ++ai)
#pragma unroll
            for (int m = 0; m < 4; ++m) {
                const int rb = tpm * 256 + ai * 128 + wr * 64 + m * 16 + fr, row = b * RPB + rb, t = rb - CTXL;
                float epsq;
                { const f32x4 d0 = *(const f32x4*)(DQSS + (size_t)row * 16), d1 = *(const f32x4*)(DQSS + (size_t)row * 16 + 4), d2 = *(const f32x4*)(DQSS + (size_t)row * 16 + 8);
                  const float ms = (((d0[0] + d0[1]) + (d0[2] + d0[3])) + ((d1[0] + d1[1]) + (d1[2] + d1[3])) + ((d2[0] + d2[1]) + (d2[2] + d2[3]))) * (1.f / 384.f); epsq = EPS * (ms + EPS); }
                const float inv = rsqrtf((ps[ai][m][0] + ps[ai][m][1]) * (1.f / 64.f) + epsq);
#pragma unroll
                for (int bj = 0; bj < 2; ++bj) {
                    f32x4 x0 = acc[ai][bj][m][0] * inv * gr[bj][0], x1 = acc[ai][bj][m][1] * inv * gr[bj][1];
                    if (tpm != 0) {
                        const int pos = bj == 0 ? (t >> 6) : (t & 63);
                        const f32x4 cs = *(const f32x4*)(tb + pos * 32 + fq * 4), sn = *(const f32x4*)(tb + pos * 32 + 16 + fq * 4);
                        const f32x4 y0 = x0 * cs - x1 * sn, y1 = x1 * cs + x0 * sn; x0 = y0; x1 = y1;
                    }
                    x0 = x0 * QSCALE; x1 = x1 * QSCALE;
                    u32x2 w0 = {pk2(x0[0], x0[1]), pk2(x0[2], x0[3])}, w1 = {pk2(x1[0], x1[1]), pk2(x1[2], x1[3])};
                    bf16_t* qd = Q + (size_t)row * 1536 + hh * 192 + 128 + bj * 32 + fq * 4;
                    *(u32x2*)qd = w0; *(u32x2*)(qd + 16) = w1;
                }
            }
    }
}

DI void epi_dqkv(const Params& p, const GemmD& g, LAS unsigned char* lds, const f32x4 (&acc)[2][2][4][2], const Unit& u, int wr, int wc, int fr, int fq) {
    const int b = u.pm / 17, tpm = u.pm - 17 * b;
    float ps[2][4][2]; epi_rowstats(acc, ps);
    bf16_t* CQ = (bf16_t*)(p.ws + WS_T + T_CQ); bf16_t* CKV = (bf16_t*)(p.ws + WS_T + T_CKV); bf16_t* KR = (bf16_t*)(p.ws + WS_T + T_KR);
    float* DQSS = (float*)(p.ws + WS_T + T_DQKV);
    float tot[2][4][2];
    if (u.pn != 0) epi_exchange(lds, ps, tot, wr, wc, fr, fq);
    f32x4 gk[2]; const float* tb = (const float*)(p.ws + WS_ROPE);
    if (u.pn == 1) { gk[0] = wc < 2 ? *(const f32x4*)(g.aux1 + wc * 32 + fq * 4) : (f32x4){0.f, 0.f, 0.f, 0.f}; gk[1] = wc < 2 ? *(const f32x4*)(g.aux1 + wc * 32 + 16 + fq * 4) : (f32x4){0.f, 0.f, 0.f, 0.f}; }
#pragma unroll
    for (int ai = 0; ai < 2; ++ai)
#pragma unroll
        for (int m = 0; m < 4; ++m) {
            const int rb = tpm * 256 + ai * 128 + wr * 64 + m * 16 + fr, row = b * RPB + rb;
            if (u.pn == 0 || u.pn == 1) {
                const int nh = u.pn == 0 ? 2 : 1;
#pragma unroll
                for (int bj = 0; bj < 2; ++bj) {
                    if (bj < nh) {
#pragma unroll
                        for (int n = 0; n < 2; ++n) { const f32x4 v = acc[ai][bj][m][n]; u32x2 w = {pk2(v[0], v[1]), pk2(v[2], v[3])};
                            *(u32x2*)(CQ + (size_t)row * 384 + u.pn * 256 + bj * 128 + wc * 32 + n * 16 + fq * 4) = w; }
                        if (fq == 0) DQSS[(size_t)row * 16 + u.pn * 8 + bj * 4 + wc] = ps[ai][m][bj];
                    }
                }
            }
            if (u.pn == 1 && wc < 2) {
                const float inv = rsqrtf(tot[ai][m][1] * (1.f / 64.f) + EPS);
                f32x4 x0 = acc[ai][1][m][0] * inv * gk[0], x1 = acc[ai][1][m][1] * inv * gk[1];
                if (tpm != 0) {
                    const int t = rb - CTXL, pos = wc == 0 ? (t >> 6) : (t & 63);
                    const f32x4 cs = *(const f32x4*)(tb + pos * 32 + fq * 4), sn = *(const f32x4*)(tb + pos * 32 + 16 + fq * 4);
                    const f32x4 y0 = x0 * cs - x1 * sn, y1 = x1 * cs + x0 * sn; x0 = y0; x1 = y1;
                }
                u32x2 w0 = {pk2(x0[0], x0[1]), pk2(x0[2], x0[3])}, w1 = {pk2(x1[0], x1[1]), pk2(x1[2], x1[3])};
                bf16_t* kd = KR + (size_t)row * 64 + wc * 32 + fq * 4;
                *(u32x2*)kd = w0; *(u32x2*)(kd + 16) = w1;
            }
            if (u.pn == 2) {
                const float inv = rsqrtf((tot[ai][m][0] + tot[ai][m][1]) * (1.f / 256.f) + EPS);
#pragma unroll
                for (int bj = 0; bj < 2; ++bj)
#pragma unroll
                    for (int n = 0; n < 2; ++n) { const int col = bj * 128 + wc * 32 + n * 16 + fq * 4;
                        const f32x4 v = acc[ai][bj][m][n] * inv * *(const f32x4*)(g.aux0 + col); u32x2 w = {pk2(v[0], v[1]), pk2(v[2], v[3])};
                        *(u32x2*)(CKV + (size_t)row * 256 + col) = w; }
            }
        }
}
DI void epi_kvn(const Params& p, const GemmD& g, LAS unsigned char* lds, const f32x4 (&acc)[2][2][4][2], const Unit& u, int wr, int wc, int fr, int fq) {
    const int b = u.pm / 17, tpm = u.pm - 17 * b;
    float ps[2][4][2], tot[2][4][2]; epi_rowstats(acc, ps); epi_exchange(lds, ps, tot, wr, wc, fr, fq);
    bf16_t* KV = (bf16_t*)g.out; const float* gk = g.aux0;
    f32x4 gn[2];
#pragma unroll
    for (int n = 0; n < 2; ++n) gn[n] = *(const f32x4*)(gk + wc * 32 + n * 16 + fq * 4);
#pragma unroll
    for (int ai = 0; ai < 2; ++ai)
#pragma unroll
        for (int m = 0; m < 4; ++m) {
            const int row = b * RPB + tpm * 256 + ai * 128 + wr * 64 + m * 16 + fr;
            const float inv = rsqrtf(tot[ai][m][0] * (1.f / 128.f) + EPS);
            bf16_t* kd = KV + (size_t)row * 2048 + u.pn * 256 + wc * 32 + fq * 4;
#pragma unroll
            for (int n = 0; n < 2; ++n) {
                const f32x4 k = acc[ai][0][m][n] * inv * gn[n], v = acc[ai][1][m][n];
                u32x2 wk = {pk2(k[0], k[1]), pk2(k[2], k[3])}, wv = {pk2(v[0], v[1]), pk2(v[2], v[3])};
                *(u32x2*)(kd + n * 16) = wk; *(u32x2*)(kd + 128 + n * 16) = wv;
            }
        }
}
DI void epilogue(const Params& p, const GemmD& g, LAS unsigned char* lds, const f32x4 (&acc)[2][2][4][2], const Unit& u, int wr, int wc, int fr, int fq) {
    asm volatile("" : "+v"(fr), "+v"(fq));
    if (u.split) {
        const int b = u.pm / 17;
#pragma unroll
        for (int ai = 0; ai < 2; ++ai)
#pragma unroll
            for (int m = 0; m < 4; ++m) {
                float* sp = g.slab + ((size_t)u.ks * 1024 + (b * CTXL + ai * 128 + wr * 64 + m * 16 + fr)) * (size_t)(g.nN * 256) + u.pn * 256 + wc * 32 + fq * 4;
#pragma unroll
                for (int bj = 0; bj < 2; ++bj)
#pragma unroll
                    for (int n = 0; n < 2; ++n) *(f32x4*)(sp + bj * 128 + n * 16) = acc[ai][bj][m][n];
            }
        return;
    }
    switch (g.kind) {
        case EPI_F32: epi_loop<EPI_F32>(p, g, acc, u, wr, wc, fr, fq); break;
        case EPI_BF16: epi_loop<EPI_BF16>(p, g, acc, u, wr, wc, fr, fq); break;
        case EPI_RES: epi_loop<EPI_RES>(p, g, acc, u, wr, wc, fr, fq); break;
        case EPI_RELU2: epi_loop<EPI_RELU2>(p, g, acc, u, wr, wc, fr, fq); break;
        case EPI_GLU: epi_loop<EPI_GLU>(p, g, acc, u, wr, wc, fr, fq); break;
        case EPI_GATES: epi_loop<EPI_GATES>(p, g, acc, u, wr, wc, fr, fq); break;
        case EPI_QN: epi_qn(p, g, lds, acc, u, wr, wc, fr, fq); break;
        case EPI_KVN: epi_kvn(p, g, lds, acc, u, wr, wc, fr, fq); break;
        case EPI_DQKV: epi_dqkv(p, g, lds, acc, u, wr, wc, fr, fq); break;
        default: epi_loop<EPI_GELUMUL>(p, g, acc, u, wr, wc, fr, fq); break;
    }
}

struct GemmD;
DI GemmD make_gemm(const Params& p, int gid, int layer, bool dry);
#if NAIVE_GEMM
DI void gemm_phase(const Params& p, LAS unsigned char* lds, const GemmD& g, int gid, int layer, bool dry) {
    const int tid = TIDX(), wid = tid >> 6, lane = tid & 63, wr = wid >> 2, wc = wid & 3, fr = lane & 15, fq = lane >> 4;
    Unit u;
    for (int ui = 0; unit_next(g, ui, u); ++ui) {
        f32x4 acc[2][2][4][2];
#pragma unroll
        for (int a = 0; a < 2; ++a)
#pragma unroll
            for (int b = 0; b < 2; ++b)
#pragma unroll
                for (int m = 0; m < 4; ++m)
#pragma unroll
                    for (int n = 0; n < 2; ++n) { const float z = ZF(); acc[a][b][m][n] = (f32x4){z, z, z, z}; }
        const bf16_t* A = g.A + (size_t)u.pm * 256 * g.lda + (size_t)((u.pn >> g.koff_shift) * g.koff_mul);
        const bf16_t* B = g.Bt + (size_t)u.pn * 256 * g.ldb;
        for (int k0 = u.k0; k0 < u.k0 + u.nt * BK; k0 += 32) {
            bf16x8 af[2][4], bfr[2][2];
#pragma unroll
            for (int ai = 0; ai < 2; ++ai)
#pragma unroll
                for (int m = 0; m < 4; ++m) af[ai][m] = *(const bf16x8*)(A + (size_t)(ai * 128 + wr * 64 + m * 16 + fr) * g.lda + k0 + fq * 8);
#pragma unroll
            for (int bj = 0; bj < 2; ++bj)
#pragma unroll
                for (int n = 0; n < 2; ++n) bfr[bj][n] = *(const bf16x8*)(B + (size_t)(bj * 128 + wc * 32 + n * 16 + fr) * g.ldb + k0 + fq * 8);
#pragma unroll
            for (int ai = 0; ai < 2; ++ai)
#pragma unroll
                for (int bj = 0; bj < 2; ++bj)
#pragma unroll
                    for (int m = 0; m < 4; ++m)
#pragma unroll
                        for (int n = 0; n < 2; ++n) acc[ai][bj][m][n] = __builtin_amdgcn_mfma_f32_16x16x32_bf16(bfr[bj][n], af[ai][m], acc[ai][bj][m][n], 0, 0, 0);
        }
        epilogue(p, g, lds, acc, u, wr, wc, fr, fq);
    }
}
#else
DI void gemm_phase(const Params& p, LAS unsigned char* lds, const GemmD& g, int gid, int layer, bool dry) {
    const int tid = TIDX(), wid = __builtin_amdgcn_readfirstlane(tid >> 6), lane = tid & 63, wr = wid >> 2, wc = wid & 3, fr = lane & 15, fq = lane >> 4;
    unsigned voffA[2], voffB[2];
#pragma unroll
    for (int i = 0; i < 2; ++i) { int R, C; stage_rc(tid * 16 + i * 8192, R, C); voffA[i] = (unsigned)(R * g.lda + C) * 2u; voffB[i] = (unsigned)(R * g.ldb + C) * 2u; }
    const size_t kstep = (size_t)(BK * 2);
    const size_t hstepA = (size_t)HALF * g.lda * 2, hstepB = (size_t)HALF * g.ldb * 2;
    const unsigned ldsw = (unsigned)wid * 1024u;
    const int aoff = lds_byte(wr * 64 + fr, fq * 8), boff = lds_byte(wc * 32 + fr, fq * 8);
#define PG8_SA(b, h) (((b) * 2 + (h)) * HTB)
#define PG8_SB(b, h) ((4 + (b) * 2 + (h)) * HTB)
#define PG8_STAGE(bufoff, gbase, voff) do { _Pragma("unroll") for (int _i = 0; _i < 2; ++_i) \
        __builtin_amdgcn_global_load_lds((const unsigned*)((const char*)(gbase) + (voff)[_i]), (LAS unsigned*)(lds + (bufoff) + ldsw + _i * 8192), 16, 0, 0); } while (0)
#define PG8_LDA(dst, b, h) do { _Pragma("unroll") for (int m = 0; m < 4; ++m) _Pragma("unroll") for (int k = 0; k < 2; ++k) dst[m][k] = *(const LAS bf16x8*)(lds + PG8_SA(b, h) + aoff + m * 2048 + k * 1024); } while (0)
#define PG8_LDB(dst, b, h) do { _Pragma("unroll") for (int n = 0; n < 2; ++n) _Pragma("unroll") for (int k = 0; k < 2; ++k) dst[n][k] = *(const LAS bf16x8*)(lds + PG8_SB(b, h) + boff + n * 2048 + k * 1024); } while (0)
#define PG8_MMA(ai, bj, At, Bt) do { __builtin_amdgcn_s_setprio(1); _Pragma("unroll") for (int m = 0; m < 4; ++m) _Pragma("unroll") for (int n = 0; n < 2; ++n) _Pragma("unroll") for (int k = 0; k < 2; ++k) \
        acc[ai][bj][m][n] = __builtin_amdgcn_mfma_f32_16x16x32_bf16(Bt[n][k], At[m][k], acc[ai][bj][m][n], 0, 0, 0); __builtin_amdgcn_s_setprio(0); } while (0)
#define PG8_WAIT_V(n) asm volatile("s_waitcnt vmcnt(" #n ")" ::: "memory")
#define PG8_WAIT_L(n) asm volatile("s_waitcnt lgkmcnt(" #n ")" ::: "memory")
#define PG8_BAR __builtin_amdgcn_s_barrier()
#define PG8_SCHED __builtin_amdgcn_sched_barrier(0)
    Unit cur, nxt; int ui = 0;
    if (!unit_next(g, 0, cur)) return;
    f32x4 acc[2][2][4][2];
#pragma unroll
    for (int a = 0; a < 2; ++a)
#pragma unroll
        for (int b = 0; b < 2; ++b)
#pragma unroll
            for (int m = 0; m < 4; ++m)
#pragma unroll
                for (int n = 0; n < 2; ++n) { const float z = ZF(); acc[a][b][m][n] = (f32x4){z, z, z, z}; }
    bf16x8 At[4][2], B0[2][2], B1[2][2];
    const char* cA = (const char*)g.A + (size_t)cur.pm * 2 * hstepA + (size_t)((cur.pn >> g.koff_shift) * g.koff_mul + cur.k0) * 2;
    const char* cB = (const char*)g.Bt + (size_t)cur.pn * 2 * hstepB + (size_t)cur.k0 * 2;
    PG8_STAGE(PG8_SB(0, 0), cB, voffB); PG8_STAGE(PG8_SB(0, 1), cB + hstepB, voffB); PG8_STAGE(PG8_SA(0, 0), cA, voffA); PG8_STAGE(PG8_SA(0, 1), cA + hstepA, voffA);
    if (wr == 1) PG8_BAR;
    PG8_WAIT_V(2); PG8_BAR;
    PG8_STAGE(PG8_SB(1, 0), cB + kstep, voffB); PG8_STAGE(PG8_SA(1, 0), cA + kstep, voffA); PG8_STAGE(PG8_SB(1, 1), cB + hstepB + kstep, voffB);
    PG8_WAIT_V(6); PG8_BAR;
    for (;;) {
        const bool has_next = unit_next(g, ui + 1, nxt);
        const char* nA = has_next ? (const char*)g.A + (size_t)nxt.pm * 2 * hstepA + (size_t)((nxt.pn >> g.koff_shift) * g.koff_mul + nxt.k0) * 2 : cA;
        const char* nB = has_next ? (const char*)g.Bt + (size_t)nxt.pn * 2 * hstepB + (size_t)nxt.k0 * 2 : cB;
        const int nt = cur.nt;
        for (int t = 0; t < nt; t += 2) {
            const bool last = (t == nt - 2);
            const char* a1 = cA + (size_t)(t + 1) * kstep;
            const char* a2 = last ? nA : cA + (size_t)(t + 2) * kstep; const char* b2 = last ? nB : cB + (size_t)(t + 2) * kstep;
            const char* a3 = a2 + kstep; const char* b3 = b2 + kstep;
            PG8_LDB(B0, 0, 0); PG8_LDB(B1, 0, 1); PG8_SCHED; PG8_LDA(At, 0, 0); PG8_STAGE(PG8_SA(1, 1), a1 + hstepA, voffA);
            PG8_WAIT_V(8); PG8_WAIT_L(0); PG8_BAR; PG8_MMA(0, 0, At, B0); PG8_MMA(0, 1, At, B1); PG8_BAR; PG8_SCHED;
            PG8_LDA(At, 0, 1); PG8_STAGE(PG8_SB(0, 0), b2, voffB); PG8_STAGE(PG8_SB(0, 1), b2 + hstepB, voffB); PG8_STAGE(PG8_SA(0, 0), a2, voffA);
            PG8_WAIT_V(8); PG8_WAIT_L(0); PG8_BAR; PG8_MMA(1, 0, At, B0); PG8_MMA(1, 1, At, B1); PG8_BAR; PG8_SCHED;
            PG8_LDB(B0, 1, 0); PG8_LDB(B1, 1, 1); PG8_SCHED; PG8_LDA(At, 1, 0); PG8_STAGE(PG8_SA(0, 1), a2 + hstepA, voffA);
            PG8_WAIT_V(8); PG8_WAIT_L(0); PG8_BAR; PG8_MMA(0, 0, At, B0); PG8_MMA(0, 1, At, B1); PG8_BAR; PG8_SCHED;
            PG8_LDA(At, 1, 1); PG8_STAGE(PG8_SB(1, 0), b3, voffB); PG8_STAGE(PG8_SB(1, 1), b3 + hstepB, voffB); PG8_STAGE(PG8_SA(1, 0), a3, voffA);
            PG8_WAIT_V(8); PG8_WAIT_L(0); PG8_BAR; PG8_MMA(1, 0, At, B0); PG8_MMA(1, 1, At, B1); PG8_BAR; PG8_SCHED;
        }
        if (wr == 0) PG8_BAR;
        { int g2 = gid; asm volatile("" : "+s"(g2));
          const GemmD ge = make_gemm(p, g2, layer, dry); epilogue(p, ge, lds, acc, cur, wr, wc, fr, fq); }
        if (!has_next) break;
#pragma unroll
        for (int a = 0; a < 2; ++a)
#pragma unroll
            for (int b = 0; b < 2; ++b)
#pragma unroll
                for (int m = 0; m < 4; ++m)
#pragma unroll
                    for (int n = 0; n < 2; ++n) { const float z = ZF(); acc[a][b][m][n] = (f32x4){z, z, z, z}; }
        cur = nxt; cA = nA; cB = nB; ++ui;
        if (wr == 1) PG8_BAR;
    }
    PG8_WAIT_V(0);
    PG8_BAR;
#undef PG8_SA
#undef PG8_SB
#undef PG8_STAGE
#undef PG8_LDA
#undef PG8_LDB
#undef PG8_MMA
#undef PG8_WAIT_V
#undef PG8_WAIT_L
#undef PG8_BAR
#undef PG8_SCHED
}
#endif

DI void rope_cs(int pos, int k, float& cs, float& sn) { const float f = exp2f(-(float)k * (13.287712379549449f / 16.f)); sincosf((float)pos * f, &sn, &cs); }

DI void rope_table(const Params& p) {
    const int gt = BIDX() * NTHREADS + TIDX();
    if (gt < 64 * 16) { const int pos = gt >> 4, k = gt & 15; float cs, sn; rope_cs(pos, k, cs, sn); float* tb = (float*)(p.ws + WS_ROPE); tb[pos * 32 + k] = cs; tb[pos * 32 + 16 + k] = sn; }
}
DI float sum8(float v) { v += __shfl_xor(v, 1); v += __shfl_xor(v, 2); v += __shfl_xor(v, 4); return v; }
DI void mla_rowop_a3(const Params& p, int j) {
    const int lane = TIDX() & 63, gw = BIDX() * NWAVES + (TIDX() >> 6), nw = GDIM() * NWAVES;
    const float* dq = (const float*)(p.ws + WS_T + T_DQKV);
    bf16_t* cq = (bf16_t*)(p.ws + WS_T + T_CQ); bf16_t* ckv = (bf16_t*)(p.ws + WS_T + T_CKV); bf16_t* kr = (bf16_t*)(p.ws + WS_T + T_KR);
    const float* tb = (const float*)(p.ws + WS_ROPE);
    const float* gq = IN(p, 8) + j * 384; const float* gkv = IN(p, 11) + j * 256; const float* gkr = IN(p, 13) + j * 384 + 192 + 128;
    const bool isq1 = lane < 32, iskr = lane >= 32 && lane < 48;
    const f32x4 g0 = *(const f32x4*)(gq + 4 * lane);
    const f32x4 g1 = isq1 ? *(const f32x4*)(gq + 256 + 4 * lane) : *(const f32x4*)(gkv + 4 * (lane - 32));
    f32x4 g2 = {0.f, 0.f, 0.f, 0.f}; if (lane < 32) g2 = *(const f32x4*)(gkv + 128 + 4 * lane); else if (iskr) g2 = *(const f32x4*)(gkr + 4 * (lane - 32));
    for (int r0 = gw * 2; r0 < MROWS; r0 += nw * 2) {
        f32x4 v[2][3]; float s0[2], s1[2], s2[2];
#pragma unroll
        for (int rr = 0; rr < 2; ++rr) {
            const float* s = dq + (size_t)(r0 + rr) * 768 + 4 * lane;
            v[rr][0] = *(const f32x4*)s; v[rr][1] = *(const f32x4*)(s + 256); v[rr][2] = lane < 48 ? *(const f32x4*)(s + 512) : (f32x4){0.f, 0.f, 0.f, 0.f};
        }
#pragma unroll
        for (int rr = 0; rr < 2; ++rr) {
            const float q0 = v[rr][0][0] * v[rr][0][0] + v[rr][0][1] * v[rr][0][1] + v[rr][0][2] * v[rr][0][2] + v[rr][0][3] * v[rr][0][3];
            const float q1 = v[rr][1][0] * v[rr][1][0] + v[rr][1][1] * v[rr][1][1] + v[rr][1][2] * v[rr][1][2] + v[rr][1][3] * v[rr][1][3];
            const float q2 = v[rr][2][0] * v[rr][2][0] + v[rr][2][1] * v[rr][2][1] + v[rr][2][2] * v[rr][2][2] + v[rr][2][3] * v[rr][2][3];
            s0[rr] = q0 + (isq1 ? q1 : 0.f); s1[rr] = (isq1 ? 0.f : q1) + (lane < 32 ? q2 : 0.f); s2[rr] = iskr ? q2 : 0.f;
        }
#pragma unroll
        for (int o = 32; o; o >>= 1) {
#pragma unroll
            for (int rr = 0; rr < 2; ++rr) { s0[rr] += __shfl_xor(s0[rr], o); s1[rr] += __shfl_xor(s1[rr], o); s2[rr] += __shfl_xor(s2[rr], o); }
        }
#pragma unroll
        for (int rr = 0; rr < 2; ++rr) {
            const int row = r0 + rr, b = row / RPB, rb = row - b * RPB;
            const float i0 = rsqrtf(s0[rr] * (1.f / 384.f) + EPS), i1 = rsqrtf(s1[rr] * (1.f / 256.f) + EPS), i2 = rsqrtf(s2[rr] * (1.f / 64.f) + EPS);
            { const f32x4 o = v[rr][0] * i0 * g0; u32x2 w = {pk2(o[0], o[1]), pk2(o[2], o[3])}; *(u32x2*)(cq + (size_t)row * 384 + 4 * lane) = w; }
            if (isq1) { const f32x4 o = v[rr][1] * i0 * g1; u32x2 w = {pk2(o[0], o[1]), pk2(o[2], o[3])}; *(u32x2*)(cq + (size_t)row * 384 + 256 + 4 * lane) = w; }
            else { const f32x4 o = v[rr][1] * i1 * g1; u32x2 w = {pk2(o[0], o[1]), pk2(o[2], o[3])}; *(u32x2*)(ckv + (size_t)row * 256 + 4 * (lane - 32)) = w; }
            if (lane < 32) { const f32x4 o = v[rr][2] * i1 * g2; u32x2 w = {pk2(o[0], o[1]), pk2(o[2], o[3])}; *(u32x2*)(ckv + (size_t)row * 256 + 128 + 4 * lane) = w; }
            f32x4 x = v[rr][2] * i2 * g2;
            f32x4 xp; xp[0] = __shfl_xor(x[0], 4); xp[1] = __shfl_xor(x[1], 4); xp[2] = __shfl_xor(x[2], 4); xp[3] = __shfl_xor(x[3], 4);
            if (iskr) {
                if (rb >= CTXL) {
                    const int t = rb - CTXL, d0 = 4 * (lane - 32), q4 = d0 >> 4, k0 = d0 & 15, pos = q4 < 2 ? (t >> 6) : (t & 63);
                    const f32x4 cs = *(const f32x4*)(tb + pos * 32 + k0), sn = *(const f32x4*)(tb + pos * 32 + 16 + k0);
                    x = x * cs + ((q4 & 1) ? xp : -xp) * sn;
                }
                u32x2 w = {pk2(x[0], x[1]), pk2(x[2], x[3])}; *(u32x2*)(kr + (size_t)row * 64 + 4 * (lane - 32)) = w;
            }
        }
    }
}
DI void mla_rowop_a5(const Params& p, int j, bool latonly) {
    const int lane = TIDX() & 63, gw = BIDX() * NWAVES + (TIDX() >> 6), nw = GDIM() * NWAVES;
    const int hg = lane >> 3, l8 = lane & 7, q4 = l8 >> 1, k0 = 8 * (l8 & 1);
    bf16_t* qp = (bf16_t*)(p.ws + WS_T + T_QPRE); bf16_t* kv = (bf16_t*)(p.ws + WS_T + T_KVPRE);
    const float* tb = (const float*)(p.ws + WS_ROPE);
    const float* gqk = IN(p, 13) + j * 384;
    f32x4 gqn[4], gqr[2], gkn[4];
#pragma unroll
    for (int i = 0; i < 4; ++i) { gqn[i] = *(const f32x4*)(gqk + 16 * l8 + 4 * i); gkn[i] = *(const f32x4*)(gqk + 192 + 16 * l8 + 4 * i); }
    gqr[0] = *(const f32x4*)(gqk + 128 + 8 * l8); gqr[1] = *(const f32x4*)(gqk + 128 + 8 * l8 + 4);
    for (int r0 = gw * 2; r0 < MROWS; r0 += nw * 2) {
        const int b = r0 / RPB, rb0 = r0 - b * RPB; const bool isctx = rb0 < CTXL;
        const bool doq = !(latonly && isctx);
        u32x4 qn[2][2], qrp[2], kn[2][2];
#pragma unroll
        for (int rr = 0; rr < 2; ++rr) {
            const bf16_t* qr = qp + (size_t)(r0 + rr) * 1536 + hg * 192; const bf16_t* kr_ = kv + (size_t)(r0 + rr) * 2048 + hg * 256 + 16 * l8;
            if (doq) { qn[rr][0] = *(const u32x4*)(qr + 16 * l8); qn[rr][1] = *(const u32x4*)(qr + 16 * l8 + 8); qrp[rr] = *(const u32x4*)(qr + 128 + 8 * l8); }
            else { qn[rr][0] = qn[rr][1] = qrp[rr] = (u32x4){0, 0, 0, 0}; }
            kn[rr][0] = *(const u32x4*)kr_; kn[rr][1] = *(const u32x4*)(kr_ + 8);
        }
#pragma unroll
        for (int rr = 0; rr < 2; ++rr) {
            const int row = r0 + rr;
            float a[16], r[8], k[16];
#pragma unroll
            for (int i = 0; i < 4; ++i) { a[2 * i] = bflo(qn[rr][0][i]); a[2 * i + 1] = bfhi(qn[rr][0][i]); a[8 + 2 * i] = bflo(qn[rr][1][i]); a[8 + 2 * i + 1] = bfhi(qn[rr][1][i]);
                r[2 * i] = bflo(qrp[rr][i]); r[2 * i + 1] = bfhi(qrp[rr][i]);
                k[2 * i] = bflo(kn[rr][0][i]); k[2 * i + 1] = bfhi(kn[rr][0][i]); k[8 + 2 * i] = bflo(kn[rr][1][i]); k[8 + 2 * i + 1] = bfhi(kn[rr][1][i]); }
            float sa = 0.f, sr = 0.f, sk = 0.f;
#pragma unroll
            for (int i = 0; i < 16; ++i) { sa += a[i] * a[i]; sk += k[i] * k[i]; }
#pragma unroll
            for (int i = 0; i < 8; ++i) sr += r[i] * r[i];
            sa = sum8(sa); sr = sum8(sr); sk = sum8(sk);
            const float ia = rsqrtf(sa * (1.f / 128.f) + EPS) * QSCALE, ir = rsqrtf(sr * (1.f / 64.f) + EPS), ik = rsqrtf(sk * (1.f / 128.f) + EPS);
            if (doq) {
                bf16_t* qr = qp + (size_t)row * 1536 + hg * 192;
                u32x4 w0, w1;
#pragma unroll
                for (int i = 0; i < 4; ++i) { w0[i] = pk2(a[2 * i] * ia * gqn[i >> 1][(2 * i) & 3], a[2 * i + 1] * ia * gqn[i >> 1][(2 * i + 1) & 3]);
                    w1[i] = pk2(a[8 + 2 * i] * ia * gqn[2 + (i >> 1)][(2 * i) & 3], a[8 + 2 * i + 1] * ia * gqn[2 + (i >> 1)][(2 * i + 1) & 3]); }
                *(u32x4*)(qr + 16 * l8) = w0; *(u32x4*)(qr + 16 * l8 + 8) = w1;
                float x[8];
#pragma unroll
                for (int i = 0; i < 8; ++i) x[i] = r[i] * ir * gqr[i >> 2][i & 3];
                if (!isctx) {
                    const int t = rb0 + rr - CTXL, pos = q4 < 2 ? (t >> 6) : (t & 63);
                    const f32x4 c0 = *(const f32x4*)(tb + pos * 32 + k0), c1 = *(const f32x4*)(tb + pos * 32 + k0 + 4), s0 = *(const f32x4*)(tb + pos * 32 + 16 + k0), s1 = *(const f32x4*)(tb + pos * 32 + 16 + k0 + 4);
#pragma unroll
                    for (int i = 0; i < 8; ++i) { const float xp = __shfl_xor(x[i], 2); const float cs = i < 4 ? c0[i & 3] : c1[i & 3], sn = i < 4 ? s0[i & 3] : s1[i & 3];
                        x[i] = x[i] * cs + ((q4 & 1) ? xp : -xp) * sn; }
                }
                u32x4 wr_;
#pragma unroll
                for (int i = 0; i < 4; ++i) wr_[i] = pk2(x[2 * i] * QSCALE, x[2 * i + 1] * QSCALE);
                *(u32x4*)(qr + 128 + 8 * l8) = wr_;
            }
            bf16_t* kr_ = kv + (size_t)row * 2048 + hg * 256 + 16 * l8;
            u32x4 k0w, k1w;
#pragma unroll
            for (int i = 0; i < 4; ++i) { k0w[i] = pk2(k[2 * i] * ik * gkn[i >> 1][(2 * i) & 3], k[2 * i + 1] * ik * gkn[i >> 1][(2 * i + 1) & 3]);
                k1w[i] = pk2(k[8 + 2 * i] * ik * gkn[2 + (i >> 1)][(2 * i) & 3], k[8 + 2 * i + 1] * ik * gkn[2 + (i >> 1)][(2 * i + 1) & 3]); }
            *(u32x4*)kr_ = k0w; *(u32x4*)(kr_ + 8) = k1w;
        }
    }
}

namespace attn {
constexpr int LDQ = 1536, LDKN = 2048, LDKR = 64, LDO = 1024, KVBLK = 64;
constexpr int SHM_V = KVBLK * 128 * 2, SHM_KN = KVBLK * 128 * 2, SHM_KR = KVBLK * 64 * 2;
constexpr int OFF_V = 0, OFF_KN = 2 * SHM_V, OFF_KR = OFF_KN + 2 * SHM_KN, OFF_WS = OFF_KR + 2 * SHM_KR, OFF_QR = OFF_WS + NWAVES * 64 * 4, LDS_BYTES = OFF_QR + NWAVES * 4096;
constexpr float THRL = 8.f * 1.4426950408889634f;
#define KSWZ(row, colB) ((row) * 256 + ((colB) ^ (((row) & 7) << 4)))
#define RSWZ(row, colB) ((row) * 128 + ((colB) ^ ((((row) >> 1) & 7) << 4)))
#define SBAR() __builtin_amdgcn_sched_barrier(0)
DI int crow(int r, int hi) { return (r & 3) + 8 * (r >> 2) + 4 * hi; }
DI unsigned cvtpk(float lo, float hi) { unsigned r; asm volatile("v_cvt_pk_bf16_f32 %0, %1, %2" : "=v"(r) : "v"(lo), "v"(hi)); return r; }

DI void partialSM(f32x16& p0, f32x16& p1, float& m_reg, float& mn, float& alpha) {
    float pmax = p0[0];
#pragma unroll
    for (int r = 1; r < 16; ++r) pmax = fmaxf(pmax, p0[r]);
#pragma unroll
    for (int r = 0; r < 16; ++r) pmax = fmaxf(pmax, p1[r]);
    { auto rr = __builtin_amdgcn_permlane32_swap(__float_as_uint(pmax), __float_as_uint(pmax), false, false);
      pmax = fmaxf(__uint_as_float(rr[0]), __uint_as_float(rr[1])); }
    if (__builtin_expect(__all(pmax - m_reg <= THRL), 1)) { mn = m_reg; alpha = 1.f; }
    else { mn = fmaxf(m_reg, pmax); alpha = __builtin_amdgcn_exp2f(m_reg - mn); m_reg = mn; }
#pragma unroll
    for (int r = 0; r < 16; ++r) p0[r] = p0[r] - mn;
#pragma unroll
    for (int r = 0; r < 16; ++r) p1[r] = p1[r] - mn;
#pragma unroll
    for (int r = 0; r < 16; ++r) p0[r] = __builtin_amdgcn_exp2f(p0[r]);
}
DI void finishSM(f32x16& p0, f32x16& p1, float alpha, float& l_reg, bf16x8& pa0, bf16x8& pa1, bf16x8& pa2, bf16x8& pa3) {
#pragma unroll
    for (int r = 0; r < 16; ++r) p1[r] = __builtin_amdgcn_exp2f(p1[r]);
    float ps = 0;
#pragma unroll
    for (int r = 0; r < 16; ++r) ps += p0[r];
#pragma unroll
    for (int r = 0; r < 16; ++r) ps += p1[r];
    { auto rr = __builtin_amdgcn_permlane32_swap(__float_as_uint(ps), __float_as_uint(ps), false, false);
      ps = __uint_as_float(rr[0]) + __uint_as_float(rr[1]); }
    l_reg = l_reg * alpha + ps;
#define PK4(P, BASE, OUT) do { unsigned a0 = cvtpk(P[BASE + 0], P[BASE + 1]), a1 = cvtpk(P[BASE + 2], P[BASE + 3]);   \
    unsigned b0 = cvtpk(P[BASE + 4], P[BASE + 5]), b1 = cvtpk(P[BASE + 6], P[BASE + 7]);                              \
    auto r0 = __builtin_amdgcn_permlane32_swap(a0, b0, false, false); auto r1 = __builtin_amdgcn_permlane32_swap(a1, b1, false, false); \
    u32x4 w = {r0[0], r1[0], r0[1], r1[1]}; OUT = *reinterpret_cast<bf16x8*>(&w); } while (0)
    PK4(p0, 0, pa0); PK4(p0, 8, pa1); PK4(p1, 0, pa2); PK4(p1, 8, pa3);
#undef PK4
}
DI void qkt(f32x16& p0, f32x16& p1, const char* Kn, const char* Kr, const bf16x8* qr, const char* qrl, int r32, int hi) {
    p0 = f32x16{}; p1 = f32x16{};
#pragma unroll
    for (int d0 = 0; d0 < 8; ++d0) { const int cb = (d0 * 16 + hi * 8) * 2;
        const bf16x8 b0 = *reinterpret_cast<const bf16x8*>(Kn + KSWZ(r32, cb));
        const bf16x8 b1 = *reinterpret_cast<const bf16x8*>(Kn + KSWZ(32 + r32, cb));
        p0 = __builtin_amdgcn_mfma_f32_32x32x16_bf16(b0, qr[d0], p0, 0, 0, 0);
        p1 = __builtin_amdgcn_mfma_f32_32x32x16_bf16(b1, qr[d0], p1, 0, 0, 0); }
#pragma unroll
    for (int d0 = 0; d0 < 4; ++d0) { const int cb = (d0 * 16 + hi * 8) * 2;
        const bf16x8 b0 = *reinterpret_cast<const bf16x8*>(Kr + RSWZ(r32, cb));
        const bf16x8 b1 = *reinterpret_cast<const bf16x8*>(Kr + RSWZ(32 + r32, cb));
        const bf16x8 qf = *reinterpret_cast<const bf16x8*>(qrl + d0 * 1024);
        p0 = __builtin_amdgcn_mfma_f32_32x32x16_bf16(b0, qf, p0, 0, 0, 0);
        p1 = __builtin_amdgcn_mfma_f32_32x32x16_bf16(b1, qf, p1, 0, 0, 0); }
}
DI int v_st(int k, int c) { const int kk = (k & ~0xC) | ((k & 4) << 1) | ((k & 8) >> 1); return ((kk >> 3) * 4 + (c >> 5)) * 512 + ((kk & 7) * 32 + (c & 31)) * 2; }
DI int v_rd_base(int lane) { return ((lane & 3) << 3) | (((lane >> 2) & 3) << 6) | (((lane >> 4) & 1) << 5) | (((lane >> 5) & 1) << 8); }
constexpr int v_rd_off(int d0, int ks, int half) { return d0 * 512 + ks * 4096 + half * 2048; }
template <int OFF> DI s16x4 tr_read(int vb) { s16x4 r; asm volatile("ds_read_b64_tr_b16 %0, %1 offset:%2" : "=&v"(r) : "v"(vb), "i"(OFF) : "memory"); return r; }
template <int D0> DI void pv_one(f32x16& od, int vb, bf16x8 pa0, bf16x8 pa1, bf16x8 pa2, bf16x8 pa3) {
    const s16x4 l0 = tr_read<v_rd_off(D0, 0, 0)>(vb), h0 = tr_read<v_rd_off(D0, 0, 1)>(vb), l1 = tr_read<v_rd_off(D0, 1, 0)>(vb), h1 = tr_read<v_rd_off(D0, 1, 1)>(vb);
    const s16x4 l2 = tr_read<v_rd_off(D0, 2, 0)>(vb), h2 = tr_read<v_rd_off(D0, 2, 1)>(vb), l3 = tr_read<v_rd_off(D0, 3, 0)>(vb), h3 = tr_read<v_rd_off(D0, 3, 1)>(vb);
    asm volatile("s_waitcnt lgkmcnt(0)" ::: "memory"); SBAR();
#define PK(L, H) (bf16x8){L[0], L[1], L[2], L[3], H[0], H[1], H[2], H[3]}
    od = __builtin_amdgcn_mfma_f32_32x32x16_bf16(pa0, PK(l0, h0), od, 0, 0, 0);
    od = __builtin_amdgcn_mfma_f32_32x32x16_bf16(pa1, PK(l1, h1), od, 0, 0, 0);
    od = __builtin_amdgcn_mfma_f32_32x32x16_bf16(pa2, PK(l2, h2), od, 0, 0, 0);
    od = __builtin_amdgcn_mfma_f32_32x32x16_bf16(pa3, PK(l3, h3), od, 0, 0, 0);
#undef PK
}
DI void pv_d0(f32x16* o, int vb, bf16x8 pa0, bf16x8 pa1, bf16x8 pa2, bf16x8 pa3) {
    pv_one<0>(o[0], vb, pa0, pa1, pa2, pa3); pv_one<1>(o[1], vb, pa0, pa1, pa2, pa3); pv_one<2>(o[2], vb, pa0, pa1, pa2, pa3); pv_one<3>(o[3], vb, pa0, pa1, pa2, pa3);
}
DI void attn_unit(const bf16_t* __restrict__ Qb, const bf16_t* __restrict__ Knb, const bf16_t* __restrict__ Krb, const bf16_t* __restrict__ Vb, bf16_t* __restrict__ Ob, int seq, char* lds) {
    const int tid = TIDX(), wid = tid >> 6, lane = tid & 63, r32 = lane & 31, hi = lane >> 5;
    char* V_lds = lds + OFF_V; char* Kn_lds = lds + OFF_KN; char* Kr_lds = lds + OFF_KR;
    float* ws = (float*)(lds + OFF_WS) + wid * 64; float* li_l = ws; float* al_l = ws + 32;
    float m_reg = -1e30f, l_reg = 0; f32x16 o[4] = {}; bf16x8 qr[8];
    const bf16_t* Qw = Qb + (long)(wid * 32 + r32) * LDQ + hi * 8;
    char* qrl = lds + OFF_QR + wid * 4096 + lane * 16;
#pragma unroll
    for (int d0 = 0; d0 < 8; ++d0) qr[d0] = *reinterpret_cast<const bf16x8*>(Qw + d0 * 16);
#pragma unroll
    for (int d0 = 0; d0 < 4; ++d0) *reinterpret_cast<bf16x8*>(qrl + d0 * 1024) = *reinterpret_cast<const bf16x8*>(Qw + 128 + d0 * 16);
    const int sr = tid >> 4, sc = (tid & 15) * 8, vst0 = v_st(sr, sc), vst1 = v_st(32 + sr, sc);
    const int rr_ = tid >> 3, rc_ = (tid & 7) * 8;
    const int vb0 = (int)(uintptr_t)V_lds + v_rd_base(lane);
    struct { bf16x8 vs0, vs1, ks0, ks1, kr; } sr_[1];
#define SLOAD(i, k0) do { sr_[i].vs0 = *(const bf16x8*)(&Vb[(long)((k0) + sr) * LDKN + sc]); sr_[i].vs1 = *(const bf16x8*)(&Vb[(long)((k0) + 32 + sr) * LDKN + sc]); \
    sr_[i].ks0 = *(const bf16x8*)(&Knb[(long)((k0) + sr) * LDKN + sc]); sr_[i].ks1 = *(const bf16x8*)(&Knb[(long)((k0) + 32 + sr) * LDKN + sc]); \
    sr_[i].kr = *(const bf16x8*)(&Krb[(long)((k0) + rr_) * LDKR + rc_]); } while (0)
#define SWRITE(b, i) do { *(bf16x8*)(V_lds + (b) * SHM_V + vst0) = sr_[i].vs0; *(bf16x8*)(V_lds + (b) * SHM_V + vst1) = sr_[i].vs1; const int kc = sc * 2; \
    *(bf16x8*)(Kn_lds + (b) * SHM_KN + KSWZ(sr, kc)) = sr_[i].ks0; *(bf16x8*)(Kn_lds + (b) * SHM_KN + KSWZ(32 + sr, kc)) = sr_[i].ks1; \
    *(bf16x8*)(Kr_lds + (b) * SHM_KR + RSWZ(rr_, rc_ * 2)) = sr_[i].kr; } while (0)
#define SWAIT() asm volatile("s_waitcnt vmcnt(0)" ::: "memory")
#define RESC(a) do { if (__any((a) < 1.f)) { if (hi == 0) al_l[r32] = (a); asm volatile("s_waitcnt lgkmcnt(0)" ::: "memory"); \
    _Pragma("unroll") for (int d = 0; d < 4; ++d) _Pragma("unroll") for (int r = 0; r < 16; ++r) o[d][r] *= al_l[crow(r, hi)]; } } while (0)
    f32x16 pA0, pA1, pB0, pB1; float mnA, mnB, alA, alB; bf16x8 pa0, pa1, pa2, pa3; const int NT = seq / KVBLK;
    constexpr int SE = 0, SO = 0;
    SLOAD(SE, 0); asm volatile("s_waitcnt vmcnt(0)" ::: "memory"); SWRITE(0, SE); __syncthreads();
    qkt(pA0, pA1, Kn_lds, Kr_lds, qr, qrl, r32, hi); partialSM(pA0, pA1, m_reg, mnA, alA);
    SLOAD(SO, KVBLK);
    SWAIT(); SWRITE(1, SO); __syncthreads();
    for (int j = 1; j + 1 < NT; j += 2) {
        SBAR(); qkt(pB0, pB1, Kn_lds + SHM_KN, Kr_lds + SHM_KR, qr, qrl, r32, hi);
        finishSM(pA0, pA1, alA, l_reg, pa0, pa1, pa2, pa3); SBAR();
        SLOAD(SE, (j + 1) * KVBLK); SBAR();
        pv_d0(o, vb0, pa0, pa1, pa2, pa3); partialSM(pB0, pB1, m_reg, mnB, alB);
        __syncthreads(); SWAIT(); SWRITE(0, SE);
        RESC(alB); __syncthreads();
        SBAR(); qkt(pA0, pA1, Kn_lds, Kr_lds, qr, qrl, r32, hi);
        finishSM(pB0, pB1, alB, l_reg, pa0, pa1, pa2, pa3); SBAR();
        SLOAD(SO, (j + 2) * KVBLK); SBAR();
        pv_d0(o, vb0 + SHM_V, pa0, pa1, pa2, pa3); partialSM(pA0, pA1, m_reg, mnA, alA);
        __syncthreads(); SWAIT(); SWRITE(1, SO);
        RESC(alA); __syncthreads();
    }
    SBAR(); qkt(pB0, pB1, Kn_lds + SHM_KN, Kr_lds + SHM_KR, qr, qrl, r32, hi);
    finishSM(pA0, pA1, alA, l_reg, pa0, pa1, pa2, pa3); SBAR();
    pv_d0(o, vb0, pa0, pa1, pa2, pa3); partialSM(pB0, pB1, m_reg, mnB, alB);
    __syncthreads(); RESC(alB);
    finishSM(pB0, pB1, alB, l_reg, pa0, pa1, pa2, pa3); SBAR();
    pv_d0(o, vb0 + SHM_V, pa0, pa1, pa2, pa3);
    if (hi == 0) li_l[r32] = l_reg; asm volatile("s_waitcnt lgkmcnt(0)" ::: "memory");
    float rli[16];
#pragma unroll
    for (int r = 0; r < 16; ++r) rli[r] = __builtin_amdgcn_rcpf(li_l[crow(r, hi)]);
    bf16_t* Ow = Ob + (long)(wid * 32) * LDO;
#pragma unroll
    for (int r = 0; r < 16; ++r) { const int orow = crow(r, hi);
#pragma unroll
        for (int d0 = 0; d0 < 4; ++d0) Ow[(long)orow * LDO + d0 * 32 + r32] = (bf16_t)f2bf(o[d0][r] * rli[r]); }
    __syncthreads();
#undef SLOAD
#undef SWRITE
#undef SWAIT
#undef RESC
}
}
DI void attn_phase(const Params& p, bool need_ctx, char* lds) {
    const bf16_t* qp = (const bf16_t*)(p.ws + WS_T + T_QPRE); const bf16_t* kv = (const bf16_t*)(p.ws + WS_T + T_KVPRE); const bf16_t* kr = (const bf16_t*)(p.ws + WS_T + T_KR);
    bf16_t* O = (bf16_t*)(p.ws + WS_H);
    const int G = GDIM(), bx = BIDX(), vcu = (G % 8 == 0) ? (bx % 8) * (G / 8) + bx / 8 : bx;
    const int nun = 512 + (need_ctx ? 32 : 0);
    for (int u = vcu; u < nun; u += G) {
        int b, h, qrow0, nkeys;
        if (u < 512) { const int bh = u >> 4, qb = u & 15; b = bh >> 3; h = bh & 7; qrow0 = b * RPB + CTXL + qb * 256; nkeys = RPB; }
        else { const int bh = u - 512; b = bh >> 3; h = bh & 7; qrow0 = b * RPB; nkeys = CTXL; }
        const size_t krow0 = (size_t)b * RPB;
        attn::attn_unit(qp + (size_t)qrow0 * 1536 + h * 192, kv + krow0 * 2048 + h * 256, kr + krow0 * 64, kv + krow0 * 2048 + h * 256 + 128,
                        O + (size_t)qrow0 * 1024 + h * 128, nkeys, lds);
    }
}

constexpr size_t S5_ABAR = 0, S5_A128 = 65536, S5_BFRAG = 131072, S5_CFRAG = 131072 + 1048576;
constexpr int S5_CH = 128, S5_NCH = RPB / S5_CH;
DI f32x2 cmul(f32x2 a, f32x2 b) { return (f32x2){a.x * b.x - a.y * b.y, a.x * b.y + a.y * b.x}; }
DI void s5_prep(const Params& p) {
    const int gt = BIDX() * NTHREADS + TIDX(), ntot = GDIM() * NTHREADS;
    unsigned char* base = p.ws + WS_S5C;
    for (int idx = gt; idx < 2 * 64 * 64; idx += ntot) {
        const int dir = idx >> 12, g = (idx >> 6) & 63, s = idx & 63;
        const float are = IN(p, 15)[idx], aim = IN(p, 16)[idx], dt = expf(IN(p, 17)[dir * 64 + g]);
        float sn, cs; sincosf(aim * dt, &sn, &cs); const float er = expf(are * dt);
        const f32x2 ab = {er * cs, er * sn};
        sincosf(aim * dt * (float)S5_CH, &sn, &cs); const float er2 = expf(are * dt * (float)S5_CH);
        ((f32x2*)(base + S5_ABAR))[idx] = ab; ((f32x2*)(base + S5_A128))[idx] = (f32x2){er2 * cs, er2 * sn};
    }
    for (int idx = gt; idx < 2 * 64 * 8 * 64; idx += ntot) {
        const int lane = idx & 63, blk = (idx >> 6) & 7, g = (idx >> 9) & 63, dir = idx >> 15;
        const int kp = 16 * blk + (lane & 15), q = lane >> 4, s = kp >> 1;
        u32x4 w = {0, 0, 0, 0};
        if (q < 2) {
            const int ai = (dir * 64 + g) * 64 + s;
            const float are = IN(p, 15)[ai], aim = IN(p, 16)[ai], dt = expf(IN(p, 17)[dir * 64 + g]);
            float sn, cs; sincosf(aim * dt, &sn, &cs); const float er = expf(are * dt);
            const f32x2 num = {er * cs - 1.f, er * sn}; const float den = are * are + aim * aim;
            const f32x2 coef = {(num.x * are + num.y * aim) / den, (num.y * are - num.x * aim) / den};
            float vals[8];
#pragma unroll
            for (int jj = 0; jj < 8; ++jj) { const int i = 8 * q + jj; const size_t bi = ((size_t)(dir * 64 + g) * 64 + s) * 16 + i;
                const f32x2 bb = cmul(coef, (f32x2){IN(p, 18)[bi], IN(p, 19)[bi]}); vals[jj] = (kp & 1) == 0 ? bb.x : bb.y; }
            w = (u32x4){pk2(vals[0], vals[1]), pk2(vals[2], vals[3]), pk2(vals[4], vals[5]), pk2(vals[6], vals[7])};
        }
        ((u32x4*)(base + S5_BFRAG))[idx] = w;
    }
    for (int idx = gt; idx < 2 * 64 * 4 * 64; idx += ntot) {
        const int lane = idx & 63, ks = (idx >> 6) & 3, g = (idx >> 8) & 63, dir = idx >> 14;
        const int i = lane & 15, q = lane >> 4; float vals[8];
#pragma unroll
        for (int jj = 0; jj < 8; ++jj) { const int kp = 32 * ks + 8 * q + jj, s = kp >> 1; const size_t ci = ((size_t)(dir * 64 + g) * 16 + i) * 64 + s;
            vals[jj] = (kp & 1) == 0 ? IN(p, 20)[ci] : -IN(p, 21)[ci]; }
        ((u32x4*)(base + S5_CFRAG))[idx] = (u32x4){pk2(vals[0], vals[1]), pk2(vals[2], vals[3]), pk2(vals[4], vals[5]), pk2(vals[6], vals[7])};
    }
}
constexpr int S5_L1S = 132, S5_L2S = 136, S5_WLDS = 12800;
template <bool PROJ, bool REV>
DI void s5_sub(const bf16x8 uf, const bf16x8 (&bf)[8], const bf16x8 (&cf)[4], f32x2 ab, f32x2& st, f32x4& yacc, char* wl, int lane) {
    float* L1 = (float*)wl; bf16_t* L2 = (bf16_t*)(wl + 8448);
    const int t = lane & 15, q = lane >> 4;
    const float zf = ZF(); const f32x4 zero4 = {zf, zf, zf, zf};
    LDS_FENCE();
#pragma unroll
    for (int blk = 0; blk < 8; ++blk) {
        const f32x4 d = __builtin_amdgcn_mfma_f32_16x16x32_bf16(bf[blk], uf, zero4, 0, 0, 0);
        *(f32x4*)(L1 + t * S5_L1S + 16 * blk + 4 * q) = d;
    }
    LDS_FENCE();
    f32x2 bu[16];
#pragma unroll
    for (int s = 0; s < 16; ++s) bu[s] = *(const f32x2*)(L1 + s * S5_L1S + 2 * lane);
#pragma unroll
    for (int s = 0; s < 16; ++s) {
        const int tt = REV ? 15 - s : s;
        const f32x2 b_ = bu[tt];
        const f32x2 n = {ab.x * st.x - ab.y * st.y + b_.x, ab.x * st.y + ab.y * st.x + b_.y};
        st = n;
        if (PROJ) ((unsigned*)L2)[tt * (S5_L2S / 2) + lane] = pk2(n.x, n.y);
    }
    if (PROJ) {
        LDS_FENCE();
#pragma unroll
        for (int ks = 0; ks < 4; ++ks) {
            const bf16x8 sf = *(const bf16x8*)(L2 + t * S5_L2S + 32 * ks + 8 * q);
            yacc = __builtin_amdgcn_mfma_f32_16x16x32_bf16(sf, cf[ks], yacc, 0, 0, 0);
        }
    }
}
DI void s5_load_frags(const Params& p, int dir, int g, int lane, bf16x8 (&bf)[8], bf16x8 (&cf)[4], f32x2& ab, f32x2& a128) {
    const unsigned char* base = p.ws + WS_S5C;
#pragma unroll
    for (int blk = 0; blk < 8; ++blk) bf[blk] = ((const bf16x8*)(base + S5_BFRAG))[((dir * 64 + g) * 8 + blk) * 64 + lane];
#pragma unroll
    for (int ks = 0; ks < 4; ++ks) cf[ks] = ((const bf16x8*)(base + S5_CFRAG))[((dir * 64 + g) * 4 + ks) * 64 + lane];
    ab = ((const f32x2*)(base + S5_ABAR))[(dir * 64 + g) * 64 + lane]; a128 = ((const f32x2*)(base + S5_A128))[(dir * 64 + g) * 64 + lane];
}
DI void s5_load_u(const bf16_t* h, int row0, int g, int lane, bf16x8 (&uf)[8]) {
    const int t = lane & 15, q = lane >> 4;
#pragma unroll
    for (int sb = 0; sb < 8; ++sb) { uf[sb] = (bf16x8){0, 0, 0, 0, 0, 0, 0, 0}; if (q < 2) uf[sb] = *(const bf16x8*)(h + (size_t)(row0 + 16 * sb + t) * DM + 16 * g + 8 * q); }
}
DI void s5_pass1(const Params& p, char* lds) {
    const int lane = TIDX() & 63, wave = TIDX() >> 6, gw = BIDX() * NWAVES + wave, nw = GDIM() * NWAVES;
    char* wl = lds + wave * S5_WLDS;
    const bf16_t* h = (const bf16_t*)(p.ws + WS_H);
    f32x2* E = (f32x2*)(p.ws + WS_T + T_S5E);
    for (int task = gw; task < NB * S5_NCH * 64; task += nw) {
        const int g = task & 63, bc = task >> 6, c = bc % S5_NCH, b = bc / S5_NCH;
        const int row0 = b * RPB + c * S5_CH;
        bf16x8 uf[8]; s5_load_u(h, row0, g, lane, uf);
        for (int dir = 0; dir < 2; ++dir) {
            bf16x8 bf[8], cf[4]; f32x2 ab, a128; s5_load_frags(p, dir, g, lane, bf, cf, ab, a128);
            f32x2 st = {0.f, 0.f}; f32x4 dummy = {0, 0, 0, 0};
            if (dir == 0) {
#pragma unroll
                for (int sb = 0; sb < 8; ++sb) s5_sub<false, false>(uf[sb], bf, cf, ab, st, dummy, wl, lane);
            } else {
#pragma unroll
                for (int sb = 0; sb < 8; ++sb) s5_sub<false, true>(uf[7 - sb], bf, cf, ab, st, dummy, wl, lane);
            }
            E[(((size_t)(b * 64 + g) * 2 + dir) * S5_NCH + c) * 64 + lane] = st;
        }
    }
}
template <int DIR> DI void s5_chain(const f32x2* Eb, f32x2* Sb, f32x2 a128) {
    f32x2 e[S5_NCH];
#pragma unroll
    for (int k = 0; k < S5_NCH; ++k) e[k] = Eb[k * 64];
    float zz = 0.f; asm volatile("" : "+v"(zz));
    f32x2 st = {zz, zz};
#pragma unroll
    for (int k = 0; k < S5_NCH; ++k) {
        const int c = DIR == 0 ? k : (k < 2 ? 1 - k : S5_NCH + 1 - k);
        Sb[c * 64] = st;
        st = cmul(a128, st); st.x += e[c].x; st.y += e[c].y;
    }
}
DI void s5_carry(const Params& p) {
    const int lane = TIDX() & 63, gw = BIDX() * NWAVES + (TIDX() >> 6), nw = GDIM() * NWAVES;
    for (int w = gw; w < NB * 64 * 2; w += nw) {
        const int dir = w & 1, g = (w >> 1) & 63;
        const f32x2 a128 = ((const f32x2*)(p.ws + WS_S5C + S5_A128))[(dir * 64 + g) * 64 + lane];
        const f32x2* Eb = (const f32x2*)(p.ws + WS_T + T_S5E) + (size_t)w * S5_NCH * 64 + lane;
        f32x2* Sb = (f32x2*)(p.ws + WS_T + T_S5S) + (size_t)w * S5_NCH * 64 + lane;
        if (dir == 0) s5_chain<0>(Eb, Sb, a128); else s5_chain<1>(Eb, Sb, a128);
    }
}
DI void s5_pass3(const Params& p, int j, bool latonly, char* lds) {
    const int lane = TIDX() & 63, wave = TIDX() >> 6, gw = BIDX() * NWAVES + wave, nw = GDIM() * NWAVES;
    char* wl = lds + wave * S5_WLDS;
    const bf16_t* h = (const bf16_t*)(p.ws + WS_H);
    const f32x2* S = (const f32x2*)(p.ws + WS_T + T_S5S);
    bf16_t* z = (bf16_t*)(p.ws + WS_T + T_Z);
    const float* dd = IN(p, 22) + j * 1024;
    for (int task = gw; task < NB * S5_NCH * 64; task += nw) {
        const int g = task & 63, bc = task >> 6, c = bc % S5_NCH, b = bc / S5_NCH;
        if (latonly && c < 2) continue;
        const int row0 = b * RPB + c * S5_CH;
        bf16x8 uf[8]; s5_load_u(h, row0, g, lane, uf);
        f32x4 yacc[8];
#pragma unroll
        for (int i = 0; i < 8; ++i) { const float z = ZF(); yacc[i] = (f32x4){z, z, z, z}; }
        for (int dir = 0; dir < 2; ++dir) {
            bf16x8 bf[8], cf[4]; f32x2 ab, a128; s5_load_frags(p, dir, g, lane, bf, cf, ab, a128);
            f32x2 st = S[(((size_t)(b * 64 + g) * 2 + dir) * S5_NCH + c) * 64 + lane];
            if (dir == 0) {
#pragma unroll
                for (int sb = 0; sb < 8; ++sb) s5_sub<true, false>(uf[sb], bf, cf, ab, st, yacc[sb], wl, lane);
            } else {
#pragma unroll
                for (int sb = 0; sb < 8; ++sb) s5_sub<true, true>(uf[7 - sb], bf, cf, ab, st, yacc[7 - sb], wl, lane);
            }
        }
        const int i = lane & 15, q = lane >> 4; const float dv = dd[16 * g + i];
#pragma unroll
        for (int sb = 0; sb < 8; ++sb)
#pragma unroll
            for (int r = 0; r < 4; ++r) {
                const size_t off = (size_t)(row0 + 16 * sb + 4 * q + r) * DM + 16 * g + i;
                const float y = bf2f(h[off]) * dv + yacc[sb][r];
                z[off] = (bf16_t)f2bf(gelu_tanh(y));
            }
    }
}


#ifndef S5_PROBE
#define S5_PROBE 0
#endif
#ifndef S5_REPS
#define S5_REPS 1
#endif
namespace s5v2 {
constexpr size_t C_APOW = 0, C_A128 = 589824, C_COEF = C_A128 + 65536;
constexpr size_t T_XS = 40 * MiB;
constexpr int L_WE = 0, L_CA = 0, L_TEND = 69632, L_CARRY = 69632  , L_BBAR = 69632  , L_KP = 104448, L_PW = 120832, L_APOW = 137216, L_C = 146432, RS = 136;
DI f32x2 cexp_(float re, float im) { float sn, cs; sincosf(im, &sn, &cs); const float e = expf(re); return (f32x2){e * cs, e * sn}; }
DI void prep(const Params& p) {
    const int gt = BIDX() * NTHREADS + TIDX(), ntot = GDIM() * NTHREADS;
    unsigned char* base = p.ws + WS_S5C;
    for (int idx = gt; idx < 2 * 64 * 64; idx += ntot) {
        const int dg = idx >> 6, s = idx & 63;
        const float are = IN(p, 15)[idx], aim = IN(p, 16)[idx], dt = expf(IN(p, 17)[dg]);
        for (int e = 0; e < 9; ++e) ((f32x2*)(base + C_APOW))[(dg * 9 + e) * 64 + s] = cexp_(are * dt * (float)e, aim * dt * (float)e);
        ((f32x2*)(base + C_A128))[idx] = cexp_(are * dt * 128.f, aim * dt * 128.f);
        const f32x2 ab = cexp_(are * dt, aim * dt); const f32x2 num = {ab.x - 1.f, ab.y}; const float den = are * are + aim * aim;
        ((f32x2*)(base + C_COEF))[idx] = (f32x2){(num.x * are + num.y * aim) / den, (num.y * are - num.x * aim) / den};
    }
}
template <int CTRL> DI float dppf(float v) { return __int_as_float(__builtin_amdgcn_update_dpp(0, __float_as_int(v), CTRL, 0xf, 0xf, false)); }
template <int DIR, int D> DI void scan_step(f32x4 (&e)[8], const char* lds, int q) {
    constexpr int CTRL = (DIR == 0 ? 0x110 : 0x100) + D;
    const f32x4* mk = (const f32x4*)(lds + L_PW) + (DIR * 16 + D) * 32;
#pragma unroll
    for (int blk = 0; blk < 8; ++blk) {
        const f32x4 m = mk[4 * blk + q];
        f32x4 sh; sh[0] = dppf<CTRL>(e[blk][0]); sh[1] = dppf<CTRL>(e[blk][1]); sh[2] = dppf<CTRL>(e[blk][2]); sh[3] = dppf<CTRL>(e[blk][3]);
        e[blk][0] += m[0] * sh[0] - m[1] * sh[1]; e[blk][1] += m[0] * sh[1] + m[1] * sh[0];
        e[blk][2] += m[2] * sh[2] - m[3] * sh[3]; e[blk][3] += m[2] * sh[3] + m[3] * sh[2];
    }
}
template <int DIR> DI void tile_stage1(const Params& p, int wgi, int g, int J, const bf16x8 (&uf)[4], char* lds, int lane) {
    const int n = lane & 15, q = lane >> 4;
    f32x4 e[8];
#pragma unroll
    for (int blk = 0; blk < 8; ++blk) { const float z = ZF(); e[blk] = (f32x4){z, z, z, z}; }
    const bf16_t* WE = (const bf16_t*)(lds + L_WE) + DIR * 128 * RS;
#pragma unroll
    for (int ks = 0; ks < 4; ++ks) {
        bf16x8 af[8];
#pragma unroll
        for (int blk = 0; blk < 8; ++blk) af[blk] = *(const bf16x8*)(WE + (16 * blk + n) * RS + 32 * ks + 8 * q);
        __builtin_amdgcn_sched_barrier(0);
#pragma unroll
        for (int blk = 0; blk < 8; ++blk) e[blk] = __builtin_amdgcn_mfma_f32_16x16x32_bf16(af[blk], uf[ks], e[blk], 0, 0, 0);
        __builtin_amdgcn_sched_barrier(0);
    }
    scan_step<DIR, 1>(e, lds, q); scan_step<DIR, 2>(e, lds, q); scan_step<DIR, 4>(e, lds, q); scan_step<DIR, 8>(e, lds, q);
    if (n == (DIR == 0 ? 15 : 0)) {
        float* te = (float*)(lds + L_TEND) + (DIR * 34 + J) * 128;
#pragma unroll
        for (int blk = 0; blk < 8; ++blk) *(f32x4*)(te + 16 * blk + 4 * q) = e[blk];
    }
    u32x4* xs = (u32x4*)(p.ws + WS_T + T_XS) + ((size_t)((wgi * 2 + DIR) * 34 + J) * 4) * 64 + lane;
    constexpr int C1 = (DIR == 0 ? 0x110 : 0x100) + 1;
#pragma unroll
    for (int ks = 0; ks < 4; ++ks) {
        u32x4 w;
#pragma unroll
        for (int hh = 0; hh < 2; ++hh) { const f32x4 v = e[2 * ks + hh];
            w[2 * hh] = pk2(dppf<C1>(v[0]), dppf<C1>(v[1])); w[2 * hh + 1] = pk2(dppf<C1>(v[2]), dppf<C1>(v[3])); }
        xs[ks * 64] = w;
    }
}
DI void load_u(const bf16_t* h, int row0, int g, int lane, bf16x8 (&uf)[4]) {
    const int n = lane & 15, q = lane >> 4;
#pragma unroll
    for (int ks = 0; ks < 4; ++ks) uf[ks] = *(const bf16x8*)(h + (size_t)(row0 + 8 * n + 2 * ks + (q >> 1)) * DM + 16 * g + 8 * (q & 1));
}
template <int DIR> DI void tile_stage3(const Params& p, int wgi, int J, const bf16x8 (&uf)[4], f32x4 (&Y)[8], char* lds, int lane) {
    const int n = lane & 15, q = lane >> 4;
    const u32x4* xs = (const u32x4*)(p.ws + WS_T + T_XS) + ((size_t)((wgi * 2 + DIR) * 34 + J) * 4) * 64 + lane;
    const f32x4* pw = (const f32x4*)(lds + L_PW) + (DIR * 16 + (DIR == 0 ? n : 15 - n)) * 32;
    const f32x4* cr = (const f32x4*)(lds + L_CARRY) + (DIR * 34 + J) * 32;
    bf16x8 sf[4];
#pragma unroll
    for (int ks = 0; ks < 4; ++ks) {
        const u32x4 xw = xs[ks * 64]; u32x4 w;
#pragma unroll
        for (int hh = 0; hh < 2; ++hh) {
            const int blk = 2 * ks + hh;
            const f32x4 a = pw[4 * blk + q], c = cr[4 * blk + q];
            const float s0 = bflo(xw[2 * hh]) + a[0] * c[0] - a[1] * c[1], s1 = bfhi(xw[2 * hh]) + a[0] * c[1] + a[1] * c[0];
            const float s2 = bflo(xw[2 * hh + 1]) + a[2] * c[2] - a[3] * c[3], s3 = bfhi(xw[2 * hh + 1]) + a[2] * c[3] + a[3] * c[2];
            w[2 * hh] = pk2(s0, s1); w[2 * hh + 1] = pk2(s2, s3);
        }
        sf[ks] = __builtin_bit_cast(bf16x8, w);
    }
    const bf16_t* CA = (const bf16_t*)(lds + L_CA) + DIR * 128 * RS;
    const bf16_t* KP = (const bf16_t*)(lds + L_KP) + DIR * 8 * 512;
#pragma unroll
    for (int t = 0; t < 8; ++t) {
        bf16x8 af[4], kf[4];
#pragma unroll
        for (int ks = 0; ks < 4; ++ks) {
            af[ks] = *(const bf16x8*)(CA + (16 * t + n) * RS + 32 * ks + 8 * q);
            const int idx = DIR == 0 ? t - 2 * ks : 2 * ks + 1 - t;
            if (idx >= 0) kf[ks] = *(const bf16x8*)(KP + idx * 512 + n * 32 + 8 * q);
        }
        __builtin_amdgcn_sched_barrier(0);
#pragma unroll
        for (int ks = 0; ks < 4; ++ks) {
            Y[t] = __builtin_amdgcn_mfma_f32_16x16x32_bf16(af[ks], sf[ks], Y[t], 0, 0, 0);
            const int idx = DIR == 0 ? t - 2 * ks : 2 * ks + 1 - t;
            if (idx >= 0) Y[t] = __builtin_amdgcn_mfma_f32_16x16x32_bf16(kf[ks], uf[ks], Y[t], 0, 0, 0);
        }
        __builtin_amdgcn_sched_barrier(0);
    }
}
DI void phase(const Params& p, int jl, char* lds) {
    const bf16_t* h = (const bf16_t*)(p.ws + WS_H); bf16_t* z = (bf16_t*)(p.ws + WS_T + T_Z);
    const unsigned char* cb = p.ws + WS_S5C;
    for (int wg0 = BIDX(); wg0 < NB * 64; wg0 += GDIM()) {
        const int tid = TIDX(), lane = tid & 63, wave = __builtin_amdgcn_readfirstlane(tid >> 6);
        const int wgi = (GDIM() == NB * 64) ? (wg0 & 7) * 32 + (wg0 >> 3) : wg0;
        const int b = wgi >> 6, g = wgi & 63;
        f32x2* Lap = (f32x2*)(lds + L_APOW); f32x2* Lbb = (f32x2*)(lds + L_BBAR); f32x2* Lc = (f32x2*)(lds + L_C);
        for (int rep3 = 0; rep3 < (S5_PROBE == 3 ? S5_REPS : 1); ++rep3) {
        for (int idx = tid; idx < 2 * 9 * 64; idx += NTHREADS) { const int dir = idx / 576, r = idx - dir * 576; Lap[idx] = ((const f32x2*)(cb + C_APOW))[(dir * 64 + g) * 576 + r]; }
        for (int idx = tid; idx < 2 * 1024; idx += NTHREADS) {
            const int dir = idx >> 10, r = idx & 1023;
            const size_t gi = (size_t)(dir * 64 + g) * 1024 + r;
            Lbb[idx] = cmul(((const f32x2*)(cb + C_COEF))[(dir * 64 + g) * 64 + (r >> 4)], (f32x2){IN(p, 18)[gi], IN(p, 19)[gi]});
            Lc[idx] = (f32x2){IN(p, 20)[gi], IN(p, 21)[gi]};
        }
        __syncthreads();
        for (int idx = tid; idx < 2 * 128 * 64; idx += NTHREADS) {
            const int dir = idx >> 13, kp = (idx >> 6) & 127, c2 = (idx & 63) * 2, pp = kp >> 1, part = kp & 1, t = c2 >> 4, i = c2 & 15;
            const f32x2 ap = Lap[(dir * 9 + (dir == 0 ? 7 - t : t)) * 64 + pp];
            const f32x2 b0 = cmul(ap, Lbb[(dir * 64 + pp) * 16 + i]), b1 = cmul(ap, Lbb[(dir * 64 + pp) * 16 + i + 1]);
            *(unsigned*)((bf16_t*)(lds + L_WE) + (dir * 128 + kp) * RS + c2) = part == 0 ? pk2(b0.x, b1.x) : pk2(b0.y, b1.y);
        }
        {
            const int dir = tid >> 8, ip = (tid >> 4) & 15, i = tid & 15;
            float acc[8];
#pragma unroll
            for (int t = 0; t < 8; ++t) acc[t] = 0.f;
#pragma unroll 4
            for (int pp = 0; pp < 64; ++pp) {
                const f32x2 a1 = Lap[(dir * 9 + 1) * 64 + pp];
                f32x2 w = cmul(Lc[(dir * 16 + ip) * 64 + pp], Lbb[(dir * 64 + pp) * 16 + i]);
#pragma unroll
                for (int t = 0; t < 8; ++t) { acc[t] += w.x; w = cmul(w, a1); }
            }
            bf16_t* KP = (bf16_t*)(lds + L_KP) + dir * 8 * 512;
#pragma unroll
            for (int t = 0; t < 8; ++t) {
                const bf16_t v = (bf16_t)f2bf(acc[t]);
                if (dir == 0) { KP[t * 512 + ip * 32 + i] = v; if (t < 7) KP[(t + 1) * 512 + ip * 32 + 16 + i] = v; }
                else { KP[t * 512 + ip * 32 + 16 + i] = v; if (t < 7) KP[(t + 1) * 512 + ip * 32 + i] = v; }
            }
            if (dir == 0) KP[0 * 512 + ip * 32 + 16 + i] = 0; else KP[0 * 512 + ip * 32 + i] = 0;
            if (tid < 128) {
                const int d2 = tid >> 6, s = tid & 63; const f32x2 a8 = Lap[(d2 * 9 + 8) * 64 + s];
                f32x2 w = {1.f, 0.f}; f32x2* pwt = (f32x2*)(lds + L_PW) + d2 * 16 * 64 + s;
#pragma unroll 1
                for (int nn = 0; nn < 16; ++nn) { pwt[nn * 64] = w; w = cmul(w, a8); }
            }
        }
        __syncthreads();
        }
        for (int rep = 0; rep < (S5_PROBE == 1 ? S5_REPS : 1); ++rep)
        for (int J = wave; J < 34; J += NWAVES) {
            const int ln = TIDX() & 63;
            bf16x8 uf[4]; load_u(h, b * RPB + 128 * J, g, ln, uf);
            tile_stage1<0>(p, wgi, g, J, uf, lds, ln);
            __builtin_amdgcn_sched_barrier(0);
            tile_stage1<1>(p, wgi, g, J, uf, lds, ln);
            __builtin_amdgcn_sched_barrier(0);
        }
        __syncthreads();
        if (wave < 2) {
            const int dir = wave;
            const f32x2 a128 = ((const f32x2*)(cb + C_A128))[(dir * 64 + g) * 64 + lane];
            f32x2* cr = (f32x2*)(lds + L_CARRY) + dir * 34 * 64 + lane;
            float zz = ZF(); f32x2 c = {zz, zz};
#pragma unroll 1
            for (int k = 0; k < 34; ++k) { const int J = dir == 0 ? k : (k < 2 ? 1 - k : 35 - k); const f32x2 e = cr[J * 64]; cr[J * 64] = c; c = cmul(a128, c); c.x += e.x; c.y += e.y; }
        } else {
            for (int idx = tid - 128; idx < 2 * 128 * 64; idx += NTHREADS - 128) {
                const int dir = idx >> 13, r = (idx >> 6) & 127, kpos = (idx & 63) * 2, t = r >> 4, ip = r & 15;
                const int ks = kpos >> 5, q = (kpos >> 3) & 3, jj = kpos & 7, kk = 32 * ks + 16 * (jj >> 2) + 4 * q + (jj & 3), pp = kk >> 1;
                const f32x2 cc = cmul(Lc[(dir * 16 + ip) * 64 + pp], Lap[(dir * 9 + (dir == 0 ? t + 1 : 8 - t)) * 64 + pp]);
                *(unsigned*)((bf16_t*)(lds + L_CA) + (dir * 128 + r) * RS + kpos) = pk2(cc.x, -cc.y);
            }
        }
        __syncthreads();
        const float* dd = IN(p, 22) + jl * 1024;
        for (int rep = 0; rep < (S5_PROBE == 2 ? S5_REPS : 1); ++rep)
        for (int J = wave; J < 34; J += NWAVES) {
            const int lane = TIDX() & 63;
            const int row0 = b * RPB + 128 * J;
            bf16x8 uf[4]; load_u(h, row0, g, lane, uf);
            f32x4 Y[8];
#pragma unroll
            for (int t = 0; t < 8; ++t) { const float zf = ZF(); Y[t] = (f32x4){zf, zf, zf, zf}; }
            tile_stage3<0>(p, wgi, J, uf, Y, lds, lane);
            __builtin_amdgcn_sched_barrier(0);
            tile_stage3<1>(p, wgi, J, uf, Y, lds, lane);
            __builtin_amdgcn_sched_barrier(0);
            const int n = lane & 15, q = lane >> 4; const f32x4 dv = *(const f32x4*)(dd + 16 * g + 4 * q);
#pragma unroll
            for (int t = 0; t < 8; ++t) {
                const size_t off = (size_t)(row0 + 8 * n + t) * DM + 16 * g + 4 * q;
                const u32x2 hw = *(const u32x2*)(h + off);
                const float y0 = bflo(hw[0]) * dv[0] + Y[t][0], y1 = bfhi(hw[0]) * dv[1] + Y[t][1], y2 = bflo(hw[1]) * dv[2] + Y[t][2], y3 = bfhi(hw[1]) * dv[3] + Y[t][3];
                u32x2 w = {pk2(gelu_tanh(y0), gelu_tanh(y1)), pk2(gelu_tanh(y2), gelu_tanh(y3))};
                *(u32x2*)(z + off) = w;
            }
        }
        __syncthreads();
    }
}
}

DI void lru_conv(const Params& p, int j) {
    const int lane = TIDX() & 63, gw = BIDX() * NWAVES + (TIDX() >> 6), nw = GDIM() * NWAVES;
    const bf16_t* xp = (const bf16_t*)(p.ws + WS_T + T_XPRE); bf16_t* xr = (bf16_t*)(p.ws + WS_T + T_XR);
    const float* cw = IN(p, 25) + j * 4 * LRUW; const float* cb = IN(p, 26) + j * LRUW;
    for (int row = gw; row < MROWS; row += nw) {
        const int b = row / RPB, rb = row - b * RPB; const bool isctx = rb < CTXL;
        const int t = isctx ? rb : rb - CTXL, L = isctx ? CTXL : SEQ;
        for (int cc = lane * 4; cc < LRUW; cc += 256) {
            f32x4 acc = *(const f32x4*)(cb + cc);
#pragma unroll
            for (int k = 0; k < 4; ++k) { const int tt = t + k - 1; if (tt < 0 || tt >= L) continue;
                const u32x2 w = *(const u32x2*)(xp + (size_t)(row + k - 1) * LRUW + cc); const f32x4 wk = *(const f32x4*)(cw + k * LRUW + cc);
                acc[0] += wk[0] * bflo(w[0]); acc[1] += wk[1] * bfhi(w[0]); acc[2] += wk[2] * bflo(w[1]); acc[3] += wk[3] * bfhi(w[1]); }
            u32x2 o = {pk2(acc[0], acc[1]), pk2(acc[2], acc[3])};
            *(u32x2*)(xr + (size_t)row * LRUW + cc) = o;
        }
    }
}
constexpr int LR_CH = 64, LR_NCH = RPB / LR_CH;
DI int lr_chain_chunk(int dir, int k) { return dir == 0 ? k : (k < 4 ? 3 - k : 71 - k); }
DI int lr_chain_pos(int dir, int c) { return dir == 0 ? c : (c < 4 ? 3 - c : 71 - c); }
DI void lru_pass1(const Params& p) {
    const int gt = BIDX() * NTHREADS + TIDX(), ntot = GDIM() * NTHREADS;
    float* P = (float*)(p.ws + WS_T + T_LP); float* E = (float*)(p.ws + WS_T + T_LE);
    for (int it = gt; it < NB * 2 * LR_NCH * 160; it += ntot) {
        const int c8 = it % 160, r1 = it / 160, c = r1 % LR_NCH, r2 = r1 / LR_NCH, dir = r2 & 1, b = r2 >> 1;
        const bf16_t* la = (const bf16_t*)(p.ws + WS_T + T_LA + dir * LRU_DIRSTRIDE) + (size_t)(b * RPB + c * LR_CH) * LRUW + c8 * 8;
        const bf16_t* bb = (const bf16_t*)(p.ws + WS_T + T_BB + dir * LRU_DIRSTRIDE) + (size_t)(b * RPB + c * LR_CH) * LRUW + c8 * 8;
        float s[8], ps[8];
#pragma unroll
        for (int e = 0; e < 8; ++e) { s[e] = 0.f; ps[e] = 0.f; }
        for (int k0 = 0; k0 < LR_CH; k0 += 8) {
            u32x4 lw[8], bw[8];
#pragma unroll
            for (int u = 0; u < 8; ++u) { const int t = dir ? LR_CH - 1 - (k0 + u) : k0 + u; lw[u] = *(const u32x4*)(la + (size_t)t * LRUW); bw[u] = *(const u32x4*)(bb + (size_t)t * LRUW); }
#pragma unroll
            for (int u = 0; u < 8; ++u)
#pragma unroll
                for (int e = 0; e < 4; ++e) {
                    const float l0 = bflo(lw[u][e]), l1 = bfhi(lw[u][e]);
                    ps[2 * e] += l0; ps[2 * e + 1] += l1;
                    s[2 * e] = __expf(l0) * s[2 * e] + bflo(bw[u][e]); s[2 * e + 1] = __expf(l1) * s[2 * e + 1] + bfhi(bw[u][e]);
                }
        }
        const size_t o = ((size_t)((b * 2 + dir) * LR_NCH + c)) * LRUW + c8 * 8;
        *(f32x4*)(P + o) = (f32x4){ps[0], ps[1], ps[2], ps[3]}; *(f32x4*)(P + o + 4) = (f32x4){ps[4], ps[5], ps[6], ps[7]};
        *(f32x4*)(E + o) = (f32x4){s[0], s[1], s[2], s[3]}; *(f32x4*)(E + o + 4) = (f32x4){s[4], s[5], s[6], s[7]};
    }
}
DI void lru_carry(const Params& p) {
    const int gt = BIDX() * NTHREADS + TIDX(), ntot = GDIM() * NTHREADS;
    const float* P = (const float*)(p.ws + WS_T + T_LP); const float* E = (const float*)(p.ws + WS_T + T_LE); float* S = (float*)(p.ws + WS_T + T_LS);
    for (int it = gt; it < NB * 2 * LRUW; it += ntot) {
        const int ch = it % LRUW, bd = it / LRUW, dir = bd & 1;
        const size_t base = (size_t)bd * LR_NCH * LRUW + ch;
        float s = 0.f;
        for (int k0 = 0; k0 < LR_NCH; k0 += 17) {
            float pv[17], ev[17];
#pragma unroll
            for (int u = 0; u < 17; ++u) { const size_t o = base + (size_t)lr_chain_chunk(dir, k0 + u) * LRUW; pv[u] = P[o]; ev[u] = E[o]; }
#pragma unroll
            for (int u = 0; u < 17; ++u) { S[base + (size_t)lr_chain_chunk(dir, k0 + u) * LRUW] = s; s = __expf(pv[u]) * s + ev[u]; }
        }
    }
}
DI void lru_pass3(const Params& p, bool latonly) {
    const int gt = BIDX() * NTHREADS + TIDX(), ntot = GDIM() * NTHREADS;
    const float* S = (const float*)(p.ws + WS_T + T_LS);
    const bf16_t* gx = (const bf16_t*)(p.ws + WS_T + T_GX); bf16_t* gh = (bf16_t*)(p.ws + WS_T + T_GH);
    for (int it = gt; it < NB * LR_NCH * 640; it += ntot) {
        const int c2 = it % 640, r1 = it / 640, c = r1 % LR_NCH, b = r1 / LR_NCH;
        if (latonly && c < 4) continue;
        const size_t rowoff = (size_t)(b * RPB + c * LR_CH) * LRUW + c2 * 2;
        f32x2 fw[LR_CH];
        {
            const size_t o = ((size_t)((b * 2 + 0) * LR_NCH + c)) * LRUW + c2 * 2;
            f32x2 s = *(const f32x2*)(S + o);
            const bf16_t* la = (const bf16_t*)(p.ws + WS_T + T_LA) + rowoff; const bf16_t* bb = (const bf16_t*)(p.ws + WS_T + T_BB) + rowoff;
#pragma unroll
            for (int k0 = 0; k0 < LR_CH; k0 += 16) {
                unsigned lw[16], bw[16];
#pragma unroll
                for (int u = 0; u < 16; ++u) { lw[u] = *(const unsigned*)(la + (size_t)(k0 + u) * LRUW); bw[u] = *(const unsigned*)(bb + (size_t)(k0 + u) * LRUW); }
#pragma unroll
                for (int u = 0; u < 16; ++u) { s.x = __expf(bflo(lw[u])) * s.x + bflo(bw[u]); s.y = __expf(bfhi(lw[u])) * s.y + bfhi(bw[u]); fw[k0 + u] = s; }
            }
        }
        {
            const size_t o = ((size_t)((b * 2 + 1) * LR_NCH + c)) * LRUW + c2 * 2;
            f32x2 s = *(const f32x2*)(S + o);
            const bf16_t* la = (const bf16_t*)(p.ws + WS_T + T_LA + LRU_DIRSTRIDE) + rowoff; const bf16_t* bb = (const bf16_t*)(p.ws + WS_T + T_BB + LRU_DIRSTRIDE) + rowoff;
#pragma unroll
            for (int k0 = 0; k0 < LR_CH; k0 += 16) {
                unsigned lw[16], bw[16], gw_[16];
#pragma unroll
                for (int u = 0; u < 16; ++u) { const int t = LR_CH - 1 - (k0 + u); lw[u] = *(const unsigned*)(la + (size_t)t * LRUW); bw[u] = *(const unsigned*)(bb + (size_t)t * LRUW); gw_[u] = *(const unsigned*)(gx + rowoff + (size_t)t * LRUW); }
#pragma unroll
                for (int u = 0; u < 16; ++u) { const int t = LR_CH - 1 - (k0 + u);
                    s.x = __expf(bflo(lw[u])) * s.x + bflo(bw[u]); s.y = __expf(bfhi(lw[u])) * s.y + bfhi(bw[u]);
                    *(unsigned*)(gh + rowoff + (size_t)t * LRUW) = pk2(bflo(gw_[u]) * (fw[t].x + s.x), bfhi(gw_[u]) * (fw[t].y + s.y)); }
            }
        }
    }
}

#define XB_TMO      128
#define XB_XCNT(j)  (256  + 64 * (j))
#define XB_XSUB(j)  (1280 + 64 * (j))
#define XB_XGEN(j)  (2304 + 64 * (j))
#define XB_TOP      3328
#define XB_TOPGEN   3392
#define XCD_BAR_WORDS 3456
#define XB_SPIN_CAP (1u << 24)
DI unsigned xb_ld(unsigned* p)              { return __hip_atomic_load(p, __ATOMIC_RELAXED, __HIP_MEMORY_SCOPE_AGENT); }
DI unsigned xb_add(unsigned* p, unsigned v) { return __hip_atomic_fetch_add(p, v, __ATOMIC_RELAXED, __HIP_MEMORY_SCOPE_AGENT); }
DI unsigned xb_xcc_id() { return (unsigned)__builtin_amdgcn_s_getreg((3 << 11) | 20) & 0xFu; }
#define XB_SPIN(cond, bar) do { unsigned _sp = 0; while (cond) { __builtin_amdgcn_s_sleep(1); \
    if ((++_sp & 255u) == 0u) { if (xb_ld(&(bar)[XB_TMO])) break; if (_sp > XB_SPIN_CAP) { atomicAdd(&(bar)[XB_TMO], 1u); break; } } } } while (0)
struct XcdBarrier { unsigned* bar; unsigned x; volatile LAS unsigned* st; };
DI XcdBarrier xcd_barrier_post(unsigned* bar, volatile LAS unsigned* st) {
    XcdBarrier b; b.bar = bar; b.x = xb_xcc_id(); b.st = st;
    if (threadIdx.x == 0) (void)xb_add(&bar[XB_XCNT(b.x)], 1u);
    return b;
}
DI void xcd_barrier_complete(unsigned* bar, unsigned x, unsigned& nloc, unsigned& nx) {
    const unsigned G = gridDim.x * gridDim.y * gridDim.z;
    unsigned sum, cnt, mine, sp = 0u;
    for (;;) {
        sum = 0u; cnt = 0u; mine = 0u;
#pragma unroll
        for (unsigned j = 0; j < 16; ++j) { const unsigned c = xb_ld(&bar[XB_XCNT(j)]); sum += c; cnt += (c > 0u) ? 1u : 0u; mine = (j == x) ? c : mine; }
        if (sum == G) break;
        __builtin_amdgcn_s_sleep(1);
        if ((++sp & 255u) == 0u) { if (xb_ld(&bar[XB_TMO])) break; if (sp > XB_SPIN_CAP) { atomicAdd(&bar[XB_TMO], 1u); break; } }
    }
    nloc = mine > 0u ? mine : 1u; nx = cnt > 0u ? cnt : 1u;
}
DI void xcd_barrier(const XcdBarrier& b) {
    asm volatile("s_waitcnt vmcnt(0)" ::: "memory");
    __syncthreads();
    if (threadIdx.x == 0) {
        unsigned* bar = b.bar;
        __builtin_amdgcn_s_waitcnt(0);
        unsigned nloc = b.st[0], nx = b.st[1];
        if (nloc == 0u) { xcd_barrier_complete(bar, b.x, nloc, nx); b.st[0] = nloc; b.st[1] = nx; }
        const unsigned old = xb_add(&bar[XB_XSUB(b.x)], 1u);
        const unsigned gen = old / nloc;
        if (old + 1u == (gen + 1u) * nloc) {
            __builtin_amdgcn_fence(__ATOMIC_RELEASE, "agent");
            asm volatile("s_waitcnt vmcnt(0)" ::: "memory");
            const unsigned og = xb_add(&bar[XB_TOP], 1u);
            const unsigned tg = og / nx;
            if (og + 1u == (tg + 1u) * nx) xb_add(&bar[XB_TOPGEN], 1u);
            else XB_SPIN(xb_ld(&bar[XB_TOPGEN]) == tg, bar);
            __builtin_amdgcn_fence(__ATOMIC_ACQUIRE, "agent");
            xb_add(&bar[XB_XGEN(b.x)], 1u);
            asm volatile("s_waitcnt vmcnt(0)" ::: "memory");
        } else {
            XB_SPIN(xb_ld(&bar[XB_XGEN(b.x)]) == gen, bar);
            __builtin_amdgcn_fence(__ATOMIC_ACQUIRE, "agent");
            asm volatile("s_waitcnt vmcnt(0)" ::: "memory");
        }
    }
    __syncthreads();
}

enum { ST_INIT = 0, ST_NORM0, ST_NORM1, ST_GEMM, ST_A3, ST_A5, ST_ATTN, ST_S5P1, ST_S5P3, ST_CONV, ST_LRU1, ST_LRU3, ST_S5C, ST_LRUC, ST_S5 };
enum { G_DQKV = 0, G_UQ, G_UKV, G_WO, G_GLU, G_WX, G_WG, G_GATES, G_WOUT, G_W1, G_W2 };
struct Step { unsigned char type, layer, gid, ng; };
#define MLA_STEPS(L) {ST_NORM0, L, 0, 0}, {ST_GEMM, L, G_DQKV, 1}, {ST_GEMM, L, G_UQ, 2}, {ST_ATTN, L, 0, 0}, {ST_GEMM, L, G_WO, 1}, \
                     {ST_NORM1, L, 0, 0}, {ST_GEMM, L, G_W1, 1}, {ST_GEMM, L, G_W2, 1}
#define S5_STEPS(L)  {ST_NORM0, L, 0, 0}, {ST_S5, L, 0, 0}, {ST_GEMM, L, G_GLU, 1}, {ST_NORM1, L, 0, 0}, {ST_GEMM, L, G_W1, 1}, {ST_GEMM, L, G_W2, 1}
#define LRU_STEPS(L) {ST_NORM0, L, 0, 0}, {ST_GEMM, L, G_WX, 2}, {ST_CONV, L, 0, 0}, {ST_GEMM, L, G_GATES, 1}, {ST_LRU1, L, 0, 0}, {ST_LRUC, L, 0, 0}, {ST_LRU3, L, 0, 0}, {ST_GEMM, L, G_WOUT, 1}, \
                     {ST_NORM1, L, 0, 0}, {ST_GEMM, L, G_W1, 1}, {ST_GEMM, L, G_W2, 1}
__constant__ Step PROGRAM[] = { {ST_INIT, 0, 0, 0}, MLA_STEPS(0), S5_STEPS(1), LRU_STEPS(2), MLA_STEPS(3) };
constexpr int NSTEPS = 1 + 8 + 6 + 11 + 8;

#ifndef PROBE_MASK
#define PROBE_MASK 0
#endif
#ifndef PROBE_GMASK
#define PROBE_GMASK 0
#endif
#ifndef PROBE_REPS
#define PROBE_REPS 2
#endif
DI GemmD make_gemm(const Params& p, int gid, int layer, bool dry) {
    unsigned char* ws = p.ws; unsigned char* T = ws + WS_T; unsigned char* wm = ws + WS_WMIX;
    const bf16_t* H = (const bf16_t*)(ws + WS_H); const float* modv = (const float*)(ws + WS_MOD);
    const int lo = layer < 3 ? 0 : 1, j = layer / 3;
    GemmD g; g.koff_shift = 30; g.koff_mul = 0; g.out = nullptr; g.ldc = 0; g.gate = modv; g.gate_off = 2 * 1024; g.layer = layer; g.aux0 = nullptr; g.aux1 = nullptr; g.aux2 = nullptr; g.out2 = nullptr; g.latonly = lo; g.rev = 0; g.splitk = 0; g.slab = nullptr; g.res_x = nullptr;
    switch (gid) {
        case G_DQKV: g.A = H; g.lda = 1024; g.Bt = (const bf16_t*)(wm + WM_D); g.ldb = 1024; g.K = 1024; g.nN = 3; g.latonly = 0; g.kind = EPI_DQKV; g.aux0 = IN(p, 11) + j * 256; g.aux1 = IN(p, 13) + j * 384 + 192 + 128; break;
        case G_UQ: g.A = (const bf16_t*)(T + T_CQ); g.lda = 384; g.Bt = (const bf16_t*)(wm + WM_UQ); g.ldb = 384; g.K = 384; g.nN = 6; g.kind = EPI_QN; g.out = T + T_QPRE; g.ldc = 1536; g.aux0 = IN(p, 13) + j * 384; break;
        case G_UKV: g.A = (const bf16_t*)(T + T_CKV); g.lda = 256; g.Bt = (const bf16_t*)(wm + WM_UKV); g.ldb = 256; g.K = 256; g.nN = 8; g.latonly = 0; g.kind = EPI_KVN; g.out = T + T_KVPRE; g.ldc = 2048; g.aux0 = IN(p, 13) + j * 384 + 192; break;
        case G_WO: if (layer == 0) g.res_x = IN(p, 0); g.A = H; g.lda = 1024; g.Bt = (const bf16_t*)(wm + WM_O); g.ldb = 1024; g.K = 1024; g.nN = 4; g.kind = EPI_RES; g.splitk = 4; g.slab = (float*)(T + T_SLAB_A); break;
        case G_GLU: g.A = (const bf16_t*)(T + T_Z); g.lda = 1024; g.Bt = (const bf16_t*)(wm + WM_GLU); g.ldb = 1024; g.K = 1024; g.nN = 8; g.kind = EPI_GLU; g.splitk = 4; g.slab = (float*)(T + T_SLAB_A); break;
        case G_WX: g.A = H; g.lda = 1024; g.Bt = (const bf16_t*)(wm + WM_X); g.ldb = 1024; g.K = 1024; g.nN = 5; g.latonly = 0; g.kind = EPI_BF16; g.out = T + T_XPRE; g.ldc = LRUW; break;
        case G_GATES: g.A = (const bf16_t*)(T + T_XR); g.lda = LRUW; g.Bt = (const bf16_t*)(wm + WM_GATE); g.ldb = 256; g.K = 256; g.nN = 20; g.latonly = 0; g.kind = EPI_GATES; g.koff_shift = 2; g.koff_mul = 256;
            g.out = T + T_LA; g.out2 = T + T_BB; g.aux0 = IN(p, 28) + j * 4 * LRUW; g.aux1 = IN(p, 29) + j * 2 * LRUW; g.aux2 = T + T_XR; break;
        case G_WG: g.A = H; g.lda = 1024; g.Bt = (const bf16_t*)(wm + WM_G); g.ldb = 1024; g.K = 1024; g.nN = 5; g.latonly = 0; g.rev = 1; g.kind = EPI_GELUMUL; g.out = T + T_GX; g.ldc = LRUW; break;
        case G_WOUT: g.A = (const bf16_t*)(T + T_GH); g.lda = LRUW; g.Bt = (const bf16_t*)(wm + WM_OUT); g.ldb = LRUW; g.K = LRUW; g.nN = 4; g.kind = EPI_RES; g.splitk = 5; g.slab = (float*)(T + T_SLAB_A_LRU); break;
        case G_W1: g.A = H; g.lda = 1024; g.Bt = mlp_wbuf(p, layer); g.ldb = 1024; g.K = 1024; g.nN = 16; g.kind = EPI_RELU2; g.out = T + T_HID; g.ldc = 4096; break;
        default: g.A = (const bf16_t*)(T + T_HID); g.lda = 4096; g.Bt = mlp_wbuf(p, layer) + (size_t)4096 * 1024; g.ldb = 4096; g.K = 4096; g.nN = 4; g.kind = EPI_RES; g.gate_off = 5 * 1024; g.splitk = 16; g.slab = (float*)(T + T_SLAB_M); break;
    }
    if (dry && (g.kind == EPI_RES || g.kind == EPI_GLU)) { g.kind = EPI_RELU2; g.out = T + 204 * MiB; g.ldc = 1024; }
    return g;
}
constexpr int LDS_BYTES = 163840;

__global__ void __launch_bounds__(NTHREADS, 2) hybrid_fwd(KArgs ka) {
    extern __shared__ __attribute__((aligned(16))) unsigned char lds_raw[];
    char* lds = (char*)lds_raw;
    LAS unsigned char* ldsl = (LAS unsigned char*)lds_raw;
    if (threadIdx.x < 33) ((LAS unsigned long long*)(ldsl + PTAB_OFF))[threadIdx.x] = (unsigned long long)ka.in[threadIdx.x];
    if (threadIdx.x < 4) ((LAS unsigned*)(ldsl + PTAB_OFF + 512))[threadIdx.x] = 0u;
    __syncthreads();
    const XcdBarrier xbar = xcd_barrier_post((unsigned*)ka.ws, (volatile LAS unsigned*)(ldsl + PTAB_OFF + 512));
    for (int step = 0; step < NSTEPS; ++step) {
        Params p; p.tab = (const LAS unsigned long long*)(ldsl + PTAB_OFF);
        { unsigned long long oi = (unsigned long long)ka.out, wi = (unsigned long long)ka.ws;
          asm volatile("" : "+s"(oi), "+s"(wi));
          p.out = (float*)(__attribute__((address_space(1))) float*)oi; p.ws = (unsigned char*)(__attribute__((address_space(1))) unsigned char*)wi; }
        const Step st = PROGRAM[step];
        const int layer = st.layer, j = layer / 3; const bool need_ctx = layer < 3;
        const int nrep = (PROBE_MASK != 0 && ((PROBE_MASK >> st.type) & 1) && (st.type != ST_GEMM || ((PROBE_GMASK >> st.gid) & 1))) ? PROBE_REPS : 1;
        for (int rr = 0; rr < nrep; ++rr) {
        switch (st.type) {
#ifndef NO_INIT
            case ST_INIT: rope_table(p); s5v2::prep(p); prep_mixer(p, 0, lds); prep_mlp(p, 0, lds); break;
#endif
#ifndef NO_NORM
            case ST_NORM0: norm_phase(p, layer, 0, layer == 0, false, (layer > 0 && rr == 0) ? 16 : 0, (const float*)(p.ws + WS_T + T_SLAB_M), (const float*)(p.ws + WS_MOD) + (size_t)(4 * 4 + layer - 1) * 6144 + 5 * 1024, false); break;
            case ST_NORM1: norm_phase(p, layer, 1, false, !need_ctx, (need_ctx && rr == 0) ? (layer % 3 == 2 ? 5 : 4) : 0, (const float*)(p.ws + WS_T + (layer % 3 == 2 ? T_SLAB_A_LRU : T_SLAB_A)), (const float*)(p.ws + WS_MOD) + (size_t)(4 * 4 + layer) * 6144 + 2 * 1024, layer % 3 == 1); break;
#endif
#ifndef NO_GEMM
            case ST_GEMM: for (int gi = 0; gi < st.ng; ++gi) { const GemmD g = make_gemm(p, st.gid + gi, layer, rr != 0); gemm_phase(p, ldsl, g, st.gid + gi, layer, rr != 0); }
                if (st.gid == G_W1 && layer < 3 && rr == 0 && BIDX() >= 64) { prep_mixer(p, layer + 1, lds, 64); prep_mlp(p, layer + 1, lds, 64); }
                break;
#endif
#ifndef NO_ROWOP
            case ST_A3: mla_rowop_a3(p, j); break;
            case ST_A5: mla_rowop_a5(p, j, !need_ctx); break;
#endif
#ifndef NO_ATTN
            case ST_ATTN: attn_phase(p, need_ctx, lds); break;
#endif
#ifndef NO_S5
            case ST_S5: s5v2::phase(p, j, lds); break;
#endif
#ifndef NO_LRU
            case ST_CONV: lru_conv(p, j); break;
            case ST_LRU1: lru_pass1(p); break;
            case ST_LRUC: lru_carry(p); break;
            case ST_LRU3: lru_pass3(p, false); break;
#endif
            default: break;
        }
        if (rr == 0) {
            int ml0 = 0, ml1 = 0, rank = BIDX(), nr = GDIM(); const int bx = BIDX();
            if (GDIM() != 256) { if (st.type == ST_INIT) ml1 = 4; }
            else if (st.type == ST_INIT) ml1 = 1;
            else if (layer == 0 && st.type == ST_GEMM && st.gid == G_DQKV) { ml0 = 1; rank = bx - 204; nr = 52; ml1 = rank >= 0 ? 2 : 0; }
            else if (layer == 0 && st.type == ST_ATTN) { ml0 = 2; rank = bx - (bx >> 3) - 1; nr = 224; ml1 = (bx & 7) ? 3 : 0; }
            else if (layer == 1 && st.type == ST_GEMM && st.gid == G_GLU) { ml0 = 3; rank = bx - 128; nr = 128; ml1 = rank >= 0 ? 4 : 0; }
            for (int ml = ml0; ml < ml1; ++ml) mod_phase(p, lds, ml, rank, nr);
        }
        xcd_barrier(xbar);
        }
    }
}

extern "C" void kernel_launch(void* const* d_in, const int* in_sizes, int n_in, void* d_out, int out_size, void* d_ws, size_t ws_size, hipStream_t stream) {
    static int grid_blocks = 0;
    if (grid_blocks == 0) {
        if (n_in != 33 || out_size != NB * SEQ * DM || ws_size < WS_END) { fprintf(stderr, "kernel_launch: unexpected shapes n_in %d out %d ws %zu (need %zu)\n", n_in, out_size, ws_size, (size_t)WS_END); grid_blocks = -1; return; }
        int dev = 0, cus = 0, per_cu = 0;
        hipGetDevice(&dev);
        hipDeviceGetAttribute(&cus, hipDeviceAttributeMultiprocessorCount, dev);
        if (hipFuncSetAttribute((const void*)hybrid_fwd, hipFuncAttributeMaxDynamicSharedMemorySize, LDS_BYTES) != hipSuccess) { fprintf(stderr, "kernel_launch: hipFuncSetAttribute failed\n"); grid_blocks = -1; return; }
        if (hipOccupancyMaxActiveBlocksPerMultiprocessor(&per_cu, (const void*)hybrid_fwd, NTHREADS, LDS_BYTES) != hipSuccess || per_cu < 1) { fprintf(stderr, "kernel_launch: occupancy query failed (%d)\n", per_cu); per_cu = 1; (void)hipGetLastError(); }
        if (per_cu > 1) per_cu = 1;
        grid_blocks = cus * per_cu;
    }
    if (grid_blocks < 0) return;
    KArgs p{};
    for (int i = 0; i < 33; ++i) p.in[i] = (const float*)d_in[i];
    p.out = (float*)d_out; p.ws = (unsigned char*)d_ws;
    if (hipMemsetAsync(d_ws, 0, 16384, stream) != hipSuccess) { fprintf(stderr, "kernel_launch: memset of the barrier words failed\n"); return; }
    void* args[] = {&p};
    hipError_t e = hipLaunchCooperativeKernel((const void*)hybrid_fwd, dim3(grid_blocks), dim3(NTHREADS), args, LDS_BYTES, stream);
    if (e != hipSuccess) fprintf(stderr, "cooperative launch failed: %s (grid %d)\n", hipGetErrorString(e), grid_blocks);
}
```

```cpp
#include <hip/hip_runtime.h>
#include <hip/hip_cooperative_groups.h>
#include <cstdio>
#include <cstdint>
namespace cg = cooperative_groups;

#ifndef NAIVE_GEMM
#define NAIVE_GEMM 0
#endif

#define DI __device__ __forceinline__
#define LAS __attribute__((address_space(3)))
typedef unsigned short bf16_t;
typedef short bf16x8 __attribute__((ext_vector_type(8)));
typedef short s16x4 __attribute__((ext_vector_type(4)));
typedef float f32x4 __attribute__((ext_vector_type(4)));
typedef float f32x2 __attribute__((ext_vector_type(2)));
typedef float f32x16 __attribute__((ext_vector_type(16)));
typedef unsigned u32x4 __attribute__((ext_vector_type(4)));
typedef unsigned u32x2 __attribute__((ext_vector_type(2)));

constexpr int DM = 1024, NB = 4, SEQ = 4096, CTXL = 256, RPB = SEQ + CTXL  , MROWS = NB * RPB  ;
constexpr int NTHREADS = 512, NWAVES = 8;
constexpr int LRUW = 1280;
constexpr float EPS = 1e-6f;
constexpr float QSCALE = 0.07216878364870323f * 1.4426950408889634f;

constexpr size_t MiB = 1u << 20;
constexpr size_t WS_MOD = 1 * MiB;
constexpr size_t WS_ROPE = 1 * MiB + 512 * 1024;
constexpr size_t WS_S5C = 2 * MiB;
constexpr size_t WS_CTXLAT = 4 * MiB;
constexpr size_t WS_WMIX = 8 * MiB;
constexpr size_t WS_WMLP = 19 * MiB;
constexpr size_t WS_H = 35 * MiB;
constexpr size_t WS_T = 69 * MiB;
constexpr size_t WS_END = WS_T + 270 * MiB;
constexpr size_t T_DQKV = 0, T_CQ = 51 * MiB, T_CKV = 64 * MiB, T_KR = 73 * MiB, T_QPRE = 76 * MiB, T_KVPRE = 127 * MiB;
constexpr size_t T_Z = 0, T_S5E = 40 * MiB, T_S5S = 50 * MiB;
constexpr size_t T_GX = 0  , T_LA = 43 * MiB  , T_BB = 129 * MiB, T_XPRE = 43 * MiB  ,
                 T_XR = 215 * MiB, T_GH = 215 * MiB  , T_LP = 258 * MiB, T_LE = 261 * MiB, T_LS = 264 * MiB;
constexpr size_t LRU_DIRSTRIDE = 43 * MiB;
constexpr size_t T_HID = 0;
constexpr size_t T_SLAB_M = 140 * MiB  , T_SLAB_A = 200 * MiB  , T_SLAB_A_LRU = 172 * MiB  ;
constexpr size_t WM_D = 0  , WM_UQ = 1572864  , WM_UKV = WM_UQ + 1179648  , WM_O = WM_UKV + 1048576  ;
constexpr size_t WM_GLU = 0;
constexpr size_t WM_X = 0  , WM_G = 2621440, WM_GATE = 2 * 2621440  , WM_OUT = 3 * 2621440  ;

struct KArgs {
    const float* in[33];
    float* out;
    unsigned char* ws;
};
constexpr int PTAB_OFF = 163072;
struct Params {
    float* out;
    unsigned char* ws;
    const LAS unsigned long long* tab;
};
__device__ __forceinline__ const float* IN(const Params& p, int k) {
    const unsigned long long v = p.tab[k];
    const unsigned lo = __builtin_amdgcn_readfirstlane((unsigned)v), hi = __builtin_amdgcn_readfirstlane((unsigned)(v >> 32));
    return (const float*)(const __attribute__((address_space(1))) float*)(((unsigned long long)hi << 32) | lo);
}

DI float ZF() { float z; asm volatile("v_mov_b32 %0, 0" : "=v"(z)); return z; }
DI int TIDX() { int t = threadIdx.x; asm volatile("" : "+v"(t)); return t; }
DI int BIDX() { int t = blockIdx.x; asm volatile("" : "+s"(t)); return t; }
DI int GDIM() { int t = gridDim.x; asm volatile("" : "+s"(t)); return t; }
typedef __bf16 bf16x2_t __attribute__((ext_vector_type(2)));
DI unsigned pk2(float lo, float hi) { f32x2 v = {lo, hi}; bf16x2_t b = __builtin_convertvector(v, bf16x2_t); return __builtin_bit_cast(unsigned, b); }
DI unsigned f2bf(float f) { return pk2(f, 0.f) & 0xffffu; }
DI float bflo(unsigned w) { return __uint_as_float(w << 16); }
DI float bfhi(unsigned w) { return __uint_as_float(w & 0xffff0000u); }
DI float bf2f(bf16_t h) { return __uint_as_float((unsigned)h << 16); }
DI float wave_sum(float v) {
#pragma unroll
    for (int o = 32; o; o >>= 1) v += __shfl_xor(v, o);
    return v;
}
DI float sigmoidf_(float x) { return __builtin_amdgcn_rcpf(1.f + __builtin_amdgcn_exp2f(-1.4426950408889634f * x)); }
DI float gelu_tanh(float x) {
    const float t = fmaf(x * x, 0.10294324f, 2.3022082f); return x * __builtin_amdgcn_rcpf(1.f + __builtin_amdgcn_exp2f(-x * t));
}
#define LDS_FENCE() asm volatile("s_waitcnt lgkmcnt(0)" ::: "memory")

DI float* lat_row(const Params& p, int row) {
    const int b = row / RPB, rb = row - b * RPB;
    return rb < CTXL ? (float*)(p.ws + WS_CTXLAT) + (size_t)(b * CTXL + rb) * DM : p.out + (size_t)(b * SEQ + rb - CTXL) * DM;
}

DI void mod_phase(const Params& p, char* lds) {
    float* sv = (float*)lds;
    float* red = (float*)(lds + 20480);
    const int tid = TIDX();
    for (int i = tid; i < 5 * 1024; i += NTHREADS) { const int mi = i >> 10, k = i & 1023; const float x = mi < 4 ? IN(p, 1)[mi * 1024 + k] : IN(p, 3)[k]; sv[i] = x / (1.f + __expf(-x)); }
    __syncthreads();
    float* modv = (float*)(p.ws + WS_MOD);
    for (int grp = BIDX(); grp < 256; grp += GDIM()) {
        const int ks = tid / 24, cq = tid % 24;
        const int col = grp * 96 + cq * 4, layer = col / 6144, cc = col % 6144;
        if (ks < 16) {
            const float* w = IN(p, 4) + (size_t)layer * 1024 * 6144 + cc;
            f32x4 a0 = {0, 0, 0, 0}, a1 = a0, a2 = a0, a3 = a0, a4 = a0;
            for (int k0 = ks * 64; k0 < ks * 64 + 64; k0 += 16) {
                f32x4 wv[16];
#pragma unroll
                for (int u = 0; u < 16; ++u) wv[u] = *(const f32x4*)(w + (size_t)(k0 + u) * 6144);
#pragma unroll
                for (int u = 0; u < 16; ++u) { const int k = k0 + u; a0 += sv[k] * wv[u]; a1 += sv[1024 + k] * wv[u]; a2 += sv[2048 + k] * wv[u]; a3 += sv[3072 + k] * wv[u]; a4 += sv[4096 + k] * wv[u]; }
            }
            f32x4* r = (f32x4*)red + (ks * 24 + cq) * 5;
            r[0] = a0; r[1] = a1; r[2] = a2; r[3] = a3; r[4] = a4;
        }
        __syncthreads();
        if (tid < 120) {
            const int q = tid / 5, mi = tid % 5; const int c2 = grp * 96 + q * 4, l2 = c2 / 6144, cc2 = c2 % 6144;
            f32x4 s = *(const f32x4*)(IN(p, 5) + l2 * 6144 + cc2);
            for (int k2 = 0; k2 < 16; ++k2) s += ((const f32x4*)red)[(k2 * 24 + q) * 5 + mi];
            *(f32x4*)(modv + (size_t)(mi * 4 + l2) * 6144 + cc2) = s;
        }
        __syncthreads();
    }
}

struct PrepCtx { char* ldsw; int gw, nw, lane, tcount; };
DI void prep_T(PrepCtx& c, const float* src, int lds_, int K, int N, bf16_t* dst, int ldd, int zero_delta = 0, int hi_stride = 32, const float* kscale = nullptr) {
    const int ntn = N / 64, nt = (K / 64) * ntn;
    unsigned* T = (unsigned*)c.ldsw;
    const int lane = c.lane, c4 = (lane & 15) * 4, r = lane >> 4, rr = lane >> 3, kc = lane & 7;
    int first = (c.gw - c.tcount) % c.nw; if (first < 0) first += c.nw;
    for (int t = first; t < nt; t += c.nw) {
        const int kt = t / ntn, nn = t - kt * ntn;
        const float* s = src + (size_t)(kt * 64 + 2 * r) * lds_ + nn * 64 + c4;
        f32x4 v0[8], v1[8];
#pragma unroll
        for (int i = 0; i < 8; ++i) { v0[i] = *(const f32x4*)(s + (size_t)(8 * i) * lds_); v1[i] = *(const f32x4*)(s + (size_t)(8 * i + 1) * lds_); }
        if (kscale) {
#pragma unroll
            for (int i = 0; i < 8; ++i) { v0[i] = v0[i] * kscale[kt * 64 + 2 * r + 8 * i]; v1[i] = v1[i] * kscale[kt * 64 + 2 * r + 8 * i + 1]; }
        }
        LDS_FENCE();
#pragma unroll
        for (int i = 0; i < 8; ++i)
#pragma unroll
            for (int e = 0; e < 4; ++e) T[(c4 + e) * 33 + 4 * i + r] = pk2(v0[i][e], v1[i][e]);
        LDS_FENCE();
#pragma unroll
        for (int i = 0; i < 8; ++i) {
            const unsigned* Tr = T + (8 * i + rr) * 33 + 4 * kc;
            const u32x4 w = {Tr[0], Tr[1], Tr[2], Tr[3]};
            const int nrow = 8 * i + rr;
            bf16_t* d = dst + (size_t)(nn * 64 + (nrow >> 5) * hi_stride + (nrow & 31)) * ldd + kt * 64 + 8 * kc;
            *(u32x4*)d = w;
            if (zero_delta) { const unsigned z = __float_as_uint(ZF()); *(u32x4*)(d + zero_delta) = (u32x4){z, z, z, z}; }
        }
    }
    c.tcount += nt;
}
DI void prep_zero_rows(bf16_t* dst, size_t nelem, int first_block = 0) {
    const size_t n8 = nelem / 8; const unsigned z0 = __float_as_uint(ZF()); const u32x4 z = {z0, z0, z0, z0};
    for (size_t i = (size_t)(BIDX() - first_block) * NTHREADS + TIDX(); i < n8; i += (size_t)(GDIM() - first_block) * NTHREADS) ((u32x4*)dst)[i] = z;
}
DI PrepCtx prep_ctx(char* lds, int first_block = 0) {
    PrepCtx c; const int wave = TIDX() >> 6; c.lane = TIDX() & 63; c.ldsw = lds + wave * 8448; c.gw = (BIDX() - first_block) * NWAVES + wave; c.nw = (GDIM() - first_block) * NWAVES; c.tcount = 0; return c;
}
DI void prep_mixer(const Params& p, int layer, char* lds, int first_block = 0) {
    PrepCtx c = prep_ctx(lds, first_block);
    unsigned char* wm = p.ws + WS_WMIX;
    const int kind = layer % 3, j = layer / 3;
    if (kind == 0) {
        bf16_t* Wd = (bf16_t*)(wm + WM_D);
        prep_T(c, IN(p, 7) + (size_t)j * 1024 * 384, 384, 1024, 384, Wd, 1024);
        prep_T(c, IN(p, 10) + (size_t)j * 1024 * 320, 320, 1024, 256, Wd + (size_t)512 * 1024, 1024);
        prep_T(c, IN(p, 10) + (size_t)j * 1024 * 320 + 256, 320, 1024, 64, Wd + (size_t)384 * 1024, 1024);
        prep_zero_rows(Wd + (size_t)448 * 1024, 64 * 1024, first_block);
        for (int hh = 0; hh < 8; ++hh) {
            const float* wsrc = IN(p, 9) + (size_t)j * 384 * 1536 + hh * 192;
            prep_T(c, wsrc, 1536, 384, 128, (bf16_t*)(wm + WM_UQ) + (size_t)(256 * (hh >> 1) + 128 * (hh & 1)) * 384, 384, 0, 32, IN(p, 8) + j * 384);
            prep_T(c, wsrc + 128, 1536, 384, 64, (bf16_t*)(wm + WM_UQ) + (size_t)(256 * (4 + (hh >> 2)) + 32 * (hh & 3)) * 384, 384, 0, 128, IN(p, 8) + j * 384);
        }
        prep_T(c, IN(p, 12) + (size_t)j * 256 * 2048, 2048, 256, 2048, (bf16_t*)(wm + WM_UKV), 256);
        prep_T(c, IN(p, 14) + (size_t)j * 1024 * 1024, 1024, 1024, 1024, (bf16_t*)(wm + WM_O), 1024);
    } else if (kind == 1) {
        bf16_t* Wg = (bf16_t*)(wm + WM_GLU);
        for (int pn = 0; pn < 8; ++pn)
            for (int bj = 0; bj < 2; ++bj)
                prep_T(c, IN(p, 23) + (size_t)j * 1024 * 2048 + bj * 1024 + 128 * pn, 2048, 1024, 128, Wg + (size_t)(256 * pn + 128 * bj) * 1024, 1024);
    } else {
        const float* win = IN(p, 24) + (size_t)j * 1024 * 2560;
        prep_T(c, win + 1280, 2560, 1024, 1280, (bf16_t*)(wm + WM_X), 1024);
        prep_T(c, win, 2560, 1024, 1280, (bf16_t*)(wm + WM_G), 1024);
        bf16_t* Wt = (bf16_t*)(wm + WM_GATE);
        const float* wg = IN(p, 27) + (size_t)j * 2 * 2 * 10 * 128 * 128;
        for (int pr = 0; pr < 5; ++pr)
            for (int bip = 0; bip < 2; ++bip)
                for (int dir = 0; dir < 2; ++dir)
                    for (int gate = 0; gate < 2; ++gate)
                        prep_T(c, wg + (size_t)(((dir * 2 + gate) * 10) + 2 * pr + bip) * 128 * 128, 128, 128, 128,
                               Wt + (size_t)(1024 * pr + ((bip * 2 + dir) * 2 + gate) * 128) * 256 + 128 * bip, 256, bip ? -128 : 128);
        prep_T(c, IN(p, 30) + (size_t)j * 1280 * 1024, 1024, 1280, 1024, (bf16_t*)(wm + WM_OUT), 1280);
    }
}
constexpr size_t T_WMLP1 = 250 * MiB;
DI bf16_t* mlp_wbuf(const Params& p, int layer) { return (bf16_t*)((layer & 1) ? p.ws + WS_T + T_WMLP1 : p.ws + WS_WMLP); }
DI void prep_mlp(const Params& p, int layer, char* lds, int first_block = 0) {
    PrepCtx c = prep_ctx(lds, first_block);
    bf16_t* W1 = mlp_wbuf(p, layer); bf16_t* W2 = W1 + (size_t)4096 * 1024;
    prep_T(c, IN(p, 31) + (size_t)layer * 1024 * 4096, 4096, 1024, 4096, W1, 1024);
    prep_T(c, IN(p, 32) + (size_t)layer * 4096 * 1024, 1024, 4096, 1024, W2, 4096);
}

DI void norm_phase(const Params& p, int layer, int which, bool first, bool latonly, int nslab, const float* slab, const float* sgate, bool glu) {
    const int lane = TIDX() & 63, gw = BIDX() * NWAVES + (TIDX() >> 6), nw = GDIM() * NWAVES;
    const float* modv = (const float*)(p.ws + WS_MOD);
    const float* g = IN(p, 6) + (size_t)(layer * 2 + which) * 1024;
    bf16_t* h = (bf16_t*)(p.ws + WS_H);
    for (int qd = gw; qd < NB * SEQ / 4; qd += nw) {
        const int b = qd / (SEQ / 4), t0 = (qd - b * (SEQ / 4)) * 4;
        float* lp = p.out + (size_t)(b * SEQ + t0) * DM;
        const float* src = first ? IN(p, 0) + (size_t)(b * SEQ + t0) * DM : lp;
        const float* md = modv + (size_t)(b * 4 + layer) * 6144 + which * 3072;
        f32x4 v[4][4]; float ss[4];
#pragma unroll
        for (int r = 0; r < 4; ++r)
#pragma unroll
            for (int j = 0; j < 4; ++j) v[r][j] = *(const f32x4*)(src + (size_t)r * DM + j * 256 + lane * 4);
        f32x4 mul[4], sh[4];
#pragma unroll
        for (int j = 0; j < 4; ++j) { const int col = j * 256 + lane * 4; mul[j] = *(const f32x4*)(g + col) * (1.f + *(const f32x4*)(md + 1024 + col)); sh[j] = *(const f32x4*)(md + col); }
#pragma unroll
        for (int r = 0; r < 4; ++r) { float a = 0.f;
#pragma unroll
            for (int j = 0; j < 4; ++j) a += v[r][j][0] * v[r][j][0] + v[r][j][1] * v[r][j][1] + v[r][j][2] * v[r][j][2] + v[r][j][3] * v[r][j][3];
            ss[r] = a; }
#pragma unroll
        for (int o = 32; o; o >>= 1) {
#pragma unroll
            for (int r = 0; r < 4; ++r) ss[r] += __shfl_xor(ss[r], o);
        }
        const size_t hrow = (size_t)(b * RPB + CTXL + t0);
#pragma unroll
        for (int r = 0; r < 4; ++r) {
            const float inv = rsqrtf(ss[r] * (1.f / 1024.f) + EPS);
#pragma unroll
            for (int j = 0; j < 4; ++j) {
                const int col = j * 256 + lane * 4;
                const f32x4 o = v[r][j] * inv * mul[j] + sh[j];
                u32x2 w = {pk2(o[0], o[1]), pk2(o[2], o[3])};
                *(u32x2*)(h + (hrow + r) * DM + col) = w;
            }
        }
    }
    if (latonly) return;
    const float* md = modv + (size_t)(4 * 4 + layer) * 6144 + which * 3072;
    for (int cr = gw; cr < NB * CTXL; cr += nw) {
        const int b = cr / CTXL, rb = cr - b * CTXL;
        float* lp = (float*)(p.ws + WS_CTXLAT) + (size_t)cr * DM;
        const float* src = first ? IN(p, 2) + (size_t)cr * DM : lp;
        f32x4 v[4]; float ss = 0.f;
#pragma unroll
        for (int j = 0; j < 4; ++j) v[j] = *(const f32x4*)(src + j * 256 + lane * 4);
        if (nslab) {
#pragma unroll
            for (int j = 0; j < 4; ++j) {
                const int col = j * 256 + lane * 4; f32x4 a = {0.f, 0.f, 0.f, 0.f};
                if (glu) {
                    const float* sp = slab + (size_t)cr * 2048 + (col >> 7) * 256 + (col & 127); f32x4 gz = {0.f, 0.f, 0.f, 0.f};
                    for (int ks = 0; ks < nslab; ++ks) { a += *(const f32x4*)(sp + (size_t)ks * 1024 * 2048); gz += *(const f32x4*)(sp + (size_t)ks * 1024 * 2048 + 128); }
#pragma unroll
                    for (int e = 0; e < 4; ++e) a[e] *= sigmoidf_(gz[e]);
                } else {
                    const float* sp = slab + (size_t)cr * 1024 + col;
                    for (int ks = 0; ks < nslab; ++ks) a += *(const f32x4*)(sp + (size_t)ks * 1024 * 1024);
                }
                v[j] += *(const f32x4*)(sgate + col) * a;
                *(f32x4*)(lp + col) = v[j];
            }
        }
#pragma unroll
        for (int j = 0; j < 4; ++j) ss += v[j][0] * v[j][0] + v[j][1] * v[j][1] + v[j][2] * v[j][2] + v[j][3] * v[j][3];
        ss = wave_sum(ss);
        const float inv = rsqrtf(ss * (1.f / 1024.f) + EPS);
#pragma unroll
        for (int j = 0; j < 4; ++j) {
            const int col = j * 256 + lane * 4;
            if (first) *(f32x4*)(lp + col) = v[j];
            const f32x4 gg = *(const f32x4*)(g + col), sh = *(const f32x4*)(md + col), sc = *(const f32x4*)(md + 1024 + col);
            const f32x4 o = v[j] * inv * gg * (1.f + sc) + sh;
            u32x2 w = {pk2(o[0], o[1]), pk2(o[2], o[3])};
            *(u32x2*)(h + (size_t)(b * RPB + rb) * DM + col) = w;
        }
    }
}

constexpr int BM = 256, BK = 64, HALF = 128, HTB = HALF * BK * 2, NXCD = 8, WGM = 8;
struct Unit { int pm, pn, k0, nt, split, ks; };
enum { EPI_F32 = 0, EPI_BF16 = 1, EPI_RES = 2, EPI_RELU2 = 3, EPI_GLU = 4, EPI_GATES = 5, EPI_GELUMUL = 6, EPI_QN = 8, EPI_KVN = 9, EPI_DQKV = 10 };
struct GemmD {
    const bf16_t* A; const bf16_t* Bt; int lda, ldb, K, nN; int latonly; int koff_shift, koff_mul;
    int kind; int rev; int splitk; float* slab;
    void* out; int ldc;
    const float* gate; int gate_off;
    int layer;
    const float* res_x;
    const float* aux0; const float* aux1; const void* aux2; void* out2;
};
DI int lds_byte(int r, int c) { const int st = (r >> 4) * 2 + (c >> 5), rr = r & 15, cc = c & 31, ob = rr * 64 + cc * 2; return st * 1024 + (ob ^ (((ob >> 9) & 1) << 5)); }
DI void stage_rc(int b, int& R, int& C) { const int st = b / 1024, sb = b % 1024, swz = sb ^ (((sb >> 9) & 1) << 5); R = (st >> 1) * 16 + swz / 64; C = (st & 1) * 32 + (swz % 64) / 2; }

DI bool unit_next(const GemmD& g, int i, Unit& u) {
    const bool sk = g.splitk > 0 && !g.latonly;
    const int nM = (g.latonly || sk) ? 64 : 68, nN = g.nN, nwg = nM * nN, G = GDIM(), c = g.rev ? GDIM() - 1 - BIDX() : BIDX();
    const long L = (long)i * G + c;
    u.k0 = 0; u.nt = g.K / BK; u.split = 0; u.ks = 0;
    if (L >= nwg) {
        if (!sk) return false;
        const int tt = (int)(L - nwg); if (tt >= 4 * nN * g.splitk) return false;
        const int ks = tt / (4 * nN), r = tt - ks * 4 * nN;
        u.pm = 17 * (r & 3); u.pn = r >> 2; u.nt = g.K / BK / g.splitk; u.k0 = ks * u.nt * BK; u.split = 1; u.ks = ks; return true;
    }
    int wgid = (int)L; { const int q = nwg / NXCD, r = nwg % NXCD, xcd = wgid % NXCD, off = wgid / NXCD; wgid = (xcd < r ? xcd * (q + 1) : r * (q + 1) + (xcd - r) * q) + off; }
    const int nig = WGM * nN, gid = wgid / nig, fm = gid * WGM, gsz = (nM - fm) < WGM ? (nM - fm) : WGM;
    int pm = fm + ((wgid % nig) % gsz); u.pn = (wgid % nig) / gsz;
    if (nM == 64) pm = 17 * (pm >> 4) + 1 + (pm & 15);
    u.pm = pm; return true;
}

template <int KIND>
DI void epi_loop(const Params& p, const GemmD& g, const f32x4 (&acc)[2][2][4][2], const Unit& u, int wr, int wc, int fr, int fq) {
    const int b = u.pm / 17, tpm = u.pm - 17 * b, mi = tpm == 0 ? 4 : b;
    const float* gatep = nullptr;
    if (KIND == EPI_RES || KIND == EPI_GLU) gatep = g.gate + (size_t)(mi * 4 + g.layer) * 6144 + g.gate_off;
    f32x4 gbias[2][2], gsp[2];
    if (KIND == EPI_GATES) {
        const int dir = u.pn & 1;
#pragma unroll
        for (int n = 0; n < 2; ++n) {
            const int ch = (u.pn >> 1) * 128 + wc * 32 + n * 16 + fq * 4;
            gbias[n][0] = *(const f32x4*)(g.aux0 + (dir * 2 + 0) * LRUW + ch); gbias[n][1] = *(const f32x4*)(g.aux0 + (dir * 2 + 1) * LRUW + ch);
            const f32x4 lam = *(const f32x4*)(g.aux1 + dir * LRUW + ch);
#pragma unroll
            for (int e = 0; e < 4; ++e) gsp[n][e] = -8.f * log1pf(__expf(-lam[e]));
        }
    }
#pragma unroll
    for (int ai = 0; ai < 2; ++ai)
#pragma unroll
        for (int m = 0; m < 4; ++m) {
            const int rb = tpm * 256 + ai * 128 + wr * 64 + m * 16 + fr;
            const int row = b * RPB + rb;
            float* lp = nullptr;
            if (KIND == EPI_RES || KIND == EPI_GLU) lp = rb < CTXL ? (float*)(p.ws + WS_CTXLAT) + (size_t)(b * CTXL + rb) * DM : p.out + (size_t)(b * SEQ + rb - CTXL) * DM;
            const float* lin = lp;
            if (KIND == EPI_RES) { if (g.res_x && rb >= CTXL) lin = g.res_x + (size_t)(b * SEQ + rb - CTXL) * DM; }
#pragma unroll
            for (int n = 0; n < 2; ++n) {
                const int cw = wc * 32 + n * 16 + fq * 4;
                if (KIND == EPI_F32) {
#pragma unroll
                    for (int bj = 0; bj < 2; ++bj) *(f32x4*)((float*)g.out + (size_t)row * g.ldc + u.pn * 256 + bj * 128 + cw) = acc[ai][bj][m][n];
                } else if (KIND == EPI_BF16) {
#pragma unroll
                    for (int bj = 0; bj < 2; ++bj) { const f32x4 v = acc[ai][bj][m][n]; u32x2 w = {pk2(v[0], v[1]), pk2(v[2], v[3])};
                        *(u32x2*)((bf16_t*)g.out + (size_t)row * g.ldc + u.pn * 256 + bj * 128 + cw) = w; }
                } else if (KIND == EPI_RELU2) {
#pragma unroll
                    for (int bj = 0; bj < 2; ++bj) { f32x4 v = acc[ai][bj][m][n];
#pragma unroll
                        for (int e = 0; e < 4; ++e) { const float r = fmaxf(v[e], 0.f); v[e] = r * r; }
                        u32x2 w = {pk2(v[0], v[1]), pk2(v[2], v[3])};
                        *(u32x2*)((bf16_t*)g.out + (size_t)row * g.ldc + u.pn * 256 + bj * 128 + cw) = w; }
                } else if (KIND == EPI_RES) {
#pragma unroll
                    for (int bj = 0; bj < 2; ++bj) { const int col = u.pn * 256 + bj * 128 + cw;
                        const f32x4 gt = *(const f32x4*)(gatep + col);
                        f32x4 v = *(const f32x4*)(lin + col); v += gt * acc[ai][bj][m][n]; *(f32x4*)(lp + col) = v; }
                } else if (KIND == EPI_GLU) {
                    const int col = u.pn * 128 + cw;
                    const f32x4 zv = acc[ai][0][m][n], zg = acc[ai][1][m][n];
                    const f32x4 gt = *(const f32x4*)(gatep + col); f32x4 v = *(f32x4*)(lp + col);
#pragma unroll
                    for (int e = 0; e < 4; ++e) v[e] += gt[e] * zv[e] * sigmoidf_(zg[e]);
                    *(f32x4*)(lp + col) = v;
                } else if (KIND == EPI_GATES) {
                    const int dir = u.pn & 1;
                    const int ch = (u.pn >> 1) * 128 + cw;
                    const u32x2 xw = *(const u32x2*)((const bf16_t*)g.aux2 + (size_t)row * LRUW + ch);
                    const float xr[4] = {bflo(xw[0]), bfhi(xw[0]), bflo(xw[1]), bfhi(xw[1])};
                    float la[4], bb[4];
#pragma unroll
                    for (int e = 0; e < 4; ++e) {
                        const float r = __builtin_amdgcn_rcpf(1.f + __expf(-(acc[ai][0][m][n][e] + gbias[n][0][e]))), ig = __builtin_amdgcn_rcpf(1.f + __expf(-(acc[ai][1][m][n][e] + gbias[n][1][e])));
                        const float l = gsp[n][e] * r;
                        const float x = 2.f * l;
                        const float om = -x * (1.f + x * (0.5f + x * (0.16666667f + x * (0.041666668f + x * 0.008333334f))));
                        la[e] = l; bb[e] = __builtin_amdgcn_sqrtf(fmaxf(om, 0.f)) * (ig * xr[e]);
                    }
                    u32x2 wl = {pk2(la[0], la[1]), pk2(la[2], la[3])}, wb = {pk2(bb[0], bb[1]), pk2(bb[2], bb[3])};
                    *(u32x2*)((bf16_t*)((unsigned char*)g.out + dir * LRU_DIRSTRIDE) + (size_t)row * LRUW + ch) = wl;
                    *(u32x2*)((bf16_t*)((unsigned char*)g.out2 + dir * LRU_DIRSTRIDE) + (size_t)row * LRUW + ch) = wb;
                } else if (KIND == EPI_GELUMUL) {
#pragma unroll
                    for (int bj = 0; bj < 2; ++bj) { const int col = u.pn * 256 + bj * 128 + cw; f32x4 v = acc[ai][bj][m][n];
#pragma unroll
                        for (int e = 0; e < 4; ++e) v[e] = gelu_tanh(v[e]);
                        u32x2 w = {pk2(v[0], v[1]), pk2(v[2], v[3])};
                        *(u32x2*)((bf16_t*)g.out + (size_t)row * g.ldc + col) = w; }
                }
            }
        }
}

constexpr int XCH_OFF = 131072;
DI void epi_rowstats(const f32x4 (&acc)[2][2][4][2], float (&ps)[2][4][2]) {
#pragma unroll
    for (int ai = 0; ai < 2; ++ai)
#pragma unroll
        for (int m = 0; m < 4; ++m)
#pragma unroll
            for (int bj = 0; bj < 2; ++bj) {
                float s = 0.f;
#pragma unroll
                for (int n = 0; n < 2; ++n) { const f32x4 v = acc[ai][bj][m][n]; s += v[0] * v[0] + v[1] * v[1] + v[2] * v[2] + v[3] * v[3]; }
                s += __shfl_xor(s, 16); s += __shfl_xor(s, 32);
                ps[ai][m][bj] = s;
            }
}
DI void epi_exchange(LAS unsigned char* lds, const float (&ps)[2][4][2], float (&tot)[2][4][2], int wr, int wc, int fr, int fq) {
    LAS float* X = (LAS float*)(lds + XCH_OFF);
    if (fq == 0) {
#pragma unroll
        for (int ai = 0; ai < 2; ++ai)
#pragma unroll
            for (int m = 0; m < 4; ++m)
#pragma unroll
                for (int bj = 0; bj < 2; ++bj) X[((ai * 128 + wr * 64 + m * 16 + fr) * 2 + bj) * 4 + wc] = ps[ai][m][bj];
    }
    asm volatile("s_waitcnt lgkmcnt(0)" ::: "memory"); __builtin_amdgcn_s_barrier(); asm volatile("" ::: "memory");
#pragma unroll
    for (int ai = 0; ai < 2; ++ai)
#pragma unroll
        for (int m = 0; m < 4; ++m)
#pragma unroll
            for (int bj = 0; bj < 2; ++bj) { const f32x4 t = *(const LAS f32x4*)(X + ((ai * 128 + wr * 64 + m * 16 + fr) * 2 + bj) * 4); tot[ai][m][bj] = (t[0] + t[1]) + (t[2] + t[3]); }
}
DI void epi_qn(const Params& p, const GemmD& g, LAS unsigned char* lds, const f32x4 (&acc)[2][2][4][2], const Unit& u, int wr, int wc, int fr, int fq) {
    const int b = u.pm / 17, tpm = u.pm - 17 * b;
    float ps[2][4][2]; epi_rowstats(acc, ps);
    bf16_t* Q = (bf16_t*)g.out; const float* gqk = g.aux0;
    const float* DQSS = (const float*)(p.ws + WS_T + T_DQKV);
    if (u.pn < 4) {
        float tot[2][4][2]; epi_exchange(lds, ps, tot, wr, wc, fr, fq);
        f32x4 gn[2];
#pragma unroll
        for (int n = 0; n < 2; ++n) gn[n] = *(const f32x4*)(gqk + wc * 32 + n * 16 + fq * 4);
#pragma unroll
        for (int ai = 0; ai < 2; ++ai)
#pragma unroll
            for (int m = 0; m < 4; ++m) {
                const int row = b * RPB + tpm * 256 + ai * 128 + wr * 64 + m * 16 + fr;
                float epsq;
                { const f32x4 d0 = *(const f32x4*)(DQSS + (size_t)row * 16), d1 = *(const f32x4*)(DQSS + (size_t)row * 16 + 4), d2 = *(const f32x4*)(DQSS + (size_t)row * 16 + 8);
                  const float ms = (((d0[0] + d0[1]) + (d0[2] + d0[3])) + ((d1[0] + d1[1]) + (d1[2] + d1[3])) + ((d2[0] + d2[1]) + (d2[2] + d2[3]))) * (1.f / 384.f); epsq = EPS * (ms + EPS); }
#pragma unroll
                for (int bj = 0; bj < 2; ++bj) {
                    const float inv = rsqrtf(tot[ai][m][bj] * (1.f / 128.f) + epsq) * QSCALE;
#pragma unroll
                    for (int n = 0; n < 2; ++n) { const f32x4 v = acc[ai][bj][m][n] * inv * gn[n]; u32x2 w = {pk2(v[0], v[1]), pk2(v[2], v[3])};
                        *(u32x2*)(Q + (size_t)row * 1536 + (2 * u.pn + bj) * 192 + wc * 32 + n * 16 + fq * 4) = w; }
                }
            }
    } else {
        const int hh = 4 * (u.pn - 4) + wc; const float* tb = (const float*)(p.ws + WS_ROPE);
        f32x4 gr[2][2];
#pragma unroll
        for (int bj = 0; bj < 2; ++bj)
#pragma unroll
            for (int n = 0; n < 2; ++n) gr[bj][n] = *(const f32x4*)(gqk + 128 + bj * 32 + n * 16 + fq * 4);
#pragma unroll
        for (int ai = 0; ai < 2; ++ai)
#pragma unroll
            for (int m = 0; m < 4; ++m) {
                const int rb = tpm * 256 + ai * 128 + wr * 64 + m * 16 + fr, row = b * RPB + rb, t = rb - CTXL;
                float epsq;
                { const f32x4 d0 = *(const f32x4*)(DQSS + (size_t)row * 16), d1 = *(const f32x4*)(DQSS + (size_t)row * 16 + 4), d2 = *(const f32x4*)(DQSS + (size_t)row * 16 + 8);
                  const float ms = (((d0[0] + d0[1]) + (d0[2] + d0[3])) + ((d1[0] + d1[1]) + (d1[2] + d1[3])) + ((d2[0] + d2[1]) + (d2[2] + d2[3]))) * (1.f / 384.f); epsq = EPS * (ms + EPS); }
                const float inv = rsqrtf((ps[ai][m][0] + ps[ai][m][1]) * (1.f / 64.f) + epsq);
#pragma unroll
                for (int bj = 0; bj < 2; ++bj) {
                    f32x4 x0 = acc[ai][bj][m][0] * inv * gr[bj][0], x1 = acc[ai][bj][m][1] * inv * gr[bj][1];
                    if (tpm != 0) {
                        const int pos = bj == 0 ? (t >> 6) : (t & 63);
                        const f32x4 cs = *(const f32x4*)(tb + pos * 32 + fq * 4), sn = *(const f32x4*)(tb + pos * 32 + 16 + fq * 4);
                        const f32x4 y0 = x0 * cs - x1 * sn, y1 = x1 * cs + x0 * sn; x0 = y0; x1 = y1;
                    }
                    x0 = x0 * QSCALE; x1 = x1 * QSCALE;
                    u32x2 w0 = {pk2(x0[0], x0[1]), pk2(x0[2], x0[3])}, w1 = {pk2(x1[0], x1[1]), pk2(x1[2], x1[3])};
                    bf16_t* qd = Q + (size_t)row * 1536 + hh * 192 + 128 + bj * 32 + fq * 4;
                    *(u32x2*)qd = w0; *(u32x2*)(qd + 16) = w1;
                }
            }
    }
}

DI void epi_dqkv(const Params& p, const GemmD& g, LAS unsigned char* lds, const f32x4 (&acc)[2][2][4][2], const Unit& u, int wr, int wc, int fr, int fq) {
    const int b = u.pm / 17, tpm = u.pm - 17 * b;
    float ps[2][4][2]; epi_rowstats(acc, ps);
    bf16_t* CQ = (bf16_t*)(p.ws + WS_T + T_CQ); bf16_t* CKV = (bf16_t*)(p.ws + WS_T + T_CKV); bf16_t* KR = (bf16_t*)(p.ws + WS_T + T_KR);
    float* DQSS = (float*)(p.ws + WS_T + T_DQKV);
    float tot[2][4][2];
    if (u.pn != 0) epi_exchange(lds, ps, tot, wr, wc, fr, fq);
    f32x4 gk[2]; const float* tb = (const float*)(p.ws + WS_ROPE);
    if (u.pn == 1) { gk[0] = wc < 2 ? *(const f32x4*)(g.aux1 + wc * 32 + fq * 4) : (f32x4){0.f, 0.f, 0.f, 0.f}; gk[1] = wc < 2 ? *(const f32x4*)(g.aux1 + wc * 32 + 16 + fq * 4) : (f32x4){0.f, 0.f, 0.f, 0.f}; }
#pragma unroll
    for (int ai = 0; ai < 2; ++ai)
#pragma unroll
        for (int m = 0; m < 4; ++m) {
            const int rb = tpm * 256 + ai * 128 + wr * 64 + m * 16 + fr, row = b * RPB + rb;
            if (u.pn == 0 || u.pn == 1) {
                const int nh = u.pn == 0 ? 2 : 1;
#pragma unroll
                for (int bj = 0; bj < 2; ++bj) {
                    if (bj < nh) {
#pragma unroll
                        for (int n = 0; n < 2; ++n) { const f32x4 v = acc[ai][bj][m][n]; u32x2 w = {pk2(v[0], v[1]), pk2(v[2], v[3])};
                            *(u32x2*)(CQ + (size_t)row * 384 + u.pn * 256 + bj * 128 + wc * 32 + n * 16 + fq * 4) = w; }
                        if (fq == 0) DQSS[(size_t)row * 16 + u.pn * 8 + bj * 4 + wc] = ps[ai][m][bj];
                    }
                }
            }
            if (u.pn == 1 && wc < 2) {
                const float inv = rsqrtf(tot[ai][m][1] * (1.f / 64.f) + EPS);
                f32x4 x0 = acc[ai][1][m][0] * inv * gk[0], x1 = acc[ai][1][m][1] * inv * gk[1];
                if (tpm != 0) {
                    const int t = rb - CTXL, pos = wc == 0 ? (t >> 6) : (t & 63);
                    const f32x4 cs = *(const f32x4*)(tb + pos * 32 + fq * 4), sn = *(const f32x4*)(tb + pos * 32 + 16 + fq * 4);
                    const f32x4 y0 = x0 * cs - x1 * sn, y1 = x1 * cs + x0 * sn; x0 = y0; x1 = y1;
                }
                u32x2 w0 = {pk2(x0[0], x0[1]), pk2(x0[2], x0[3])}, w1 = {pk2(x1[0], x1[1]), pk2(x1[2], x1[3])};
                bf16_t* kd = KR + (size_t)row * 64 + wc * 32 + fq * 4;
                *(u32x2*)kd = w0; *(u32x2*)(kd + 16) = w1;
            }
            if (u.pn == 2) {
                const float inv = rsqrtf((tot[ai][m][0] + tot[ai][m][1]) * (1.f / 256.f) + EPS);
#pragma unroll
                for (int bj = 0; bj < 2; ++bj)
#pragma unroll
                    for (int n = 0; n < 2; ++n) { const int col = bj * 128 + wc * 32 + n * 16 + fq * 4;
                        const f32x4 v = acc[ai][bj][m][n] * inv * *(const f32x4*)(g.aux0 + col); u32x2 w = {pk2(v[0], v[1]), pk2(v[2], v[3])};
                        *(u32x2*)(CKV + (size_t)row * 256 + col) = w; }
            }
        }
}
DI void epi_kvn(const Params& p, const GemmD& g, LAS unsigned char* lds, const f32x4 (&acc)[2][2][4][2], const Unit& u, int wr, int wc, int fr, int fq) {
    const int b = u.pm / 17, tpm = u.pm - 17 * b;
    float ps[2][4][2], tot[2][4][2]; epi_rowstats(acc, ps); epi_exchange(lds, ps, tot, wr, wc, fr, fq);
    bf16_t* KV = (bf16_t*)g.out; const float* gk = g.aux0;
    f32x4 gn[2];
#pragma unroll
    for (int n = 0; n < 2; ++n) gn[n] = *(const f32x4*)(gk + wc * 32 + n * 16 + fq * 4);
#pragma unroll
    for (int ai = 0; ai < 2; ++ai)
#pragma unroll
        for (int m = 0; m < 4; ++m) {
            const int row = b * RPB + tpm * 256 + ai * 128 + wr * 64 + m * 16 + fr;
            const float inv = rsqrtf(tot[ai][m][0] * (1.f / 128.f) + EPS);
            bf16_t* kd = KV + (size_t)row * 2048 + u.pn * 256 + wc * 32 + fq * 4;
#pragma unroll
            for (int n = 0; n < 2; ++n) {
                const f32x4 k = acc[ai][0][m][n] * inv * gn[n], v = acc[ai][1][m][n];
                u32x2 wk = {pk2(k[0], k[1]), pk2(k[2], k[3])}, wv = {pk2(v[0], v[1]), pk2(v[2], v[3])};
                *(u32x2*)(kd + n * 16) = wk; *(u32x2*)(kd + 128 + n * 16) = wv;
            }
        }
}
DI void epilogue(const Params& p, const GemmD& g, LAS unsigned char* lds, const f32x4 (&acc)[2][2][4][2], const Unit& u, int wr, int wc, int fr, int fq) {
    asm volatile("" : "+v"(fr), "+v"(fq));
    if (u.split) {
        const int b = u.pm / 17;
#pragma unroll
        for (int ai = 0; ai < 2; ++ai)
#pragma unroll
            for (int m = 0; m < 4; ++m) {
                float* sp = g.slab + ((size_t)u.ks * 1024 + (b * CTXL + ai * 128 + wr * 64 + m * 16 + fr)) * (size_t)(g.nN * 256) + u.pn * 256 + wc * 32 + fq * 4;
#pragma unroll
                for (int bj = 0; bj < 2; ++bj)
#pragma unroll
                    for (int n = 0; n < 2; ++n) *(f32x4*)(sp + bj * 128 + n * 16) = acc[ai][bj][m][n];
            }
        return;
    }
    switch (g.kind) {
        case EPI_F32: epi_loop<EPI_F32>(p, g, acc, u, wr, wc, fr, fq); break;
        case EPI_BF16: epi_loop<EPI_BF16>(p, g, acc, u, wr, wc, fr, fq); break;
        case EPI_RES: epi_loop<EPI_RES>(p, g, acc, u, wr, wc, fr, fq); break;
        case EPI_RELU2: epi_loop<EPI_RELU2>(p, g, acc, u, wr, wc, fr, fq); break;
        case EPI_GLU: epi_loop<EPI_GLU>(p, g, acc, u, wr, wc, fr, fq); break;
        case EPI_GATES: epi_loop<EPI_GATES>(p, g, acc, u, wr, wc, fr, fq); break;
        case EPI_QN: epi_qn(p, g, lds, acc, u, wr, wc, fr, fq); break;
        case EPI_KVN: epi_kvn(p, g, lds, acc, u, wr, wc, fr, fq); break;
        case EPI_DQKV: epi_dqkv(p, g, lds, acc, u, wr, wc, fr, fq); break;
        default: epi_loop<EPI_GELUMUL>(p, g, acc, u, wr, wc, fr, fq); break;
    }
}

struct GemmD;
DI GemmD make_gemm(const Params& p, int gid, int layer, bool dry);
#if NAIVE_GEMM
DI void gemm_phase(const Params& p, LAS unsigned char* lds, const GemmD& g, int gid, int layer, bool dry) {
    const int tid = TIDX(), wid = tid >> 6, lane = tid & 63, wr = wid >> 2, wc = wid & 3, fr = lane & 15, fq = lane >> 4;
    Unit u;
    for (int ui = 0; unit_next(g, ui, u); ++ui) {
        f32x4 acc[2][2][4][2];
#pragma unroll
        for (int a = 0; a < 2; ++a)
#pragma unroll
            for (int b = 0; b < 2; ++b)
#pragma unroll
                for (int m = 0; m < 4; ++m)
#pragma unroll
                    for (int n = 0; n < 2; ++n) { const float z = ZF(); acc[a][b][m][n] = (f32x4){z, z, z, z}; }
        const bf16_t* A = g.A + (size_t)u.pm * 256 * g.lda + (size_t)((u.pn >> g.koff_shift) * g.koff_mul);
        const bf16_t* B = g.Bt + (size_t)u.pn * 256 * g.ldb;
        for (int k0 = u.k0; k0 < u.k0 + u.nt * BK; k0 += 32) {
            bf16x8 af[2][4], bfr[2][2];
#pragma unroll
            for (int ai = 0; ai < 2; ++ai)
#pragma unroll
                for (int m = 0; m < 4; ++m) af[ai][m] = *(const bf16x8*)(A + (size_t)(ai * 128 + wr * 64 + m * 16 + fr) * g.lda + k0 + fq * 8);
#pragma unroll
            for (int bj = 0; bj < 2; ++bj)
#pragma unroll
                for (int n = 0; n < 2; ++n) bfr[bj][n] = *(const bf16x8*)(B + (size_t)(bj * 128 + wc * 32 + n * 16 + fr) * g.ldb + k0 + fq * 8);
#pragma unroll
            for (int ai = 0; ai < 2; ++ai)
#pragma unroll
                for (int bj = 0; bj < 2; ++bj)
#pragma unroll
                    for (int m = 0; m < 4; ++m)
#pragma unroll
                        for (int n = 0; n < 2; ++n) acc[ai][bj][m][n] = __builtin_amdgcn_mfma_f32_16x16x32_bf16(bfr[bj][n], af[ai][m], acc[ai][bj][m][n], 0, 0, 0);
        }
        epilogue(p, g, lds, acc, u, wr, wc, fr, fq);
    }
}
#else
DI void gemm_phase(const Params& p, LAS unsigned char* lds, const GemmD& g, int gid, int layer, bool dry) {
    const int tid = TIDX(), wid = __builtin_amdgcn_readfirstlane(tid >> 6), lane = tid & 63, wr = wid >> 2, wc = wid & 3, fr = lane & 15, fq = lane >> 4;
    unsigned voffA[2], voffB[2];
#pragma unroll
    for (int i = 0; i < 2; ++i) { int R, C; stage_rc(tid * 16 + i * 8192, R, C); voffA[i] = (unsigned)(R * g.lda + C) * 2u; voffB[i] = (unsigned)(R * g.ldb + C) * 2u; }
    const size_t kstep = (size_t)(BK * 2);
    const size_t hstepA = (size_t)HALF * g.lda * 2, hstepB = (size_t)HALF * g.ldb * 2;
    const unsigned ldsw = (unsigned)wid * 1024u;
    const int aoff = lds_byte(wr * 64 + fr, fq * 8), boff = lds_byte(wc * 32 + fr, fq * 8);
#define PG8_SA(b, h) (((b) * 2 + (h)) * HTB)
#define PG8_SB(b, h) ((4 + (b) * 2 + (h)) * HTB)
#define PG8_STAGE(bufoff, gbase, voff) do { _Pragma("unroll") for (int _i = 0; _i < 2; ++_i) \
        __builtin_amdgcn_global_load_lds((const unsigned*)((const char*)(gbase) + (voff)[_i]), (LAS unsigned*)(lds + (bufoff) + ldsw + _i * 8192), 16, 0, 0); } while (0)
#define PG8_LDA(dst, b, h) do { _Pragma("unroll") for (int m = 0; m < 4; ++m) _Pragma("unroll") for (int k = 0; k < 2; ++k) dst[m][k] = *(const LAS bf16x8*)(lds + PG8_SA(b, h) + aoff + m * 2048 + k * 1024); } while (0)
#define PG8_LDB(dst, b, h) do { _Pragma("unroll") for (int n = 0; n < 2; ++n) _Pragma("unroll") for (int k = 0; k < 2; ++k) dst[n][k] = *(const LAS bf16x8*)(lds + PG8_SB(b, h) + boff + n * 2048 + k * 1024); } while (0)
#define PG8_MMA(ai, bj, At, Bt) do { __builtin_amdgcn_s_setprio(1); _Pragma("unroll") for (int m = 0; m < 4; ++m) _Pragma("unroll") for (int n = 0; n < 2; ++n) _Pragma("unroll") for (int k = 0; k < 2; ++k) \
        acc[ai][bj][m][n] = __builtin_amdgcn_mfma_f32_16x16x32_bf16(Bt[n][k], At[m][k], acc[ai][bj][m][n], 0, 0, 0); __builtin_amdgcn_s_setprio(0); } while (0)
#define PG8_WAIT_V(n) asm volatile("s_waitcnt vmcnt(" #n ")" ::: "memory")
#define PG8_WAIT_L(n) asm volatile("s_waitcnt lgkmcnt(" #n ")" ::: "memory")
#define PG8_BAR __builtin_amdgcn_s_barrier()
#define PG8_SCHED __builtin_amdgcn_sched_barrier(0)
    Unit cur, nxt; int ui = 0;
    if (!unit_next(g, 0, cur)) return;
    f32x4 acc[2][2][4][2];
#pragma unroll
    for (int a = 0; a < 2; ++a)
#pragma unroll
        for (int b = 0; b < 2; ++b)
#pragma unroll
            for (int m = 0; m < 4; ++m)
#pragma unroll
                for (int n = 0; n < 2; ++n) { const float z = ZF(); acc[a][b][m][n] = (f32x4){z, z, z, z}; }
    bf16x8 At[4][2], B0[2][2], B1[2][2];
    const char* cA = (const char*)g.A + (size_t)cur.pm * 2 * hstepA + (size_t)((cur.pn >> g.koff_shift) * g.koff_mul + cur.k0) * 2;
    const char* cB = (const char*)g.Bt + (size_t)cur.pn * 2 * hstepB + (size_t)cur.k0 * 2;
    PG8_STAGE(PG8_SB(0, 0), cB, voffB); PG8_STAGE(PG8_SB(0, 1), cB + hstepB, voffB); PG8_STAGE(PG8_SA(0, 0), cA, voffA); PG8_STAGE(PG8_SA(0, 1), cA + hstepA, voffA);
    if (wr == 1) PG8_BAR;
    PG8_WAIT_V(2); PG8_BAR;
    PG8_STAGE(PG8_SB(1, 0), cB + kstep, voffB); PG8_STAGE(PG8_SA(1, 0), cA + kstep, voffA); PG8_STAGE(PG8_SB(1, 1), cB + hstepB + kstep, voffB);
    PG8_WAIT_V(6); PG8_BAR;
    for (;;) {
        const bool has_next = unit_next(g, ui + 1, nxt);
        const char* nA = has_next ? (const char*)g.A + (size_t)nxt.pm * 2 * hstepA + (size_t)((nxt.pn >> g.koff_shift) * g.koff_mul + nxt.k0) * 2 : cA;
        const char* nB = has_next ? (const char*)g.Bt + (size_t)nxt.pn * 2 * hstepB + (size_t)nxt.k0 * 2 : cB;
        const int nt = cur.nt;
        for (int t = 0; t < nt; t += 2) {
            const bool last = (t == nt - 2);
            const char* a1 = cA + (size_t)(t + 1) * kstep;
            const char* a2 = last ? nA : cA + (size_t)(t + 2) * kstep; const char* b2 = last ? nB : cB + (size_t)(t + 2) * kstep;
            const char* a3 = a2 + kstep; const char* b3 = b2 + kstep;
            PG8_LDB(B0, 0, 0); PG8_LDB(B1, 0, 1); PG8_SCHED; PG8_LDA(At, 0, 0); PG8_STAGE(PG8_SA(1, 1), a1 + hstepA, voffA);
            PG8_WAIT_V(8); PG8_WAIT_L(0); PG8_BAR; PG8_MMA(0, 0, At, B0); PG8_MMA(0, 1, At, B1); PG8_BAR; PG8_SCHED;
            PG8_LDA(At, 0, 1); PG8_STAGE(PG8_SB(0, 0), b2, voffB); PG8_STAGE(PG8_SB(0, 1), b2 + hstepB, voffB); PG8_STAGE(PG8_SA(0, 0), a2, voffA);
            PG8_WAIT_V(8); PG8_WAIT_L(0); PG8_BAR; PG8_MMA(1, 0, At, B0); PG8_MMA(1, 1, At, B1); PG8_BAR; PG8_SCHED;
            PG8_LDB(B0, 1, 0); PG8_LDB(B1, 1, 1); PG8_SCHED; PG8_LDA(At, 1, 0); PG8_STAGE(PG8_SA(0, 1), a2 + hstepA, voffA);
            PG8_WAIT_V(8); PG8_WAIT_L(0); PG8_BAR; PG8_MMA(0, 0, At, B0); PG8_MMA(0, 1, At, B1); PG8_BAR; PG8_SCHED;
            PG8_LDA(At, 1, 1); PG8_STAGE(PG8_SB(1, 0), b3, voffB); PG8_STAGE(PG8_SB(1, 1), b3 + hstepB, voffB); PG8_STAGE(PG8_SA(1, 0), a3, voffA);
            PG8_WAIT_V(8); PG8_WAIT_L(0); PG8_BAR; PG8_MMA(1, 0, At, B0); PG8_MMA(1, 1, At, B1); PG8_BAR; PG8_SCHED;
        }
        if (wr == 0) PG8_BAR;
        { int g2 = gid; asm volatile("" : "+s"(g2));
          const GemmD ge = make_gemm(p, g2, layer, dry); epilogue(p, ge, lds, acc, cur, wr, wc, fr, fq); }
        if (!has_next) break;
#pragma unroll
        for (int a = 0; a < 2; ++a)
#pragma unroll
            for (int b = 0; b < 2; ++b)
#pragma unroll
                for (int m = 0; m < 4; ++m)
#pragma unroll
                    for (int n = 0; n < 2; ++n) { const float z = ZF(); acc[a][b][m][n] = (f32x4){z, z, z, z}; }
        cur = nxt; cA = nA; cB = nB; ++ui;
        if (wr == 1) PG8_BAR;
    }
    PG8_WAIT_V(0);
    PG8_BAR;
#undef PG8_SA
#undef PG8_SB
#undef PG8_STAGE
#undef PG8_LDA
#undef PG8_LDB
#undef PG8_MMA
#undef PG8_WAIT_V
#undef PG8_WAIT_L
#undef PG8_BAR
#undef PG8_SCHED
}
#endif

DI void rope_cs(int pos, int k, float& cs, float& sn) { const float f = exp2f(-(float)k * (13.287712379549449f / 16.f)); sincosf((float)pos * f, &sn, &cs); }

DI void rope_table(const Params& p) {
    const int gt = BIDX() * NTHREADS + TIDX();
    if (gt < 64 * 16) { const int pos = gt >> 4, k = gt & 15; float cs, sn; rope_cs(pos, k, cs, sn); float* tb = (float*)(p.ws + WS_ROPE); tb[pos * 32 + k] = cs; tb[pos * 32 + 16 + k] = sn; }
}
DI float sum8(float v) { v += __shfl_xor(v, 1); v += __shfl_xor(v, 2); v += __shfl_xor(v, 4); return v; }
DI void mla_rowop_a3(const Params& p, int j) {
    const int lane = TIDX() & 63, gw = BIDX() * NWAVES + (TIDX() >> 6), nw = GDIM() * NWAVES;
    const float* dq = (const float*)(p.ws + WS_T + T_DQKV);
    bf16_t* cq = (bf16_t*)(p.ws + WS_T + T_CQ); bf16_t* ckv = (bf16_t*)(p.ws + WS_T + T_CKV); bf16_t* kr = (bf16_t*)(p.ws + WS_T + T_KR);
    const float* tb = (const float*)(p.ws + WS_ROPE);
    const float* gq = IN(p, 8) + j * 384; const float* gkv = IN(p, 11) + j * 256; const float* gkr = IN(p, 13) + j * 384 + 192 + 128;
    const bool isq1 = lane < 32, iskr = lane >= 32 && lane < 48;
    const f32x4 g0 = *(const f32x4*)(gq + 4 * lane);
    const f32x4 g1 = isq1 ? *(const f32x4*)(gq + 256 + 4 * lane) : *(const f32x4*)(gkv + 4 * (lane - 32));
    f32x4 g2 = {0.f, 0.f, 0.f, 0.f}; if (lane < 32) g2 = *(const f32x4*)(gkv + 128 + 4 * lane); else if (iskr) g2 = *(const f32x4*)(gkr + 4 * (lane - 32));
    for (int r0 = gw * 2; r0 < MROWS; r0 += nw * 2) {
        f32x4 v[2][3]; float s0[2], s1[2], s2[2];
#pragma unroll
        for (int rr = 0; rr < 2; ++rr) {
            const float* s = dq + (size_t)(r0 + rr) * 768 + 4 * lane;
            v[rr][0] = *(const f32x4*)s; v[rr][1] = *(const f32x4*)(s + 256); v[rr][2] = lane < 48 ? *(const f32x4*)(s + 512) : (f32x4){0.f, 0.f, 0.f, 0.f};
        }
#pragma unroll
        for (int rr = 0; rr < 2; ++rr) {
            const float q0 = v[rr][0][0] * v[rr][0][0] + v[rr][0][1] * v[rr][0][1] + v[rr][0][2] * v[rr][0][2] + v[rr][0][3] * v[rr][0][3];
            const float q1 = v[rr][1][0] * v[rr][1][0] + v[rr][1][1] * v[rr][1][1] + v[rr][1][2] * v[rr][1][2] + v[rr][1][3] * v[rr][1][3];
            const float q2 = v[rr][2][0] * v[rr][2][0] + v[rr][2][1] * v[rr][2][1] + v[rr][2][2] * v[rr][2][2] + v[rr][2][3] * v[rr][2][3];
            s0[rr] = q0 + (isq1 ? q1 : 0.f); s1[rr] = (isq1 ? 0.f : q1) + (lane < 32 ? q2 : 0.f); s2[rr] = iskr ? q2 : 0.f;
        }
#pragma unroll
        for (int o = 32; o; o >>= 1) {
#pragma unroll
            for (int rr = 0; rr < 2; ++rr) { s0[rr] += __shfl_xor(s0[rr], o); s1[rr] += __shfl_xor(s1[rr], o); s2[rr] += __shfl_xor(s2[rr], o); }
        }
#pragma unroll
        for (int rr = 0; rr < 2; ++rr) {
            const int row = r0 + rr, b = row / RPB, rb = row - b * RPB;
            const float i0 = rsqrtf(s0[rr] * (1.f / 384.f) + EPS), i1 = rsqrtf(s1[rr] * (1.f / 256.f) + EPS), i2 = rsqrtf(s2[rr] * (1.f / 64.f) + EPS);
            { const f32x4 o = v[rr][0] * i0 * g0; u32x2 w = {pk2(o[0], o[1]), pk2(o[2], o[3])}; *(u32x2*)(cq + (size_t)row * 384 + 4 * lane) = w; }
            if (isq1) { const f32x4 o = v[rr][1] * i0 * g1; u32x2 w = {pk2(o[0], o[1]), pk2(o[2], o[3])}; *(u32x2*)(cq + (size_t)row * 384 + 256 + 4 * lane) = w; }
            else { const f32x4 o = v[rr][1] * i1 * g1; u32x2 w = {pk2(o[0], o[1]), pk2(o[2], o[3])}; *(u32x2*)(ckv + (size_t)row * 256 + 4 * (lane - 32)) = w; }
            if (lane < 32) { const f32x4 o = v[rr][2] * i1 * g2; u32x2 w = {pk2(o[0], o[1]), pk2(o[2], o[3])}; *(u32x2*)(ckv + (size_t)row * 256 + 128 + 4 * lane) = w; }
            f32x4 x = v[rr][2] * i2 * g2;
            f32x4 xp; xp[0] = __shfl_xor(x[0], 4); xp[1] = __shfl_xor(x[1], 4); xp[2] = __shfl_xor(x[2], 4); xp[3] = __shfl_xor(x[3], 4);
            if (iskr) {
                if (rb >= CTXL) {
                    const int t = rb - CTXL, d0 = 4 * (lane - 32), q4 = d0 >> 4, k0 = d0 & 15, pos = q4 < 2 ? (t >> 6) : (t & 63);
                    const f32x4 cs = *(const f32x4*)(tb + pos * 32 + k0), sn = *(const f32x4*)(tb + pos * 32 + 16 + k0);
                    x = x * cs + ((q4 & 1) ? xp : -xp) * sn;
                }
                u32x2 w = {pk2(x[0], x[1]), pk2(x[2], x[3])}; *(u32x2*)(kr + (size_t)row * 64 + 4 * (lane - 32)) = w;
            }
        }
    }
}
DI void mla_rowop_a5(const Params& p, int j, bool latonly) {
    const int lane = TIDX() & 63, gw = BIDX() * NWAVES + (TIDX() >> 6), nw = GDIM() * NWAVES;
    const int hg = lane >> 3, l8 = lane & 7, q4 = l8 >> 1, k0 = 8 * (l8 & 1);
    bf16_t* qp = (bf16_t*)(p.ws + WS_T + T_QPRE); bf16_t* kv = (bf16_t*)(p.ws + WS_T + T_KVPRE);
    const float* tb = (const float*)(p.ws + WS_ROPE);
    const float* gqk = IN(p, 13) + j * 384;
    f32x4 gqn[4], gqr[2], gkn[4];
#pragma unroll
    for (int i = 0; i < 4; ++i) { gqn[i] = *(const f32x4*)(gqk + 16 * l8 + 4 * i); gkn[i] = *(const f32x4*)(gqk + 192 + 16 * l8 + 4 * i); }
    gqr[0] = *(const f32x4*)(gqk + 128 + 8 * l8); gqr[1] = *(const f32x4*)(gqk + 128 + 8 * l8 + 4);
    for (int r0 = gw * 2; r0 < MROWS; r0 += nw * 2) {
        const int b = r0 / RPB, rb0 = r0 - b * RPB; const bool isctx = rb0 < CTXL;
        const bool doq = !(latonly && isctx);
        u32x4 qn[2][2], qrp[2], kn[2][2];
#pragma unroll
        for (int rr = 0; rr < 2; ++rr) {
            const bf16_t* qr = qp + (size_t)(r0 + rr) * 1536 + hg * 192; const bf16_t* kr_ = kv + (size_t)(r0 + rr) * 2048 + hg * 256 + 16 * l8;
            if (doq) { qn[rr][0] = *(const u32x4*)(qr + 16 * l8); qn[rr][1] = *(const u32x4*)(qr + 16 * l8 + 8); qrp[rr] = *(const u32x4*)(qr + 128 + 8 * l8); }
            else { qn[rr][0] = qn[rr][1] = qrp[rr] = (u32x4){0, 0, 0, 0}; }
            kn[rr][0] = *(const u32x4*)kr_; kn[rr][1] = *(const u32x4*)(kr_ + 8);
        }
#pragma unroll
        for (int rr = 0; rr < 2; ++rr) {
            const int row = r0 + rr;
            float a[16], r[8], k[16];
#pragma unroll
            for (int i = 0; i < 4; ++i) { a[2 * i] = bflo(qn[rr][0][i]); a[2 * i + 1] = bfhi(qn[rr][0][i]); a[8 + 2 * i] = bflo(qn[rr][1][i]); a[8 + 2 * i + 1] = bfhi(qn[rr][1][i]);
                r[2 * i] = bflo(qrp[rr][i]); r[2 * i + 1] = bfhi(qrp[rr][i]);
                k[2 * i] = bflo(kn[rr][0][i]); k[2 * i + 1] = bfhi(kn[rr][0][i]); k[8 + 2 * i] = bflo(kn[rr][1][i]); k[8 + 2 * i + 1] = bfhi(kn[rr][1][i]); }
            float sa = 0.f, sr = 0.f, sk = 0.f;
#pragma unroll
            for (int i = 0; i < 16; ++i) { sa += a[i] * a[i]; sk += k[i] * k[i]; }
#pragma unroll
            for (int i = 0; i < 8; ++i) sr += r[i] * r[i];
            sa = sum8(sa); sr = sum8(sr); sk = sum8(sk);
            const float ia = rsqrtf(sa * (1.f / 128.f) + EPS) * QSCALE, ir = rsqrtf(sr * (1.f / 64.f) + EPS), ik = rsqrtf(sk * (1.f / 128.f) + EPS);
            if (doq) {
                bf16_t* qr = qp + (size_t)row * 1536 + hg * 192;
                u32x4 w0, w1;
#pragma unroll
                for (int i = 0; i < 4; ++i) { w0[i] = pk2(a[2 * i] * ia * gqn[i >> 1][(2 * i) & 3], a[2 * i + 1] * ia * gqn[i >> 1][(2 * i + 1) & 3]);
                    w1[i] = pk2(a[8 + 2 * i] * ia * gqn[2 + (i >> 1)][(2 * i) & 3], a[8 + 2 * i + 1] * ia * gqn[2 + (i >> 1)][(2 * i + 1) & 3]); }
                *(u32x4*)(qr + 16 * l8) = w0; *(u32x4*)(qr + 16 * l8 + 8) = w1;
                float x[8];
#pragma unroll
                for (int i = 0; i < 8; ++i) x[i] = r[i] * ir * gqr[i >> 2][i & 3];
                if (!isctx) {
                    const int t = rb0 + rr - CTXL, pos = q4 < 2 ? (t >> 6) : (t & 63);
                    const f32x4 c0 = *(const f32x4*)(tb + pos * 32 + k0), c1 = *(const f32x4*)(tb + pos * 32 + k0 + 4), s0 = *(const f32x4*)(tb + pos * 32 + 16 + k0), s1 = *(const f32x4*)(tb + pos * 32 + 16 + k0 + 4);
#pragma unroll
                    for (int i = 0; i < 8; ++i) { const float xp = __shfl_xor(x[i], 2); const float cs = i < 4 ? c0[i & 3] : c1[i & 3], sn = i < 4 ? s0[i & 3] : s1[i & 3];
                        x[i] = x[i] * cs + ((q4 & 1) ? xp : -xp) * sn; }
                }
                u32x4 wr_;
#pragma unroll
                for (int i = 0; i < 4; ++i) wr_[i] = pk2(x[2 * i] * QSCALE, x[2 * i + 1] * QSCALE);
                *(u32x4*)(qr + 128 + 8 * l8) = wr_;
            }
            bf16_t* kr_ = kv + (size_t)row * 2048 + hg * 256 + 16 * l8;
            u32x4 k0w, k1w;
#pragma unroll
            for (int i = 0; i < 4; ++i) { k0w[i] = pk2(k[2 * i] * ik * gkn[i >> 1][(2 * i) & 3], k[2 * i + 1] * ik * gkn[i >> 1][(2 * i + 1) & 3]);
                k1w[i] = pk2(k[8 + 2 * i] * ik * gkn[2 + (i >> 1)][(2 * i) & 3], k[8 + 2 * i + 1] * ik * gkn[2 + (i >> 1)][(2 * i + 1) & 3]); }
            *(u32x4*)kr_ = k0w; *(u32x4*)(kr_ + 8) = k1w;
        }
    }
}

namespace attn {
constexpr int LDQ = 1536, LDKN = 2048, LDKR = 64, LDO = 1024, KVBLK = 64;
constexpr int SHM_V = KVBLK * 128 * 2, SHM_KN = KVBLK * 128 * 2, SHM_KR = KVBLK * 64 * 2;
constexpr int OFF_V = 0, OFF_KN = 2 * SHM_V, OFF_KR = OFF_KN + 2 * SHM_KN, OFF_WS = OFF_KR + 2 * SHM_KR, OFF_QR = OFF_WS + NWAVES * 64 * 4, LDS_BYTES = OFF_QR + NWAVES * 4096;
constexpr float THRL = 8.f * 1.4426950408889634f;
#define KSWZ(row, colB) ((row) * 256 + ((colB) ^ (((row) & 7) << 4)))
#define RSWZ(row, colB) ((row) * 128 + ((colB) ^ ((((row) >> 1) & 7) << 4)))
#define SBAR() __builtin_amdgcn_sched_barrier(0)
DI int crow(int r, int hi) { return (r & 3) + 8 * (r >> 2) + 4 * hi; }
DI unsigned cvtpk(float lo, float hi) { unsigned r; asm volatile("v_cvt_pk_bf16_f32 %0, %1, %2" : "=v"(r) : "v"(lo), "v"(hi)); return r; }

DI void partialSM(f32x16& p0, f32x16& p1, float& m_reg, float& mn, float& alpha) {
    float pmax = p0[0];
#pragma unroll
    for (int r = 1; r < 16; ++r) pmax = fmaxf(pmax, p0[r]);
#pragma unroll
    for (int r = 0; r < 16; ++r) pmax = fmaxf(pmax, p1[r]);
    { auto rr = __builtin_amdgcn_permlane32_swap(__float_as_uint(pmax), __float_as_uint(pmax), false, false);
      pmax = fmaxf(__uint_as_float(rr[0]), __uint_as_float(rr[1])); }
    if (__builtin_expect(__all(pmax - m_reg <= THRL), 1)) { mn = m_reg; alpha = 1.f; }
    else { mn = fmaxf(m_reg, pmax); alpha = __builtin_amdgcn_exp2f(m_reg - mn); m_reg = mn; }
#pragma unroll
    for (int r = 0; r < 16; ++r) p0[r] = p0[r] - mn;
#pragma unroll
    for (int r = 0; r < 16; ++r) p1[r] = p1[r] - mn;
#pragma unroll
    for (int r = 0; r < 16; ++r) p0[r] = __builtin_amdgcn_exp2f(p0[r]);
}
DI void finishSM(f32x16& p0, f32x16& p1, float alpha, float& l_reg, bf16x8& pa0, bf16x8& pa1, bf16x8& pa2, bf16x8& pa3) {
#pragma unroll
    for (int r = 0; r < 16; ++r) p1[r] = __builtin_amdgcn_exp2f(p1[r]);
    float ps = 0;
#pragma unroll
    for (int r = 0; r < 16; ++r) ps += p0[r];
#pragma unroll
    for (int r = 0; r < 16; ++r) ps += p1[r];
    { auto rr = __builtin_amdgcn_permlane32_swap(__float_as_uint(ps), __float_as_uint(ps), false, false);
      ps = __uint_as_float(rr[0]) + __uint_as_float(rr[1]); }
    l_reg = l_reg * alpha + ps;
#define PK4(P, BASE, OUT) do { unsigned a0 = cvtpk(P[BASE + 0], P[BASE + 1]), a1 = cvtpk(P[BASE + 2], P[BASE + 3]);   \
    unsigned b0 = cvtpk(P[BASE + 4], P[BASE + 5]), b1 = cvtpk(P[BASE + 6], P[BASE + 7]);                              \
    auto r0 = __builtin_amdgcn_permlane32_swap(a0, b0, false, false); auto r1 = __builtin_amdgcn_permlane32_swap(a1, b1, false, false); \
    u32x4 w = {r0[0], r1[0], r0[1], r1[1]}; OUT = *reinterpret_cast<bf16x8*>(&w); } while (0)
    PK4(p0, 0, pa0); PK4(p0, 8, pa1); PK4(p1, 0, pa2); PK4(p1, 8, pa3);
#undef PK4
}
DI void qkt(f32x16& p0, f32x16& p1, const char* Kn, const char* Kr, const bf16x8* qr, const char* qrl, int r32, int hi) {
    p0 = f32x16{}; p1 = f32x16{};
#pragma unroll
    for (int d0 = 0; d0 < 8; ++d0) { const int cb = (d0 * 16 + hi * 8) * 2;
        const bf16x8 b0 = *reinterpret_cast<const bf16x8*>(Kn + KSWZ(r32, cb));
        const bf16x8 b1 = *reinterpret_cast<const bf16x8*>(Kn + KSWZ(32 + r32, cb));
        p0 = __builtin_amdgcn_mfma_f32_32x32x16_bf16(b0, qr[d0], p0, 0, 0, 0);
        p1 = __builtin_amdgcn_mfma_f32_32x32x16_bf16(b1, qr[d0], p1, 0, 0, 0); }
#pragma unroll
    for (int d0 = 0; d0 < 4; ++d0) { const int cb = (d0 * 16 + hi * 8) * 2;
        const bf16x8 b0 = *reinterpret_cast<const bf16x8*>(Kr + RSWZ(r32, cb));
        const bf16x8 b1 = *reinterpret_cast<const bf16x8*>(Kr + RSWZ(32 + r32, cb));
        const bf16x8 qf = *reinterpret_cast<const bf16x8*>(qrl + d0 * 1024);
        p0 = __builtin_amdgcn_mfma_f32_32x32x16_bf16(b0, qf, p0, 0, 0, 0);
        p1 = __builtin_amdgcn_mfma_f32_32x32x16_bf16(b1, qf, p1, 0, 0, 0); }
}
DI int v_st(int k, int c) { const int kk = (k & ~0xC) | ((k & 4) << 1) | ((k & 8) >> 1); return ((kk >> 3) * 4 + (c >> 5)) * 512 + ((kk & 7) * 32 + (c & 31)) * 2; }
DI int v_rd_base(int lane) { return ((lane & 3) << 3) | (((lane >> 2) & 3) << 6) | (((lane >> 4) & 1) << 5) | (((lane >> 5) & 1) << 8); }
constexpr int v_rd_off(int d0, int ks, int half) { return d0 * 512 + ks * 4096 + half * 2048; }
template <int OFF> DI s16x4 tr_read(int vb) { s16x4 r; asm volatile("ds_read_b64_tr_b16 %0, %1 offset:%2" : "=&v"(r) : "v"(vb), "i"(OFF) : "memory"); return r; }
template <int D0> DI void pv_one(f32x16& od, int vb, bf16x8 pa0, bf16x8 pa1, bf16x8 pa2, bf16x8 pa3) {
    const s16x4 l0 = tr_read<v_rd_off(D0, 0, 0)>(vb), h0 = tr_read<v_rd_off(D0, 0, 1)>(vb), l1 = tr_read<v_rd_off(D0, 1, 0)>(vb), h1 = tr_read<v_rd_off(D0, 1, 1)>(vb);
    const s16x4 l2 = tr_read<v_rd_off(D0, 2, 0)>(vb), h2 = tr_read<v_rd_off(D0, 2, 1)>(vb), l3 = tr_read<v_rd_off(D0, 3, 0)>(vb), h3 = tr_read<v_rd_off(D0, 3, 1)>(vb);
    asm volatile("s_waitcnt lgkmcnt(0)" ::: "memory"); SBAR();
#define PK(L, H) (bf16x8){L[0], L[1], L[2], L[3], H[0], H[1], H[2], H[3]}
    od = __builtin_amdgcn_mfma_f32_32x32x16_bf16(pa0, PK(l0, h0), od, 0, 0, 0);
    od = __builtin_amdgcn_mfma_f32_32x32x16_bf16(pa1, PK(l1, h1), od, 0, 0, 0);
    od = __builtin_amdgcn_mfma_f32_32x32x16_bf16(pa2, PK(l2, h2), od, 0, 0, 0);
    od = __builtin_amdgcn_mfma_f32_32x32x16_bf16(pa3, PK(l3, h3), od, 0, 0, 0);
#undef PK
}
DI void pv_d0(f32x16* o, int vb, bf16x8 pa0, bf16x8 pa1, bf16x8 pa2, bf16x8 pa3) {
    pv_one<0>(o[0], vb, pa0, pa1, pa2, pa3); pv_one<1>(o[1], vb, pa0, pa1, pa2, pa3); pv_one<2>(o[2], vb, pa0, pa1, pa2, pa3); pv_one<3>(o[3], vb, pa0, pa1, pa2, pa3);
}
DI void attn_unit(const bf16_t* __restrict__ Qb, const bf16_t* __restrict__ Knb, const bf16_t* __restrict__ Krb, const bf16_t* __restrict__ Vb, bf16_t* __restrict__ Ob, int seq, char* lds) {
    const int tid = TIDX(), wid = tid >> 6, lane = tid & 63, r32 = lane & 31, hi = lane >> 5;
    char* V_lds = lds + OFF_V; char* Kn_lds = lds + OFF_KN; char* Kr_lds = lds + OFF_KR;
    float* ws = (float*)(lds + OFF_WS) + wid * 64; float* li_l = ws; float* al_l = ws + 32;
    float m_reg = -1e30f, l_reg = 0; f32x16 o[4] = {}; bf16x8 qr[8];
    const bf16_t* Qw = Qb + (long)(wid * 32 + r32) * LDQ + hi * 8;
    char* qrl = lds + OFF_QR + wid * 4096 + lane * 16;
#pragma unroll
    for (int d0 = 0; d0 < 8; ++d0) qr[d0] = *reinterpret_cast<const bf16x8*>(Qw + d0 * 16);
#pragma unroll
    for (int d0 = 0; d0 < 4; ++d0) *reinterpret_cast<bf16x8*>(qrl + d0 * 1024) = *reinterpret_cast<const bf16x8*>(Qw + 128 + d0 * 16);
    const int sr = tid >> 4, sc = (tid & 15) * 8, vst0 = v_st(sr, sc), vst1 = v_st(32 + sr, sc);
    const int rr_ = tid >> 3, rc_ = (tid & 7) * 8;
    const int vb0 = (int)(uintptr_t)V_lds + v_rd_base(lane);
    struct { bf16x8 vs0, vs1, ks0, ks1, kr; } sr_[1];
#define SLOAD(i, k0) do { sr_[i].vs0 = *(const bf16x8*)(&Vb[(long)((k0) + sr) * LDKN + sc]); sr_[i].vs1 = *(const bf16x8*)(&Vb[(long)((k0) + 32 + sr) * LDKN + sc]); \
    sr_[i].ks0 = *(const bf16x8*)(&Knb[(long)((k0) + sr) * LDKN + sc]); sr_[i].ks1 = *(const bf16x8*)(&Knb[(long)((k0) + 32 + sr) * LDKN + sc]); \
    sr_[i].kr = *(const bf16x8*)(&Krb[(long)((k0) + rr_) * LDKR + rc_]); } while (0)
#define SWRITE(b, i) do { *(bf16x8*)(V_lds + (b) * SHM_V + vst0) = sr_[i].vs0; *(bf16x8*)(V_lds + (b) * SHM_V + vst1) = sr_[i].vs1; const int kc = sc * 2; \
    *(bf16x8*)(Kn_lds + (b) * SHM_KN + KSWZ(sr, kc)) = sr_[i].ks0; *(bf16x8*)(Kn_lds + (b) * SHM_KN + KSWZ(32 + sr, kc)) = sr_[i].ks1; \
    *(bf16x8*)(Kr_lds + (b) * SHM_KR + RSWZ(rr_, rc_ * 2)) = sr_[i].kr; } while (0)
#define SWAIT() asm volatile("s_waitcnt vmcnt(0)" ::: "memory")
#define RESC(a) do { if (__any((a) < 1.f)) { if (hi == 0) al_l[r32] = (a); asm volatile("s_waitcnt lgkmcnt(0)" ::: "memory"); \
    _Pragma("unroll") for (int d = 0; d < 4; ++d) _Pragma("unroll") for (int r = 0; r < 16; ++r) o[d][r] *= al_l[crow(r, hi)]; } } while (0)
    f32x16 pA0, pA1, pB0, pB1; float mnA, mnB, alA, alB; bf16x8 pa0, pa1, pa2, pa3; const int NT = seq / KVBLK;
    constexpr int SE = 0, SO = 0;
    SLOAD(SE, 0); asm volatile("s_waitcnt vmcnt(0)" ::: "memory"); SWRITE(0, SE); __syncthreads();
    qkt(pA0, pA1, Kn_lds, Kr_lds, qr, qrl, r32, hi); partialSM(pA0, pA1, m_reg, mnA, alA);
    SLOAD(SO, KVBLK);
    SWAIT(); SWRITE(1, SO); __syncthreads();
    for (int j = 1; j + 1 < NT; j += 2) {
        SBAR(); qkt(pB0, pB1, Kn_lds + SHM_KN, Kr_lds + SHM_KR, qr, qrl, r32, hi);
        finishSM(pA0, pA1, alA, l_reg, pa0, pa1, pa2, pa3); SBAR();
        SLOAD(SE, (j + 1) * KVBLK); SBAR();
        pv_d0(o, vb0, pa0, pa1, pa2, pa3); partialSM(pB0, pB1, m_reg, mnB, alB);
        __syncthreads(); SWAIT(); SWRITE(0, SE);
        RESC(alB); __syncthreads();
        SBAR(); qkt(pA0, pA1, Kn_lds, Kr_lds, qr, qrl, r32, hi);
        finishSM(pB0, pB1, alB, l_reg, pa0, pa1, pa2, pa3); SBAR();
        SLOAD(SO, (j + 2) * KVBLK); SBAR();
        pv_d0(o, vb0 + SHM_V, pa0, pa1, pa2, pa3); partialSM(pA0, pA1, m_reg, mnA, alA);
        __syncthreads(); SWAIT(); SWRITE(1, SO);
        RESC(alA); __syncthreads();
    }
    SBAR(); qkt(pB0, pB1, Kn_lds + SHM_KN, Kr_lds + SHM_KR, qr, qrl, r32, hi);
    finishSM(pA0, pA1, alA, l_reg, pa0, pa1, pa2, pa3); SBAR();
    pv_d0(o, vb0, pa0, pa1, pa2, pa3); partialSM(pB0, pB1, m_reg, mnB, alB);
    __syncthreads(); RESC(alB);
    finishSM(pB0, pB1, alB, l_reg, pa0, pa1, pa2, pa3); SBAR();
    pv_d0(o, vb0 + SHM_V, pa0, pa1, pa2, pa3);
    if (hi == 0) li_l[r32] = l_reg; asm volatile("s_waitcnt lgkmcnt(0)" ::: "memory");
    float rli[16];
#pragma unroll
    for (int r = 0; r < 16; ++r) rli[r] = __builtin_amdgcn_rcpf(li_l[crow(r, hi)]);
    bf16_t* Ow = Ob + (long)(wid * 32) * LDO;
#pragma unroll
    for (int r = 0; r < 16; ++r) { const int orow = crow(r, hi);
#pragma unroll
        for (int d0 = 0; d0 < 4; ++d0) Ow[(long)orow * LDO + d0 * 32 + r32] = (bf16_t)f2bf(o[d0][r] * rli[r]); }
    __syncthreads();
#undef SLOAD
#undef SWRITE
#undef SWAIT
#undef RESC
}
}
DI void attn_phase(const Params& p, bool need_ctx, char* lds) {
    const bf16_t* qp = (const bf16_t*)(p.ws + WS_T + T_QPRE); const bf16_t* kv = (const bf16_t*)(p.ws + WS_T + T_KVPRE); const bf16_t* kr = (const bf16_t*)(p.ws + WS_T + T_KR);
    bf16_t* O = (bf16_t*)(p.ws + WS_H);
    const int G = GDIM(), bx = BIDX(), vcu = (G % 8 == 0) ? (bx % 8) * (G / 8) + bx / 8 : bx;
    const int nun = 512 + (need_ctx ? 32 : 0);
    for (int u = vcu; u < nun; u += G) {
        int b, h, qrow0, nkeys;
        if (u < 512) { const int bh = u >> 4, qb = u & 15; b = bh >> 3; h = bh & 7; qrow0 = b * RPB + CTXL + qb * 256; nkeys = RPB; }
        else { const int bh = u - 512; b = bh >> 3; h = bh & 7; qrow0 = b * RPB; nkeys = CTXL; }
        const size_t krow0 = (size_t)b * RPB;
        attn::attn_unit(qp + (size_t)qrow0 * 1536 + h * 192, kv + krow0 * 2048 + h * 256, kr + krow0 * 64, kv + krow0 * 2048 + h * 256 + 128,
                        O + (size_t)qrow0 * 1024 + h * 128, nkeys, lds);
    }
}

constexpr size_t S5_ABAR = 0, S5_A128 = 65536, S5_BFRAG = 131072, S5_CFRAG = 131072 + 1048576;
constexpr int S5_CH = 128, S5_NCH = RPB / S5_CH;
DI f32x2 cmul(f32x2 a, f32x2 b) { return (f32x2){a.x * b.x - a.y * b.y, a.x * b.y + a.y * b.x}; }
DI void s5_prep(const Params& p) {
    const int gt = BIDX() * NTHREADS + TIDX(), ntot = GDIM() * NTHREADS;
    unsigned char* base = p.ws + WS_S5C;
    for (int idx = gt; idx < 2 * 64 * 64; idx += ntot) {
        const int dir = idx >> 12, g = (idx >> 6) & 63, s = idx & 63;
        const float are = IN(p, 15)[idx], aim = IN(p, 16)[idx], dt = expf(IN(p, 17)[dir * 64 + g]);
        float sn, cs; sincosf(aim * dt, &sn, &cs); const float er = expf(are * dt);
        const f32x2 ab = {er * cs, er * sn};
        sincosf(aim * dt * (float)S5_CH, &sn, &cs); const float er2 = expf(are * dt * (float)S5_CH);
        ((f32x2*)(base + S5_ABAR))[idx] = ab; ((f32x2*)(base + S5_A128))[idx] = (f32x2){er2 * cs, er2 * sn};
    }
    for (int idx = gt; idx < 2 * 64 * 8 * 64; idx += ntot) {
        const int lane = idx & 63, blk = (idx >> 6) & 7, g = (idx >> 9) & 63, dir = idx >> 15;
        const int kp = 16 * blk + (lane & 15), q = lane >> 4, s = kp >> 1;
        u32x4 w = {0, 0, 0, 0};
        if (q < 2) {
            const int ai = (dir * 64 + g) * 64 + s;
            const float are = IN(p, 15)[ai], aim = IN(p, 16)[ai], dt = expf(IN(p, 17)[dir * 64 + g]);
            float sn, cs; sincosf(aim * dt, &sn, &cs); const float er = expf(are * dt);
            const f32x2 num = {er * cs - 1.f, er * sn}; const float den = are * are + aim * aim;
            const f32x2 coef = {(num.x * are + num.y * aim) / den, (num.y * are - num.x * aim) / den};
            float vals[8];
#pragma unroll
            for (int jj = 0; jj < 8; ++jj) { const int i = 8 * q + jj; const size_t bi = ((size_t)(dir * 64 + g) * 64 + s) * 16 + i;
                const f32x2 bb = cmul(coef, (f32x2){IN(p, 18)[bi], IN(p, 19)[bi]}); vals[jj] = (kp & 1) == 0 ? bb.x : bb.y; }
            w = (u32x4){pk2(vals[0], vals[1]), pk2(vals[2], vals[3]), pk2(vals[4], vals[5]), pk2(vals[6], vals[7])};
        }
        ((u32x4*)(base + S5_BFRAG))[idx] = w;
    }
    for (int idx = gt; idx < 2 * 64 * 4 * 64; idx += ntot) {
        const int lane = idx & 63, ks = (idx >> 6) & 3, g = (idx >> 8) & 63, dir = idx >> 14;
        const int i = lane & 15, q = lane >> 4; float vals[8];
#pragma unroll
        for (int jj = 0; jj < 8; ++jj) { const int kp = 32 * ks + 8 * q + jj, s = kp >> 1; const size_t ci = ((size_t)(dir * 64 + g) * 16 + i) * 64 + s;
            vals[jj] = (kp & 1) == 0 ? IN(p, 20)[ci] : -IN(p, 21)[ci]; }
        ((u32x4*)(base + S5_CFRAG))[idx] = (u32x4){pk2(vals[0], vals[1]), pk2(vals[2], vals[3]), pk2(vals[4], vals[5]), pk2(vals[6], vals[7])};
    }
}
constexpr int S5_L1S = 132, S5_L2S = 136, S5_WLDS = 12800;
template <bool PROJ, bool REV>
DI void s5_sub(const bf16x8 uf, const bf16x8 (&bf)[8], const bf16x8 (&cf)[4], f32x2 ab, f32x2& st, f32x4& yacc, char* wl, int lane) {
    float* L1 = (float*)wl; bf16_t* L2 = (bf16_t*)(wl + 8448);
    const int t = lane & 15, q = lane >> 4;
    const float zf = ZF(); const f32x4 zero4 = {zf, zf, zf, zf};
    LDS_FENCE();
#pragma unroll
    for (int blk = 0; blk < 8; ++blk) {
        const f32x4 d = __builtin_amdgcn_mfma_f32_16x16x32_bf16(bf[blk], uf, zero4, 0, 0, 0);
        *(f32x4*)(L1 + t * S5_L1S + 16 * blk + 4 * q) = d;
    }
    LDS_FENCE();
    f32x2 bu[16];
#pragma unroll
    for (int s = 0; s < 16; ++s) bu[s] = *(const f32x2*)(L1 + s * S5_L1S + 2 * lane);
#pragma unroll
    for (int s = 0; s < 16; ++s) {
        const int tt = REV ? 15 - s : s;
        const f32x2 b_ = bu[tt];
        const f32x2 n = {ab.x * st.x - ab.y * st.y + b_.x, ab.x * st.y + ab.y * st.x + b_.y};
        st = n;
        if (PROJ) ((unsigned*)L2)[tt * (S5_L2S / 2) + lane] = pk2(n.x, n.y);
    }
    if (PROJ) {
        LDS_FENCE();
#pragma unroll
        for (int ks = 0; ks < 4; ++ks) {
            const bf16x8 sf = *(const bf16x8*)(L2 + t * S5_L2S + 32 * ks + 8 * q);
            yacc = __builtin_amdgcn_mfma_f32_16x16x32_bf16(sf, cf[ks], yacc, 0, 0, 0);
        }
    }
}
DI void s5_load_frags(const Params& p, int dir, int g, int lane, bf16x8 (&bf)[8], bf16x8 (&cf)[4], f32x2& ab, f32x2& a128) {
    const unsigned char* base = p.ws + WS_S5C;
#pragma unroll
    for (int blk = 0; blk < 8; ++blk) bf[blk] = ((const bf16x8*)(base + S5_BFRAG))[((dir * 64 + g) * 8 + blk) * 64 + lane];
#pragma unroll
    for (int ks = 0; ks < 4; ++ks) cf[ks] = ((const bf16x8*)(base + S5_CFRAG))[((dir * 64 + g) * 4 + ks) * 64 + lane];
    ab = ((const f32x2*)(base + S5_ABAR))[(dir * 64 + g) * 64 + lane]; a128 = ((const f32x2*)(base + S5_A128))[(dir * 64 + g) * 64 + lane];
}
DI void s5_load_u(const bf16_t* h, int row0, int g, int lane, bf16x8 (&uf)[8]) {
    const int t = lane & 15, q = lane >> 4;
#pragma unroll
    for (int sb = 0; sb < 8; ++sb) { uf[sb] = (bf16x8){0, 0, 0, 0, 0, 0, 0, 0}; if (q < 2) uf[sb] = *(const bf16x8*)(h + (size_t)(row0 + 16 * sb + t) * DM + 16 * g + 8 * q); }
}
DI void s5_pass1(const Params& p, char* lds) {
    const int lane = TIDX() & 63, wave = TIDX() >> 6, gw = BIDX() * NWAVES + wave, nw = GDIM() * NWAVES;
    char* wl = lds + wave * S5_WLDS;
    const bf16_t* h = (const bf16_t*)(p.ws + WS_H);
    f32x2* E = (f32x2*)(p.ws + WS_T + T_S5E);
    for (int task = gw; task < NB * S5_NCH * 64; task += nw) {
        const int g = task & 63, bc = task >> 6, c = bc % S5_NCH, b = bc / S5_NCH;
        const int row0 = b * RPB + c * S5_CH;
        bf16x8 uf[8]; s5_load_u(h, row0, g, lane, uf);
        for (int dir = 0; dir < 2; ++dir) {
            bf16x8 bf[8], cf[4]; f32x2 ab, a128; s5_load_frags(p, dir, g, lane, bf, cf, ab, a128);
            f32x2 st = {0.f, 0.f}; f32x4 dummy = {0, 0, 0, 0};
            if (dir == 0) {
#pragma unroll
                for (int sb = 0; sb < 8; ++sb) s5_sub<false, false>(uf[sb], bf, cf, ab, st, dummy, wl, lane);
            } else {
#pragma unroll
                for (int sb = 0; sb < 8; ++sb) s5_sub<false, true>(uf[7 - sb], bf, cf, ab, st, dummy, wl, lane);
            }
            E[(((size_t)(b * 64 + g) * 2 + dir) * S5_NCH + c) * 64 + lane] = st;
        }
    }
}
template <int DIR> DI void s5_chain(const f32x2* Eb, f32x2* Sb, f32x2 a128) {
    f32x2 e[S5_NCH];
#pragma unroll
    for (int k = 0; k < S5_NCH; ++k) e[k] = Eb[k * 64];
    float zz = 0.f; asm volatile("" : "+v"(zz));
    f32x2 st = {zz, zz};
#pragma unroll
    for (int k = 0; k < S5_NCH; ++k) {
        const int c = DIR == 0 ? k : (k < 2 ? 1 - k : S5_NCH + 1 - k);
        Sb[c * 64] = st;
        st = cmul(a128, st); st.x += e[c].x; st.y += e[c].y;
    }
}
DI void s5_carry(const Params& p) {
    const int lane = TIDX() & 63, gw = BIDX() * NWAVES + (TIDX() >> 6), nw = GDIM() * NWAVES;
    for (int w = gw; w < NB * 64 * 2; w += nw) {
        const int dir = w & 1, g = (w >> 1) & 63;
        const f32x2 a128 = ((const f32x2*)(p.ws + WS_S5C + S5_A128))[(dir * 64 + g) * 64 + lane];
        const f32x2* Eb = (const f32x2*)(p.ws + WS_T + T_S5E) + (size_t)w * S5_NCH * 64 + lane;
        f32x2* Sb = (f32x2*)(p.ws + WS_T + T_S5S) + (size_t)w * S5_NCH * 64 + lane;
        if (dir == 0) s5_chain<0>(Eb, Sb, a128); else s5_chain<1>(Eb, Sb, a128);
    }
}
DI void s5_pass3(const Params& p, int j, bool latonly, char* lds) {
    const int lane = TIDX() & 63, wave = TIDX() >> 6, gw = BIDX() * NWAVES + wave, nw = GDIM() * NWAVES;
    char* wl = lds + wave * S5_WLDS;
    const bf16_t* h = (const bf16_t*)(p.ws + WS_H);
    const f32x2* S = (const f32x2*)(p.ws + WS_T + T_S5S);
    bf16_t* z = (bf16_t*)(p.ws + WS_T + T_Z);
    const float* dd = IN(p, 22) + j * 1024;
    for (int task = gw; task < NB * S5_NCH * 64; task += nw) {
        const int g = task & 63, bc = task >> 6, c = bc % S5_NCH, b = bc / S5_NCH;
        if (latonly && c < 2) continue;
        const int row0 = b * RPB + c * S5_CH;
        bf16x8 uf[8]; s5_load_u(h, row0, g, lane, uf);
        f32x4 yacc[8];
#pragma unroll
        for (int i = 0; i < 8; ++i) { const float z = ZF(); yacc[i] = (f32x4){z, z, z, z}; }
        for (int dir = 0; dir < 2; ++dir) {
            bf16x8 bf[8], cf[4]; f32x2 ab, a128; s5_load_frags(p, dir, g, lane, bf, cf, ab, a128);
            f32x2 st = S[(((size_t)(b * 64 + g) * 2 + dir) * S5_NCH + c) * 64 + lane];
            if (dir == 0) {
#pragma unroll
                for (int sb = 0; sb < 8; ++sb) s5_sub<true, false>(uf[sb], bf, cf, ab, st, yacc[sb], wl, lane);
            } else {
#pragma unroll
                for (int sb = 0; sb < 8; ++sb) s5_sub<true, true>(uf[7 - sb], bf, cf, ab, st, yacc[7 - sb], wl, lane);
            }
        }
        const int i = lane & 15, q = lane >> 4; const float dv = dd[16 * g + i];
#pragma unroll
        for (int sb = 0; sb < 8; ++sb)
#pragma unroll
            for (int r = 0; r < 4; ++r) {
                const size_t off = (size_t)(row0 + 16 * sb + 4 * q + r) * DM + 16 * g + i;
                const float y = bf2f(h[off]) * dv + yacc[sb][r];
                z[off] = (bf16_t)f2bf(gelu_tanh(y));
            }
    }
}


#ifndef S5_PROBE
#define S5_PROBE 0
#endif
#ifndef S5_REPS
#define S5_REPS 1
#endif
namespace s5v2 {
constexpr size_t C_APOW = 0, C_A128 = 589824, C_COEF = C_A128 + 65536;
constexpr size_t T_XS = 40 * MiB;
constexpr int L_WE = 0, L_CA = 0, L_TEND = 69632, L_CARRY = 69632  , L_BBAR = 69632  , L_KP = 104448, L_PW = 120832, L_APOW = 137216, L_C = 146432, RS = 136;
DI f32x2 cexp_(float re, float im) { float sn, cs; sincosf(im, &sn, &cs); const float e = expf(re); return (f32x2){e * cs, e * sn}; }
DI void prep(const Params& p) {
    const int gt = BIDX() * NTHREADS + TIDX(), ntot = GDIM() * NTHREADS;
    unsigned char* base = p.ws + WS_S5C;
    for (int idx = gt; idx < 2 * 64 * 64; idx += ntot) {
        const int dg = idx >> 6, s = idx & 63;
        const float are = IN(p, 15)[idx], aim = IN(p, 16)[idx], dt = expf(IN(p, 17)[dg]);
        for (int e = 0; e < 9; ++e) ((f32x2*)(base + C_APOW))[(dg * 9 + e) * 64 + s] = cexp_(are * dt * (float)e, aim * dt * (float)e);
        ((f32x2*)(base + C_A128))[idx] = cexp_(are * dt * 128.f, aim * dt * 128.f);
        const f32x2 ab = cexp_(are * dt, aim * dt); const f32x2 num = {ab.x - 1.f, ab.y}; const float den = are * are + aim * aim;
        ((f32x2*)(base + C_COEF))[idx] = (f32x2){(num.x * are + num.y * aim) / den, (num.y * are - num.x * aim) / den};
    }
}
template <int CTRL> DI float dppf(float v) { return __int_as_float(__builtin_amdgcn_update_dpp(0, __float_as_int(v), CTRL, 0xf, 0xf, false)); }
template <int DIR, int D> DI void scan_step(f32x4 (&e)[8], const char* lds, int q) {
    constexpr int CTRL = (DIR == 0 ? 0x110 : 0x100) + D;
    const f32x4* mk = (const f32x4*)(lds + L_PW) + (DIR * 16 + D) * 32;
#pragma unroll
    for (int blk = 0; blk < 8; ++blk) {
        const f32x4 m = mk[4 * blk + q];
        f32x4 sh; sh[0] = dppf<CTRL>(e[blk][0]); sh[1] = dppf<CTRL>(e[blk][1]); sh[2] = dppf<CTRL>(e[blk][2]); sh[3] = dppf<CTRL>(e[blk][3]);
        e[blk][0] += m[0] * sh[0] - m[1] * sh[1]; e[blk][1] += m[0] * sh[1] + m[1] * sh[0];
        e[blk][2] += m[2] * sh[2] - m[3] * sh[3]; e[blk][3] += m[2] * sh[3] + m[3] * sh[2];
    }
}
template <int DIR> DI void tile_stage1(const Params& p, int wgi, int g, int J, const bf16x8 (&uf)[4], char* lds, int lane) {
    const int n = lane & 15, q = lane >> 4;
    f32x4 e[8];
#pragma unroll
    for (int blk = 0; blk < 8; ++blk) { const float z = ZF(); e[blk] = (f32x4){z, z, z, z}; }
    const bf16_t* WE = (const bf16_t*)(lds + L_WE) + DIR * 128 * RS;
#pragma unroll
    for (int ks = 0; ks < 4; ++ks) {
        bf16x8 af[8];
#pragma unroll
        for (int blk = 0; blk < 8; ++blk) af[blk] = *(const bf16x8*)(WE + (16 * blk + n) * RS + 32 * ks + 8 * q);
        __builtin_amdgcn_sched_barrier(0);
#pragma unroll
        for (int blk = 0; blk < 8; ++blk) e[blk] = __builtin_amdgcn_mfma_f32_16x16x32_bf16(af[blk], uf[ks], e[blk], 0, 0, 0);
        __builtin_amdgcn_sched_barrier(0);
    }
    scan_step<DIR, 1>(e, lds, q); scan_step<DIR, 2>(e, lds, q); scan_step<DIR, 4>(e, lds, q); scan_step<DIR, 8>(e, lds, q);
    if (n == (DIR == 0 ? 15 : 0)) {
        float* te = (float*)(lds + L_TEND) + (DIR * 34 + J) * 128;
#pragma unroll
        for (int blk = 0; blk < 8; ++blk) *(f32x4*)(te + 16 * blk + 4 * q) = e[blk];
    }
    u32x4* xs = (u32x4*)(p.ws + WS_T + T_XS) + ((size_t)((wgi * 2 + DIR) * 34 + J) * 4) * 64 + lane;
    constexpr int C1 = (DIR == 0 ? 0x110 : 0x100) + 1;
#pragma unroll
    for (int ks = 0; ks < 4; ++ks) {
        u32x4 w;
#pragma unroll
        for (int hh = 0; hh < 2; ++hh) { const f32x4 v = e[2 * ks + hh];
            w[2 * hh] = pk2(dppf<C1>(v[0]), dppf<C1>(v[1])); w[2 * hh + 1] = pk2(dppf<C1>(v[2]), dppf<C1>(v[3])); }
        xs[ks * 64] = w;
    }
}
DI void load_u(const bf16_t* h, int row0, int g, int lane, bf16x8 (&uf)[4]) {
    const int n = lane & 15, q = lane >> 4;
#pragma unroll
    for (int ks = 0; ks < 4; ++ks) uf[ks] = *(const bf16x8*)(h + (size_t)(row0 + 8 * n + 2 * ks + (q >> 1)) * DM + 16 * g + 8 * (q & 1));
}
template <int DIR> DI void tile_stage3(const Params& p, int wgi, int J, const bf16x8 (&uf)[4], f32x4 (&Y)[8], char* lds, int lane) {
    const int n = lane & 15, q = lane >> 4;
    const u32x4* xs = (const u32x4*)(p.ws + WS_T + T_XS) + ((size_t)((wgi * 2 + DIR) * 34 + J) * 4) * 64 + lane;
    const f32x4* pw = (const f32x4*)(lds + L_PW) + (DIR * 16 + (DIR == 0 ? n : 15 - n)) * 32;
    const f32x4* cr = (const f32x4*)(lds + L_CARRY) + (DIR * 34 + J) * 32;
    bf16x8 sf[4];
#pragma unroll
    for (int ks = 0; ks < 4; ++ks) {
        const u32x4 xw = xs[ks * 64]; u32x4 w;
#pragma unroll
        for (int hh = 0; hh < 2; ++hh) {
            const int blk = 2 * ks + hh;
            const f32x4 a = pw[4 * blk + q], c = cr[4 * blk + q];
            const float s0 = bflo(xw[2 * hh]) + a[0] * c[0] - a[1] * c[1], s1 = bfhi(xw[2 * hh]) + a[0] * c[1] + a[1] * c[0];
            const float s2 = bflo(xw[2 * hh + 1]) + a[2] * c[2] - a[3] * c[3], s3 = bfhi(xw[2 * hh + 1]) + a[2] * c[3] + a[3] * c[2];
            w[2 * hh] = pk2(s0, s1); w[2 * hh + 1] = pk2(s2, s3);
        }
        sf[ks] = __builtin_bit_cast(bf16x8, w);
    }
    const bf16_t* CA = (const bf16_t*)(lds + L_CA) + DIR * 128 * RS;
    const bf16_t* KP = (const bf16_t*)(lds + L_KP) + DIR * 8 * 512;
#pragma unroll
    for (int t = 0; t < 8; ++t) {
        bf16x8 af[4], kf[4];
#pragma unroll
        for (int ks = 0; ks < 4; ++ks) {
            af[ks] = *(const bf16x8*)(CA + (16 * t + n) * RS + 32 * ks + 8 * q);
            const int idx = DIR == 0 ? t - 2 * ks : 2 * ks + 1 - t;
            if (idx >= 0) kf[ks] = *(const bf16x8*)(KP + idx * 512 + n * 32 + 8 * q);
        }
        __builtin_amdgcn_sched_barrier(0);
#pragma unroll
        for (int ks = 0; ks < 4; ++ks) {
            Y[t] = __builtin_amdgcn_mfma_f32_16x16x32_bf16(af[ks], sf[ks], Y[t], 0, 0, 0);
            const int idx = DIR == 0 ? t - 2 * ks : 2 * ks + 1 - t;
            if (idx >= 0) Y[t] = __builtin_amdgcn_mfma_f32_16x16x32_bf16(kf[ks], uf[ks], Y[t], 0, 0, 0);
        }
        __builtin_amdgcn_sched_barrier(0);
    }
}
DI void phase(const Params& p, int jl, char* lds) {
    const bf16_t* h = (const bf16_t*)(p.ws + WS_H); bf16_t* z = (bf16_t*)(p.ws + WS_T + T_Z);
    const unsigned char* cb = p.ws + WS_S5C;
    for (int wg0 = BIDX(); wg0 < NB * 64; wg0 += GDIM()) {
        const int tid = TIDX(), lane = tid & 63, wave = __builtin_amdgcn_readfirstlane(tid >> 6);
        const int wgi = (GDIM() == NB * 64) ? (wg0 & 7) * 32 + (wg0 >> 3) : wg0;
        const int b = wgi >> 6, g = wgi & 63;
        f32x2* Lap = (f32x2*)(lds + L_APOW); f32x2* Lbb = (f32x2*)(lds + L_BBAR); f32x2* Lc = (f32x2*)(lds + L_C);
        for (int rep3 = 0; rep3 < (S5_PROBE == 3 ? S5_REPS : 1); ++rep3) {
        for (int idx = tid; idx < 2 * 9 * 64; idx += NTHREADS) { const int dir = idx / 576, r = idx - dir * 576; Lap[idx] = ((const f32x2*)(cb + C_APOW))[(dir * 64 + g) * 576 + r]; }
        for (int idx = tid; idx < 2 * 1024; idx += NTHREADS) {
            const int dir = idx >> 10, r = idx & 1023;
            const size_t gi = (size_t)(dir * 64 + g) * 1024 + r;
            Lbb[idx] = cmul(((const f32x2*)(cb + C_COEF))[(dir * 64 + g) * 64 + (r >> 4)], (f32x2){IN(p, 18)[gi], IN(p, 19)[gi]});
            Lc[idx] = (f32x2){IN(p, 20)[gi], IN(p, 21)[gi]};
        }
        __syncthreads();
        for (int idx = tid; idx < 2 * 128 * 64; idx += NTHREADS) {
            const int dir = idx >> 13, kp = (idx >> 6) & 127, c2 = (idx & 63) * 2, pp = kp >> 1, part = kp & 1, t = c2 >> 4, i = c2 & 15;
            const f32x2 ap = Lap[(dir * 9 + (dir == 0 ? 7 - t : t)) * 64 + pp];
            const f32x2 b0 = cmul(ap, Lbb[(dir * 64 + pp) * 16 + i]), b1 = cmul(ap, Lbb[(dir * 64 + pp) * 16 + i + 1]);
            *(unsigned*)((bf16_t*)(lds + L_WE) + (dir * 128 + kp) * RS + c2) = part == 0 ? pk2(b0.x, b1.x) : pk2(b0.y, b1.y);
        }
        {
            const int dir = tid >> 8, ip = (tid >> 4) & 15, i = tid & 15;
            float acc[8];
#pragma unroll
            for (int t = 0; t < 8; ++t) acc[t] = 0.f;
#pragma unroll 4
            for (int pp = 0; pp < 64; ++pp) {
                const f32x2 a1 = Lap[(dir * 9 + 1) * 64 + pp];
                f32x2 w = cmul(Lc[(dir * 16 + ip) * 64 + pp], Lbb[(dir * 64 + pp) * 16 + i]);
#pragma unroll
                for (int t = 0; t < 8; ++t) { acc[t] += w.x; w = cmul(w, a1); }
            }
            bf16_t* KP = (bf16_t*)(lds + L_KP) + dir * 8 * 512;
#pragma unroll
            for (int t = 0; t < 8; ++t) {
                const bf16_t v = (bf16_t)f2bf(acc[t]);
                if (dir == 0) { KP[t * 512 + ip * 32 + i] = v; if (t < 7) KP[(t + 1) * 512 + ip * 32 + 16 + i] = v; }
                else { KP[t * 512 + ip * 32 + 16 + i] = v; if (t < 7) KP[(t + 1) * 512 + ip * 32 + i] = v; }
            }
            if (dir == 0) KP[0 * 512 + ip * 32 + 16 + i] = 0; else KP[0 * 512 + ip * 32 + i] = 0;
            if (tid < 128) {
                const int d2 = tid >> 6, s = tid & 63; const f32x2 a8 = Lap[(d2 * 9 + 8) * 64 + s];
                f32x2 w = {1.f, 0.f}; f32x2* pwt = (f32x2*)(lds + L_PW) + d2 * 16 * 64 + s;
#pragma unroll 1
                for (int nn = 0; nn < 16; ++nn) { pwt[nn * 64] = w; w = cmul(w, a8); }
            }
        }
        __syncthreads();
        }
        for (int rep = 0; rep < (S5_PROBE == 1 ? S5_REPS : 1); ++rep)
        for (int J = wave; J < 34; J += NWAVES) {
            const int ln = TIDX() & 63;
            bf16x8 uf[4]; load_u(h, b * RPB + 128 * J, g, ln, uf);
            tile_stage1<0>(p, wgi, g, J, uf, lds, ln);
            __builtin_amdgcn_sched_barrier(0);
            tile_stage1<1>(p, wgi, g, J, uf, lds, ln);
            __builtin_amdgcn_sched_barrier(0);
        }
        __syncthreads();
        if (wave < 2) {
            const int dir = wave;
            const f32x2 a128 = ((const f32x2*)(cb + C_A128))[(dir * 64 + g) * 64 + lane];
            f32x2* cr = (f32x2*)(lds + L_CARRY) + dir * 34 * 64 + lane;
            float zz = ZF(); f32x2 c = {zz, zz};
#pragma unroll 1
            for (int k = 0; k < 34; ++k) { const int J = dir == 0 ? k : (k < 2 ? 1 - k : 35 - k); const f32x2 e = cr[J * 64]; cr[J * 64] = c; c = cmul(a128, c); c.x += e.x; c.y += e.y; }
        } else {
            for (int idx = tid - 128; idx < 2 * 128 * 64; idx += NTHREADS - 128) {
                const int dir = idx >> 13, r = (idx >> 6) & 127, kpos = (idx & 63) * 2, t = r >> 4, ip = r & 15;
                const int ks = kpos >> 5, q = (kpos >> 3) & 3, jj = kpos & 7, kk = 32 * ks + 16 * (jj >> 2) + 4 * q + (jj & 3), pp = kk >> 1;
                const f32x2 cc = cmul(Lc[(dir * 16 + ip) * 64 + pp], Lap[(dir * 9 + (dir == 0 ? t + 1 : 8 - t)) * 64 + pp]);
                *(unsigned*)((bf16_t*)(lds + L_CA) + (dir * 128 + r) * RS + kpos) = pk2(cc.x, -cc.y);
            }
        }
        __syncthreads();
        const float* dd = IN(p, 22) + jl * 1024;
        for (int rep = 0; rep < (S5_PROBE == 2 ? S5_REPS : 1); ++rep)
        for (int J = wave; J < 34; J += NWAVES) {
            const int lane = TIDX() & 63;
            const int row0 = b * RPB + 128 * J;
            bf16x8 uf[4]; load_u(h, row0, g, lane, uf);
            f32x4 Y[8];
#pragma unroll
            for (int t = 0; t < 8; ++t) { const float zf = ZF(); Y[t] = (f32x4){zf, zf, zf, zf}; }
            tile_stage3<0>(p, wgi, J, uf, Y, lds, lane);
            __builtin_amdgcn_sched_barrier(0);
            tile_stage3<1>(p, wgi, J, uf, Y, lds, lane);
            __builtin_amdgcn_sched_barrier(0);
            const int n = lane & 15, q = lane >> 4; const f32x4 dv = *(const f32x4*)(dd + 16 * g + 4 * q);
#pragma unroll
            for (int t = 0; t < 8; ++t) {
                const size_t off = (size_t)(row0 + 8 * n + t) * DM + 16 * g + 4 * q;
                const u32x2 hw = *(const u32x2*)(h + off);
                const float y0 = bflo(hw[0]) * dv[0] + Y[t][0], y1 = bfhi(hw[0]) * dv[1] + Y[t][1], y2 = bflo(hw[1]) * dv[2] + Y[t][2], y3 = bfhi(hw[1]) * dv[3] + Y[t][3];
                u32x2 w = {pk2(gelu_tanh(y0), gelu_tanh(y1)), pk2(gelu_tanh(y2), gelu_tanh(y3))};
                *(u32x2*)(z + off) = w;
            }
        }
        __syncthreads();
    }
}
}

DI void lru_conv(const Params& p, int j) {
    const int lane = TIDX() & 63, gw = BIDX() * NWAVES + (TIDX() >> 6), nw = GDIM() * NWAVES;
    const bf16_t* xp = (const bf16_t*)(p.ws + WS_T + T_XPRE); bf16_t* xr = (bf16_t*)(p.ws + WS_T + T_XR);
    const float* cw = IN(p, 25) + j * 4 * LRUW; const float* cb = IN(p, 26) + j * LRUW;
    for (int row = gw; row < MROWS; row += nw) {
        const int b = row / RPB, rb = row - b * RPB; const bool isctx = rb < CTXL;
        const int t = isctx ? rb : rb - CTXL, L = isctx ? CTXL : SEQ;
        for (int cc = lane * 4; cc < LRUW; cc += 256) {
            f32x4 acc = *(const f32x4*)(cb + cc);
#pragma unroll
            for (int k = 0; k < 4; ++k) { const int tt = t + k - 1; if (tt < 0 || tt >= L) continue;
                const u32x2 w = *(const u32x2*)(xp + (size_t)(row + k - 1) * LRUW + cc); const f32x4 wk = *(const f32x4*)(cw + k * LRUW + cc);
                acc[0] += wk[0] * bflo(w[0]); acc[1] += wk[1] * bfhi(w[0]); acc[2] += wk[2] * bflo(w[1]); acc[3] += wk[3] * bfhi(w[1]); }
            u32x2 o = {pk2(acc[0], acc[1]), pk2(acc[2], acc[3])};
            *(u32x2*)(xr + (size_t)row * LRUW + cc) = o;
        }
    }
}
constexpr int LR_CH = 64, LR_NCH = RPB / LR_CH;
DI int lr_chain_chunk(int dir, int k) { return dir == 0 ? k : (k < 4 ? 3 - k : 71 - k); }
DI int lr_chain_pos(int dir, int c) { return dir == 0 ? c : (c < 4 ? 3 - c : 71 - c); }
DI void lru_pass1(const Params& p) {
    const int gt = BIDX() * NTHREADS + TIDX(), ntot = GDIM() * NTHREADS;
    float* P = (float*)(p.ws + WS_T + T_LP); float* E = (float*)(p.ws + WS_T + T_LE);
    for (int it = gt; it < NB * 2 * LR_NCH * 160; it += ntot) {
        const int c8 = it % 160, r1 = it / 160, c = r1 % LR_NCH, r2 = r1 / LR_NCH, dir = r2 & 1, b = r2 >> 1;
        const bf16_t* la = (const bf16_t*)(p.ws + WS_T + T_LA + dir * LRU_DIRSTRIDE) + (size_t)(b * RPB + c * LR_CH) * LRUW + c8 * 8;
        const bf16_t* bb = (const bf16_t*)(p.ws + WS_T + T_BB + dir * LRU_DIRSTRIDE) + (size_t)(b * RPB + c * LR_CH) * LRUW + c8 * 8;
        float s[8], ps[8];
#pragma unroll
        for (int e = 0; e < 8; ++e) { s[e] = 0.f; ps[e] = 0.f; }
        for (int k0 = 0; k0 < LR_CH; k0 += 8) {
            u32x4 lw[8], bw[8];
#pragma unroll
            for (int u = 0; u < 8; ++u) { const int t = dir ? LR_CH - 1 - (k0 + u) : k0 + u; lw[u] = *(const u32x4*)(la + (size_t)t * LRUW); bw[u] = *(const u32x4*)(bb + (size_t)t * LRUW); }
#pragma unroll
            for (int u = 0; u < 8; ++u)
#pragma unroll
                for (int e = 0; e < 4; ++e) {
                    const float l0 = bflo(lw[u][e]), l1 = bfhi(lw[u][e]);
                    ps[2 * e] += l0; ps[2 * e + 1] += l1;
                    s[2 * e] = __expf(l0) * s[2 * e] + bflo(bw[u][e]); s[2 * e + 1] = __expf(l1) * s[2 * e + 1] + bfhi(bw[u][e]);
                }
        }
        const size_t o = ((size_t)((b * 2 + dir) * LR_NCH + c)) * LRUW + c8 * 8;
        *(f32x4*)(P + o) = (f32x4){ps[0], ps[1], ps[2], ps[3]}; *(f32x4*)(P + o + 4) = (f32x4){ps[4], ps[5], ps[6], ps[7]};
        *(f32x4*)(E + o) = (f32x4){s[0], s[1], s[2], s[3]}; *(f32x4*)(E + o + 4) = (f32x4){s[4], s[5], s[6], s[7]};
    }
}
DI void lru_carry(const Params& p) {
    const int gt = BIDX() * NTHREADS + TIDX(), ntot = GDIM() * NTHREADS;
    const float* P = (const float*)(p.ws + WS_T + T_LP); const float* E = (const float*)(p.ws + WS_T + T_LE); float* S = (float*)(p.ws + WS_T + T_LS);
    for (int it = gt; it < NB * 2 * LRUW; it += ntot) {
        const int ch = it % LRUW, bd = it / LRUW, dir = bd & 1;
        const size_t base = (size_t)bd * LR_NCH * LRUW + ch;
        float s = 0.f;
        for (int k0 = 0; k0 < LR_NCH; k0 += 17) {
            float pv[17], ev[17];
#pragma unroll
            for (int u = 0; u < 17; ++u) { const size_t o = base + (size_t)lr_chain_chunk(dir, k0 + u) * LRUW; pv[u] = P[o]; ev[u] = E[o]; }
#pragma unroll
            for (int u = 0; u < 17; ++u) { S[base + (size_t)lr_chain_chunk(dir, k0 + u) * LRUW] = s; s = __expf(pv[u]) * s + ev[u]; }
        }
    }
}
DI void lru_pass3(const Params& p, bool latonly) {
    const int gt = BIDX() * NTHREADS + TIDX(), ntot = GDIM() * NTHREADS;
    const float* S = (const float*)(p.ws + WS_T + T_LS);
    const bf16_t* gx = (const bf16_t*)(p.ws + WS_T + T_GX); bf16_t* gh = (bf16_t*)(p.ws + WS_T + T_GH);
    for (int it = gt; it < NB * LR_NCH * 640; it += ntot) {
        const int c2 = it % 640, r1 = it / 640, c = r1 % LR_NCH, b = r1 / LR_NCH;
        if (latonly && c < 4) continue;
        const size_t rowoff = (size_t)(b * RPB + c * LR_CH) * LRUW + c2 * 2;
        f32x2 fw[LR_CH];
        {
            const size_t o = ((size_t)((b * 2 + 0) * LR_NCH + c)) * LRUW + c2 * 2;
            f32x2 s = *(const f32x2*)(S + o);
            const bf16_t* la = (const bf16_t*)(p.ws + WS_T + T_LA) + rowoff; const bf16_t* bb = (const bf16_t*)(p.ws + WS_T + T_BB) + rowoff;
#pragma unroll
            for (int k0 = 0; k0 < LR_CH; k0 += 16) {
                unsigned lw[16], bw[16];
#pragma unroll
                for (int u = 0; u < 16; ++u) { lw[u] = *(const unsigned*)(la + (size_t)(k0 + u) * LRUW); bw[u] = *(const unsigned*)(bb + (size_t)(k0 + u) * LRUW); }
#pragma unroll
                for (int u = 0; u < 16; ++u) { s.x = __expf(bflo(lw[u])) * s.x + bflo(bw[u]); s.y = __expf(bfhi(lw[u])) * s.y + bfhi(bw[u]); fw[k0 + u] = s; }
            }
        }
        {
            const size_t o = ((size_t)((b * 2 + 1) * LR_NCH + c)) * LRUW + c2 * 2;
            f32x2 s = *(const f32x2*)(S + o);
            const bf16_t* la = (const bf16_t*)(p.ws + WS_T + T_LA + LRU_DIRSTRIDE) + rowoff; const bf16_t* bb = (const bf16_t*)(p.ws + WS_T + T_BB + LRU_DIRSTRIDE) + rowoff;
#pragma unroll
            for (int k0 = 0; k0 < LR_CH; k0 += 16) {
                unsigned lw[16], bw[16], gw_[16];
#pragma unroll
                for (int u = 0; u < 16; ++u) { const int t = LR_CH - 1 - (k0 + u); lw[u] = *(const unsigned*)(la + (size_t)t * LRUW); bw[u] = *(const unsigned*)(bb + (size_t)t * LRUW); gw_[u] = *(const unsigned*)(gx + rowoff + (size_t)t * LRUW); }
#pragma unroll
                for (int u = 0; u < 16; ++u) { const int t = LR_CH - 1 - (k0 + u);
                    s.x = __expf(bflo(lw[u])) * s.x + bflo(bw[u]); s.y = __expf(bfhi(lw[u])) * s.y + bfhi(bw[u]);
                    *(unsigned*)(gh + rowoff + (size_t)t * LRUW) = pk2(bflo(gw_[u]) * (fw[t].x + s.x), bfhi(gw_[u]) * (fw[t].y + s.y)); }
            }
        }
    }
}

#define XB_TMO      128
#define XB_XCNT(j)  (256  + 64 * (j))
#define XB_XSUB(j)  (1280 + 64 * (j))
#define XB_XGEN(j)  (2304 + 64 * (j))
#define XB_TOP      3328
#define XB_TOPGEN   3392
#define XCD_BAR_WORDS 3456
#define XB_SPIN_CAP (1u << 24)
DI unsigned xb_ld(unsigned* p)              { return __hip_atomic_load(p, __ATOMIC_RELAXED, __HIP_MEMORY_SCOPE_AGENT); }
DI unsigned xb_add(unsigned* p, unsigned v) { return __hip_atomic_fetch_add(p, v, __ATOMIC_RELAXED, __HIP_MEMORY_SCOPE_AGENT); }
DI unsigned xb_xcc_id() { return (unsigned)__builtin_amdgcn_s_getreg((3 << 11) | 20) & 0xFu; }
#define XB_SPIN(cond, bar) do { unsigned _sp = 0; while (cond) { __builtin_amdgcn_s_sleep(1); \
    if ((++_sp & 255u) == 0u) { if (xb_ld(&(bar)[XB_TMO])) break; if (_sp > XB_SPIN_CAP) { atomicAdd(&(bar)[XB_TMO], 1u); break; } } } } while (0)
struct XcdBarrier { unsigned* bar; unsigned x; volatile LAS unsigned* st; };
DI XcdBarrier xcd_barrier_post(unsigned* bar, volatile LAS unsigned* st) {
    XcdBarrier b; b.bar = bar; b.x = xb_xcc_id(); b.st = st;
    if (threadIdx.x == 0) (void)xb_add(&bar[XB_XCNT(b.x)], 1u);
    return b;
}
DI void xcd_barrier_complete(unsigned* bar, unsigned x, unsigned& nloc, unsigned& nx) {
    const unsigned G = gridDim.x * gridDim.y * gridDim.z;
    unsigned sum, cnt, mine, sp = 0u;
    for (;;) {
        sum = 0u; cnt = 0u; mine = 0u;
#pragma unroll
        for (unsigned j = 0; j < 16; ++j) { const unsigned c = xb_ld(&bar[XB_XCNT(j)]); sum += c; cnt += (c > 0u) ? 1u : 0u; mine = (j == x) ? c : mine; }
        if (sum == G) break;
        __builtin_amdgcn_s_sleep(1);
        if ((++sp & 255u) == 0u) { if (xb_ld(&bar[XB_TMO])) break; if (sp > XB_SPIN_CAP) { atomicAdd(&bar[XB_TMO], 1u); break; } }
    }
    nloc = mine > 0u ? mine : 1u; nx = cnt > 0u ? cnt : 1u;
}
DI void xcd_barrier(const XcdBarrier& b) {
    asm volatile("s_waitcnt vmcnt(0)" ::: "memory");
    __syncthreads();
    if (threadIdx.x == 0) {
        unsigned* bar = b.bar;
        __builtin_amdgcn_s_waitcnt(0);
        unsigned nloc = b.st[0], nx = b.st[1];
        if (nloc == 0u) { xcd_barrier_complete(bar, b.x, nloc, nx); b.st[0] = nloc; b.st[1] = nx; }
        const unsigned old = xb_add(&bar[XB_XSUB(b.x)], 1u);
        const unsigned gen = old / nloc;
        if (old + 1u == (gen + 1u) * nloc) {
            __builtin_amdgcn_fence(__ATOMIC_RELEASE, "agent");
            asm volatile("s_waitcnt vmcnt(0)" ::: "memory");
            const unsigned og = xb_add(&bar[XB_TOP], 1u);
            const unsigned tg = og / nx;
            if (og + 1u == (tg + 1u) * nx) xb_add(&bar[XB_TOPGEN], 1u);
            else XB_SPIN(xb_ld(&bar[XB_TOPGEN]) == tg, bar);
            __builtin_amdgcn_fence(__ATOMIC_ACQUIRE, "agent");
            xb_add(&bar[XB_XGEN(b.x)], 1u);
            asm volatile("s_waitcnt vmcnt(0)" ::: "memory");
        } else {
            XB_SPIN(xb_ld(&bar[XB_XGEN(b.x)]) == gen, bar);
            __builtin_amdgcn_fence(__ATOMIC_ACQUIRE, "agent");
            asm volatile("s_waitcnt vmcnt(0)" ::: "memory");
        }
    }
    __syncthreads();
}

enum { ST_INIT = 0, ST_NORM0, ST_NORM1, ST_GEMM, ST_A3, ST_A5, ST_ATTN, ST_S5P1, ST_S5P3, ST_CONV, ST_LRU1, ST_LRU3, ST_S5C, ST_LRUC, ST_S5 };
enum { G_DQKV = 0, G_UQ, G_UKV, G_WO, G_GLU, G_WX, G_WG, G_GATES, G_WOUT, G_W1, G_W2 };
struct Step { unsigned char type, layer, gid, ng; };
#define MLA_STEPS(L) {ST_NORM0, L, 0, 0}, {ST_GEMM, L, G_DQKV, 1}, {ST_GEMM, L, G_UQ, 2}, {ST_ATTN, L, 0, 0}, {ST_GEMM, L, G_WO, 1}, \
                     {ST_NORM1, L, 0, 0}, {ST_GEMM, L, G_W1, 1}, {ST_GEMM, L, G_W2, 1}
#define S5_STEPS(L)  {ST_NORM0, L, 0, 0}, {ST_S5, L, 0, 0}, {ST_GEMM, L, G_GLU, 1}, {ST_NORM1, L, 0, 0}, {ST_GEMM, L, G_W1, 1}, {ST_GEMM, L, G_W2, 1}
#define LRU_STEPS(L) {ST_NORM0, L, 0, 0}, {ST_GEMM, L, G_WX, 2}, {ST_CONV, L, 0, 0}, {ST_GEMM, L, G_GATES, 1}, {ST_LRU1, L, 0, 0}, {ST_LRUC, L, 0, 0}, {ST_LRU3, L, 0, 0}, {ST_GEMM, L, G_WOUT, 1}, \
                     {ST_NORM1, L, 0, 0}, {ST_GEMM, L, G_W1, 1}, {ST_GEMM, L, G_W2, 1}
__constant__ Step PROGRAM[] = { {ST_INIT, 0, 0, 0}, MLA_STEPS(0), S5_STEPS(1), LRU_STEPS(2), MLA_STEPS(3) };
constexpr int NSTEPS = 1 + 8 + 6 + 11 + 8;

#ifndef PROBE_MASK
#define PROBE_MASK 0
#endif
#ifndef PROBE_GMASK
#define PROBE_GMASK 0
#endif
#ifndef PROBE_REPS
#define PROBE_REPS 2
#endif
DI GemmD make_gemm(const Params& p, int gid, int layer, bool dry) {
    unsigned char* ws = p.ws; unsigned char* T = ws + WS_T; unsigned char* wm = ws + WS_WMIX;
    const bf16_t* H = (const bf16_t*)(ws + WS_H); const float* modv = (const float*)(ws + WS_MOD);
    const int lo = layer < 3 ? 0 : 1, j = layer / 3;
    GemmD g; g.koff_shift = 30; g.koff_mul = 0; g.out = nullptr; g.ldc = 0; g.gate = modv; g.gate_off = 2 * 1024; g.layer = layer; g.aux0 = nullptr; g.aux1 = nullptr; g.aux2 = nullptr; g.out2 = nullptr; g.latonly = lo; g.rev = 0; g.splitk = 0; g.slab = nullptr; g.res_x = nullptr;
    switch (gid) {
        case G_DQKV: g.A = H; g.lda = 1024; g.Bt = (const bf16_t*)(wm + WM_D); g.ldb = 1024; g.K = 1024; g.nN = 3; g.latonly = 0; g.kind = EPI_DQKV; g.aux0 = IN(p, 11) + j * 256; g.aux1 = IN(p, 13) + j * 384 + 192 + 128; break;
        case G_UQ: g.A = (const bf16_t*)(T + T_CQ); g.lda = 384; g.Bt = (const bf16_t*)(wm + WM_UQ); g.ldb = 384; g.K = 384; g.nN = 6; g.kind = EPI_QN; g.out = T + T_QPRE; g.ldc = 1536; g.aux0 = IN(p, 13) + j * 384; break;
        case G_UKV: g.A = (const bf16_t*)(T + T_CKV); g.lda = 256; g.Bt = (const bf16_t*)(wm + WM_UKV); g.ldb = 256; g.K = 256; g.nN = 8; g.latonly = 0; g.kind = EPI_KVN; g.out = T + T_KVPRE; g.ldc = 2048; g.aux0 = IN(p, 13) + j * 384 + 192; break;
        case G_WO: if (layer == 0) g.res_x = IN(p, 0); g.A = H; g.lda = 1024; g.Bt = (const bf16_t*)(wm + WM_O); g.ldb = 1024; g.K = 1024; g.nN = 4; g.kind = EPI_RES; g.splitk = 4; g.slab = (float*)(T + T_SLAB_A); break;
        case G_GLU: g.A = (const bf16_t*)(T + T_Z); g.lda = 1024; g.Bt = (const bf16_t*)(wm + WM_GLU); g.ldb = 1024; g.K = 1024; g.nN = 8; g.kind = EPI_GLU; g.splitk = 4; g.slab = (float*)(T + T_SLAB_A); break;
        case G_WX: g.A = H; g.lda = 1024; g.Bt = (const bf16_t*)(wm + WM_X); g.ldb = 1024; g.K = 1024; g.nN = 5; g.latonly = 0; g.kind = EPI_BF16; g.out = T + T_XPRE; g.ldc = LRUW; break;
        case G_GATES: g.A = (const bf16_t*)(T + T_XR); g.lda = LRUW; g.Bt = (const bf16_t*)(wm + WM_GATE); g.ldb = 256; g.K = 256; g.nN = 20; g.latonly = 0; g.kind = EPI_GATES; g.koff_shift = 2; g.koff_mul = 256;
            g.out = T + T_LA; g.out2 = T + T_BB; g.aux0 = IN(p, 28) + j * 4 * LRUW; g.aux1 = IN(p, 29) + j * 2 * LRUW; g.aux2 = T + T_XR; break;
        case G_WG: g.A = H; g.lda = 1024; g.Bt = (const bf16_t*)(wm + WM_G); g.ldb = 1024; g.K = 1024; g.nN = 5; g.latonly = 0; g.rev = 1; g.kind = EPI_GELUMUL; g.out = T + T_GX; g.ldc = LRUW; break;
        case G_WOUT: g.A = (const bf16_t*)(T + T_GH); g.lda = LRUW; g.Bt = (const bf16_t*)(wm + WM_OUT); g.ldb = LRUW; g.K = LRUW; g.nN = 4; g.kind = EPI_RES; g.splitk = 5; g.slab = (float*)(T + T_SLAB_A_LRU); break;
        case G_W1: g.A = H; g.lda = 1024; g.Bt = mlp_wbuf(p, layer); g.ldb = 1024; g.K = 1024; g.nN = 16; g.kind = EPI_RELU2; g.out = T + T_HID; g.ldc = 4096; break;
        default: g.A = (const bf16_t*)(T + T_HID); g.lda = 4096; g.Bt = mlp_wbuf(p, layer) + (size_t)4096 * 1024; g.ldb = 4096; g.K = 4096; g.nN = 4; g.kind = EPI_RES; g.gate_off = 5 * 1024; g.splitk = 16; g.slab = (float*)(T + T_SLAB_M); break;
    }
    if (dry && (g.kind == EPI_RES || g.kind == EPI_GLU)) { g.kind = EPI_RELU2; g.out = T + 204 * MiB; g.ldc = 1024; }
    return g;
}
constexpr int LDS_BYTES = 163840;

__global__ void __launch_bounds__(NTHREADS, 2) hybrid_fwd(KArgs ka) {
    extern __shared__ __attribute__((aligned(16))) unsigned char lds_raw[];
    char* lds = (char*)lds_raw;
    LAS unsigned char* ldsl = (LAS unsigned char*)lds_raw;
    if (threadIdx.x < 33) ((LAS unsigned long long*)(ldsl + PTAB_OFF))[threadIdx.x] = (unsigned long long)ka.in[threadIdx.x];
    if (threadIdx.x < 4) ((LAS unsigned*)(ldsl + PTAB_OFF + 512))[threadIdx.x] = 0u;
    __syncthreads();
    const XcdBarrier xbar = xcd_barrier_post((unsigned*)ka.ws, (volatile LAS unsigned*)(ldsl + PTAB_OFF + 512));
    for (int step = 0; step < NSTEPS; ++step) {
        Params p; p.tab = (const LAS unsigned long long*)(ldsl + PTAB_OFF);
        { unsigned long long oi = (unsigned long long)ka.out, wi = (unsigned long long)ka.ws;
          asm volatile("" : "+s"(oi), "+s"(wi));
          p.out = (float*)(__attribute__((address_space(1))) float*)oi; p.ws = (unsigned char*)(__attribute__((address_space(1))) unsigned char*)wi; }
        const Step st = PROGRAM[step];
        const int layer = st.layer, j = layer / 3; const bool need_ctx = layer < 3;
        const int nrep = (PROBE_MASK != 0 && ((PROBE_MASK >> st.type) & 1) && (st.type != ST_GEMM || ((PROBE_GMASK >> st.gid) & 1))) ? PROBE_REPS : 1;
        for (int rr = 0; rr < nrep; ++rr) {
        switch (st.type) {
#ifndef NO_INIT
            case ST_INIT: mod_phase(p, lds); rope_table(p); s5v2::prep(p); prep_mixer(p, 0, lds); prep_mlp(p, 0, lds); break;
#endif
#ifndef NO_NORM
            case ST_NORM0: norm_phase(p, layer, 0, layer == 0, false, (layer > 0 && rr == 0) ? 16 : 0, (const float*)(p.ws + WS_T + T_SLAB_M), (const float*)(p.ws + WS_MOD) + (size_t)(4 * 4 + layer - 1) * 6144 + 5 * 1024, false); break;
            case ST_NORM1: norm_phase(p, layer, 1, false, !need_ctx, (need_ctx && rr == 0) ? (layer % 3 == 2 ? 5 : 4) : 0, (const float*)(p.ws + WS_T + (layer % 3 == 2 ? T_SLAB_A_LRU : T_SLAB_A)), (const float*)(p.ws + WS_MOD) + (size_t)(4 * 4 + layer) * 6144 + 2 * 1024, layer % 3 == 1); break;
#endif
#ifndef NO_GEMM
            case ST_GEMM: for (int gi = 0; gi < st.ng; ++gi) { const GemmD g = make_gemm(p, st.gid + gi, layer, rr != 0); gemm_phase(p, ldsl, g, st.gid + gi, layer, rr != 0); }
                if (st.gid == G_W1 && layer < 3 && rr == 0 && BIDX() >= 64) { prep_mixer(p, layer + 1, lds, 64); prep_mlp(p, layer + 1, lds, 64); }
                break;
#endif
#ifndef NO_ROWOP
            case ST_A3: mla_rowop_a3(p, j); break;
            case ST_A5: mla_rowop_a5(p, j, !need_ctx); break;
#endif
#ifndef NO_ATTN
            case ST_ATTN: attn_phase(p, need_ctx, lds); break;
#endif
#ifndef NO_S5
            case ST_S5: s5v2::phase(p, j, lds); break;
#endif
#ifndef NO_LRU
            case ST_CONV: lru_conv(p, j); break;
            case ST_LRU1: lru_pass1(p); break;
            case ST_LRUC: lru_carry(p); break;
            case ST_LRU3: lru_pass3(p, false); break;
#endif
            default: break;
        }
        if (step + 1 < NSTEPS) xcd_barrier(xbar);
        }
    }
}

extern "C" void kernel_launch(void* const* d_in, const int* in_sizes, int n_in, void* d_out, int out_size, void* d_ws, size_t ws_size, hipStream_t stream) {
    static int grid_blocks = 0;
    if (grid_blocks == 0) {
        if (n_in != 33 || out_size != NB * SEQ * DM || ws_size < WS_END) { fprintf(stderr, "kernel_launch: unexpected shapes n_in %d out %d ws %zu (need %zu)\n", n_in, out_size, ws_size, (size_t)WS_END); grid_blocks = -1; return; }
        int dev = 0, cus = 0, per_cu = 0;
        hipGetDevice(&dev);
        hipDeviceGetAttribute(&cus, hipDeviceAttributeMultiprocessorCount, dev);
        if (hipFuncSetAttribute((const void*)hybrid_fwd, hipFuncAttributeMaxDynamicSharedMemorySize, LDS_BYTES) != hipSuccess) { fprintf(stderr, "kernel_launch: hipFuncSetAttribute failed\n"); grid_blocks = -1; return; }
        if (hipOccupancyMaxActiveBlocksPerMultiprocessor(&per_cu, (const void*)hybrid_fwd, NTHREADS, LDS_BYTES) != hipSuccess || per_cu < 1) { fprintf(stderr, "kernel_launch: occupancy query failed (%d)\n", per_cu); per_cu = 1; (void)hipGetLastError(); }
        if (per_cu > 1) per_cu = 1;
        grid_blocks = cus * per_cu;
    }
    if (grid_blocks < 0) return;
    KArgs p{};
    for (int i = 0; i < 33; ++i) p.in[i] = (const float*)d_in[i];
    p.out = (float*)d_out; p.ws = (unsigned char*)d_ws;
    if (hipMemsetAsync(d_ws, 0, 16384, stream) != hipSuccess) { fprintf(stderr, "kernel_launch: memset of the barrier words failed\n"); return; }
    void* args[] = {&p};
    hipError_t e = hipLaunchCooperativeKernel((const void*)hybrid_fwd, dim3(grid_blocks), dim3(NTHREADS), args, LDS_BYTES, stream);
    if (e != hipSuccess) fprintf(stderr, "cooperative launch failed: %s (grid %d)\n", hipGetErrorString(e), grid_blocks);
}
```

```cpp
#include <hip/hip_runtime.h>
#include <hip/hip_cooperative_groups.h>
#include <cstdio>
#include <cstdint>
namespace cg = cooperative_groups;

#ifndef NAIVE_GEMM
#define NAIVE_GEMM 0
#endif

#define DI __device__ __forceinline__
#define LAS __attribute__((address_space(3)))
typedef unsigned short bf16_t;
typedef short bf16x8 __attribute__((ext_vector_type(8)));
typedef short s16x4 __attribute__((ext_vector_type(4)));
typedef float f32x4 __attribute__((ext_vector_type(4)));
typedef float f32x2 __attribute__((ext_vector_type(2)));
typedef float f32x16 __attribute__((ext_vector_type(16)));
typedef unsigned u32x4 __attribute__((ext_vector_type(4)));
typedef unsigned u32x2 __attribute__((ext_vector_type(2)));

constexpr int DM = 1024, NB = 4, SEQ = 4096, CTXL = 256, RPB = SEQ + CTXL  , MROWS = NB * RPB  ;
constexpr int NTHREADS = 512, NWAVES = 8;
constexpr int LRUW = 1280;
constexpr float EPS = 1e-6f;
constexpr float QSCALE = 0.07216878364870323f * 1.4426950408889634f;

constexpr size_t MiB = 1u << 20;
constexpr size_t WS_MOD = 1 * MiB;
constexpr size_t WS_ROPE = 1 * MiB + 512 * 1024;
constexpr size_t WS_S5C = 2 * MiB;
constexpr size_t WS_CTXLAT = 4 * MiB;
constexpr size_t WS_WMIX = 8 * MiB;
constexpr size_t WS_WMLP = 19 * MiB;
constexpr size_t WS_RL = 35 * MiB;
constexpr size_t WS_T = 69 * MiB;
constexpr size_t WS_END = WS_T + 270 * MiB;
constexpr size_t T_DQKV = 0, T_CQ = 51 * MiB, T_CKV = 64 * MiB, T_KR = 73 * MiB, T_QPRE = 76 * MiB, T_KVPRE = 127 * MiB;
constexpr size_t T_Z = 0, T_S5E = 40 * MiB, T_S5S = 50 * MiB;
constexpr size_t T_GX = 0  , T_LA = 43 * MiB  , T_BB = 129 * MiB, T_XPRE = 43 * MiB  ,
                 T_XR = 215 * MiB, T_GH = 215 * MiB  , T_LP = 258 * MiB, T_LE = 261 * MiB, T_LS = 264 * MiB;
constexpr size_t LRU_DIRSTRIDE = 43 * MiB;
constexpr size_t T_HID = 0;
constexpr size_t T_SLAB_M = 140 * MiB  , T_SLAB_A = 200 * MiB  , T_SLAB_A_LRU = 172 * MiB  ;
constexpr size_t WM_D = 0  , WM_UQ = 1572864  , WM_UKV = WM_UQ + 1179648  , WM_O = WM_UKV + 1048576  ;
constexpr size_t WM_GLU = 0;
constexpr size_t WM_X = 0  , WM_G = 2621440, WM_GATE = 2 * 2621440  , WM_OUT = 3 * 2621440  ;

struct KArgs {
    const float* in[33];
    float* out;
    unsigned char* ws;
};
constexpr int PTAB_OFF = 163072;
struct Params {
    float* out;
    unsigned char* ws;
    const LAS unsigned long long* tab;
};
__device__ __forceinline__ const float* IN(const Params& p, int k) {
    const unsigned long long v = p.tab[k];
    const unsigned lo = __builtin_amdgcn_readfirstlane((unsigned)v), hi = __builtin_amdgcn_readfirstlane((unsigned)(v >> 32));
    return (const float*)(const __attribute__((address_space(1))) float*)(((unsigned long long)hi << 32) | lo);
}

DI float ZF() { float z; asm volatile("v_mov_b32 %0, 0" : "=v"(z)); return z; }
DI int TIDX() { int t = threadIdx.x; asm volatile("" : "+v"(t)); return t; }
DI int BIDX() { int t = blockIdx.x; asm volatile("" : "+s"(t)); return t; }
DI int GDIM() { int t = gridDim.x; asm volatile("" : "+s"(t)); return t; }
typedef __bf16 bf16x2_t __attribute__((ext_vector_type(2)));
DI unsigned pk2(float lo, float hi) { f32x2 v = {lo, hi}; bf16x2_t b = __builtin_convertvector(v, bf16x2_t); return __builtin_bit_cast(unsigned, b); }
DI unsigned f2bf(float f) { return pk2(f, 0.f) & 0xffffu; }
DI float bflo(unsigned w) { return __uint_as_float(w << 16); }
DI float bfhi(unsigned w) { return __uint_as_float(w & 0xffff0000u); }
DI float bf2f(bf16_t h) { return __uint_as_float((unsigned)h << 16); }
DI float wave_sum(float v) {
#pragma unroll
    for (int o = 32; o; o >>= 1) v += __shfl_xor(v, o);
    return v;
}
DI float sigmoidf_(float x) { return __builtin_amdgcn_rcpf(1.f + __builtin_amdgcn_exp2f(-1.4426950408889634f * x)); }
DI float gelu_tanh(float x) {
    const float t = fmaf(x * x, 0.10294324f, 2.3022082f); return x * __builtin_amdgcn_rcpf(1.f + __builtin_amdgcn_exp2f(-x * t));
}
#define LDS_FENCE() asm volatile("s_waitcnt lgkmcnt(0)" ::: "memory")

DI bf16_t* hbuf(const Params& p) { return (bf16_t*)p.out; }

DI void mod_phase(const Params& p, char* lds) {
    float* sv = (float*)lds;
    float* red = (float*)(lds + 20480);
    const int tid = TIDX();
    for (int i = tid; i < 5 * 1024; i += NTHREADS) { const int mi = i >> 10, k = i & 1023; const float x = mi < 4 ? IN(p, 1)[mi * 1024 + k] : IN(p, 3)[k]; sv[i] = x / (1.f + __expf(-x)); }
    __syncthreads();
    float* modv = (float*)(p.ws + WS_MOD);
    for (int grp = BIDX(); grp < 256; grp += GDIM()) {
        const int ks = tid / 24, cq = tid % 24;
        const int col = grp * 96 + cq * 4, layer = col / 6144, cc = col % 6144;
        if (ks < 16) {
            const float* w = IN(p, 4) + (size_t)layer * 1024 * 6144 + cc;
            f32x4 a0 = {0, 0, 0, 0}, a1 = a0, a2 = a0, a3 = a0, a4 = a0;
            for (int k0 = ks * 64; k0 < ks * 64 + 64; k0 += 16) {
                f32x4 wv[16];
#pragma unroll
                for (int u = 0; u < 16; ++u) wv[u] = *(const f32x4*)(w + (size_t)(k0 + u) * 6144);
#pragma unroll
                for (int u = 0; u < 16; ++u) { const int k = k0 + u; a0 += sv[k] * wv[u]; a1 += sv[1024 + k] * wv[u]; a2 += sv[2048 + k] * wv[u]; a3 += sv[3072 + k] * wv[u]; a4 += sv[4096 + k] * wv[u]; }
            }
            f32x4* r = (f32x4*)red + (ks * 24 + cq) * 5;
            r[0] = a0; r[1] = a1; r[2] = a2; r[3] = a3; r[4] = a4;
        }
        __syncthreads();
        if (tid < 120) {
            const int q = tid / 5, mi = tid % 5; const int c2 = grp * 96 + q * 4, l2 = c2 / 6144, cc2 = c2 % 6144;
            f32x4 s = *(const f32x4*)(IN(p, 5) + l2 * 6144 + cc2);
            for (int k2 = 0; k2 < 16; ++k2) s += ((const f32x4*)red)[(k2 * 24 + q) * 5 + mi];
            *(f32x4*)(modv + (size_t)(mi * 4 + l2) * 6144 + cc2) = s;
        }
        __syncthreads();
    }
}

struct PrepCtx { char* ldsw; int gw, nw, lane, tcount; };
DI void prep_T(PrepCtx& c, const float* src, int lds_, int K, int N, bf16_t* dst, int ldd, int zero_delta = 0, int hi_stride = 32, const float* kscale = nullptr) {
    const int ntn = N / 64, nt = (K / 64) * ntn;
    unsigned* T = (unsigned*)c.ldsw;
    const int lane = c.lane, c4 = (lane & 15) * 4, r = lane >> 4, rr = lane >> 3, kc = lane & 7;
    int first = (c.gw - c.tcount) % c.nw; if (first < 0) first += c.nw;
    for (int t = first; t < nt; t += c.nw) {
        const int kt = t / ntn, nn = t - kt * ntn;
        const float* s = src + (size_t)(kt * 64 + 2 * r) * lds_ + nn * 64 + c4;
        f32x4 v0[8], v1[8];
#pragma unroll
        for (int i = 0; i < 8; ++i) { v0[i] = *(const f32x4*)(s + (size_t)(8 * i) * lds_); v1[i] = *(const f32x4*)(s + (size_t)(8 * i + 1) * lds_); }
        if (kscale) {
#pragma unroll
            for (int i = 0; i < 8; ++i) { v0[i] = v0[i] * kscale[kt * 64 + 2 * r + 8 * i]; v1[i] = v1[i] * kscale[kt * 64 + 2 * r + 8 * i + 1]; }
        }
        LDS_FENCE();
#pragma unroll
        for (int i = 0; i < 8; ++i)
#pragma unroll
            for (int e = 0; e < 4; ++e) T[(c4 + e) * 33 + 4 * i + r] = pk2(v0[i][e], v1[i][e]);
        LDS_FENCE();
#pragma unroll
        for (int i = 0; i < 8; ++i) {
            const unsigned* Tr = T + (8 * i + rr) * 33 + 4 * kc;
            const u32x4 w = {Tr[0], Tr[1], Tr[2], Tr[3]};
            const int nrow = 8 * i + rr;
            bf16_t* d = dst + (size_t)(nn * 64 + (nrow >> 5) * hi_stride + (nrow & 31)) * ldd + kt * 64 + 8 * kc;
            *(u32x4*)d = w;
            if (zero_delta) { const unsigned z = __float_as_uint(ZF()); *(u32x4*)(d + zero_delta) = (u32x4){z, z, z, z}; }
        }
    }
    c.tcount += nt;
}
DI void prep_zero_rows(bf16_t* dst, size_t nelem, int first_block = 0) {
    const size_t n8 = nelem / 8; const unsigned z0 = __float_as_uint(ZF()); const u32x4 z = {z0, z0, z0, z0};
    for (size_t i = (size_t)(BIDX() - first_block) * NTHREADS + TIDX(); i < n8; i += (size_t)(GDIM() - first_block) * NTHREADS) ((u32x4*)dst)[i] = z;
}
DI PrepCtx prep_ctx(char* lds, int first_block = 0) {
    PrepCtx c; const int wave = TIDX() >> 6; c.lane = TIDX() & 63; c.ldsw = lds + wave * 8448; c.gw = (BIDX() - first_block) * NWAVES + wave; c.nw = (GDIM() - first_block) * NWAVES; c.tcount = 0; return c;
}
DI void prep_mixer(const Params& p, int layer, char* lds, int first_block = 0) {
    PrepCtx c = prep_ctx(lds, first_block);
    unsigned char* wm = p.ws + WS_WMIX;
    const int kind = layer % 3, j = layer / 3;
    if (kind == 0) {
        bf16_t* Wd = (bf16_t*)(wm + WM_D);
        prep_T(c, IN(p, 7) + (size_t)j * 1024 * 384, 384, 1024, 384, Wd, 1024);
        prep_T(c, IN(p, 10) + (size_t)j * 1024 * 320, 320, 1024, 256, Wd + (size_t)512 * 1024, 1024);
        prep_T(c, IN(p, 10) + (size_t)j * 1024 * 320 + 256, 320, 1024, 64, Wd + (size_t)384 * 1024, 1024);
        prep_zero_rows(Wd + (size_t)448 * 1024, 64 * 1024, first_block);
        for (int hh = 0; hh < 8; ++hh) {
            const float* wsrc = IN(p, 9) + (size_t)j * 384 * 1536 + hh * 192;
            prep_T(c, wsrc, 1536, 384, 128, (bf16_t*)(wm + WM_UQ) + (size_t)(256 * (hh >> 1) + 128 * (hh & 1)) * 384, 384, 0, 32, IN(p, 8) + j * 384);
            prep_T(c, wsrc + 128, 1536, 384, 64, (bf16_t*)(wm + WM_UQ) + (size_t)(256 * (4 + (hh >> 2)) + 32 * (hh & 3)) * 384, 384, 0, 128, IN(p, 8) + j * 384);
        }
        prep_T(c, IN(p, 12) + (size_t)j * 256 * 2048, 2048, 256, 2048, (bf16_t*)(wm + WM_UKV), 256);
        prep_T(c, IN(p, 14) + (size_t)j * 1024 * 1024, 1024, 1024, 1024, (bf16_t*)(wm + WM_O), 1024);
    } else if (kind == 1) {
        bf16_t* Wg = (bf16_t*)(wm + WM_GLU);
        for (int pn = 0; pn < 8; ++pn)
            for (int bj = 0; bj < 2; ++bj)
                prep_T(c, IN(p, 23) + (size_t)j * 1024 * 2048 + bj * 1024 + 128 * pn, 2048, 1024, 128, Wg + (size_t)(256 * pn + 128 * bj) * 1024, 1024);
    } else {
        const float* win = IN(p, 24) + (size_t)j * 1024 * 2560;
        prep_T(c, win + 1280, 2560, 1024, 1280, (bf16_t*)(wm + WM_X), 1024);
        prep_T(c, win, 2560, 1024, 1280, (bf16_t*)(wm + WM_G), 1024);
        bf16_t* Wt = (bf16_t*)(wm + WM_GATE);
        const float* wg = IN(p, 27) + (size_t)j * 2 * 2 * 10 * 128 * 128;
        for (int pr = 0; pr < 5; ++pr)
            for (int bip = 0; bip < 2; ++bip)
                for (int dir = 0; dir < 2; ++dir)
                    for (int gate = 0; gate < 2; ++gate)
                        prep_T(c, wg + (size_t)(((dir * 2 + gate) * 10) + 2 * pr + bip) * 128 * 128, 128, 128, 128,
                               Wt + (size_t)(1024 * pr + ((bip * 2 + dir) * 2 + gate) * 128) * 256 + 128 * bip, 256, bip ? -128 : 128);
        prep_T(c, IN(p, 30) + (size_t)j * 1280 * 1024, 1024, 1280, 1024, (bf16_t*)(wm + WM_OUT), 1280);
    }
}
constexpr size_t T_WMLP1 = 250 * MiB;
DI bf16_t* mlp_wbuf(const Params& p, int layer) { return (bf16_t*)((layer & 1) ? p.ws + WS_T + T_WMLP1 : p.ws + WS_WMLP); }
DI void prep_mlp(const Params& p, int layer, char* lds, int first_block = 0) {
    PrepCtx c = prep_ctx(lds, first_block);
    bf16_t* W1 = mlp_wbuf(p, layer); bf16_t* W2 = W1 + (size_t)4096 * 1024;
    prep_T(c, IN(p, 31) + (size_t)layer * 1024 * 4096, 4096, 1024, 4096, W1, 1024);
    prep_T(c, IN(p, 32) + (size_t)layer * 4096 * 1024, 1024, 4096, 1024, W2, 4096);
}

DI void norm_phase(const Params& p, int layer, int which, bool first, bool latonly, int nslab, const float* slab, const float* sgate, bool glu) {
    const int lane = TIDX() & 63, gw = BIDX() * NWAVES + (TIDX() >> 6), nw = GDIM() * NWAVES;
    const float* modv = (const float*)(p.ws + WS_MOD);
    const float* g = IN(p, 6) + (size_t)(layer * 2 + which) * 1024;
    bf16_t* h = hbuf(p);
    for (int qd = gw; qd < NB * SEQ / 4; qd += nw) {
        const int b = qd / (SEQ / 4), t0 = (qd - b * (SEQ / 4)) * 4;
        const float* src = IN(p, 0) + (size_t)(b * SEQ + t0) * DM;
        const bf16_t* rl = (const bf16_t*)(p.ws + WS_RL) + (size_t)(b * SEQ + t0) * DM;
        const float* md = modv + (size_t)(b * 4 + layer) * 6144 + which * 3072;
        f32x4 v[4][4]; float ss[4];
        if (first) {
#pragma unroll
            for (int r = 0; r < 4; ++r)
#pragma unroll
                for (int j = 0; j < 4; ++j) v[r][j] = *(const f32x4*)(src + (size_t)r * DM + j * 256 + lane * 4);
        } else {
            u32x2 w[4][4];
#pragma unroll
            for (int r = 0; r < 4; ++r)
#pragma unroll
                for (int j = 0; j < 4; ++j) w[r][j] = *(const u32x2*)(rl + (size_t)r * DM + j * 256 + lane * 4);
#pragma unroll
            for (int r = 0; r < 4; ++r)
#pragma unroll
                for (int j = 0; j < 4; ++j) v[r][j] = (f32x4){bflo(w[r][j][0]), bfhi(w[r][j][0]), bflo(w[r][j][1]), bfhi(w[r][j][1])};
        }
        f32x4 mul[4], sh[4];
#pragma unroll
        for (int j = 0; j < 4; ++j) { const int col = j * 256 + lane * 4; mul[j] = *(const f32x4*)(g + col) * (1.f + *(const f32x4*)(md + 1024 + col)); sh[j] = *(const f32x4*)(md + col); }
#pragma unroll
        for (int r = 0; r < 4; ++r) { float a = 0.f;
#pragma unroll
            for (int j = 0; j < 4; ++j) a += v[r][j][0] * v[r][j][0] + v[r][j][1] * v[r][j][1] + v[r][j][2] * v[r][j][2] + v[r][j][3] * v[r][j][3];
            ss[r] = a; }
#pragma unroll
        for (int o = 32; o; o >>= 1) {
#pragma unroll
            for (int r = 0; r < 4; ++r) ss[r] += __shfl_xor(ss[r], o);
        }
        const size_t hrow = (size_t)(b * RPB + CTXL + t0);
#pragma unroll
        for (int r = 0; r < 4; ++r) {
            const float inv = rsqrtf(ss[r] * (1.f / 1024.f) + EPS);
#pragma unroll
            for (int j = 0; j < 4; ++j) {
                const int col = j * 256 + lane * 4;
                const f32x4 o = v[r][j] * inv * mul[j] + sh[j];
                u32x2 w = {pk2(o[0], o[1]), pk2(o[2], o[3])};
                *(u32x2*)(h + (hrow + r) * DM + col) = w;
            }
        }
    }
    if (latonly) return;
    const float* md = modv + (size_t)(4 * 4 + layer) * 6144 + which * 3072;
    for (int cr = gw; cr < NB * CTXL; cr += nw) {
        const int b = cr / CTXL, rb = cr - b * CTXL;
        float* lp = (float*)(p.ws + WS_CTXLAT) + (size_t)cr * DM;
        const float* src = first ? IN(p, 2) + (size_t)cr * DM : lp;
        f32x4 v[4]; float ss = 0.f;
#pragma unroll
        for (int j = 0; j < 4; ++j) v[j] = *(const f32x4*)(src + j * 256 + lane * 4);
        if (nslab) {
#pragma unroll
            for (int j = 0; j < 4; ++j) {
                const int col = j * 256 + lane * 4; f32x4 a = {0.f, 0.f, 0.f, 0.f};
                if (glu) {
                    const float* sp = slab + (size_t)cr * 2048 + (col >> 7) * 256 + (col & 127); f32x4 gz = {0.f, 0.f, 0.f, 0.f};
                    for (int ks = 0; ks < nslab; ++ks) { a += *(const f32x4*)(sp + (size_t)ks * 1024 * 2048); gz += *(const f32x4*)(sp + (size_t)ks * 1024 * 2048 + 128); }
#pragma unroll
                    for (int e = 0; e < 4; ++e) a[e] *= sigmoidf_(gz[e]);
                } else {
                    const float* sp = slab + (size_t)cr * 1024 + col;
                    for (int ks = 0; ks < nslab; ++ks) a += *(const f32x4*)(sp + (size_t)ks * 1024 * 1024);
                }
                v[j] += *(const f32x4*)(sgate + col) * a;
                *(f32x4*)(lp + col) = v[j];
            }
        }
#pragma unroll
        for (int j = 0; j < 4; ++j) ss += v[j][0] * v[j][0] + v[j][1] * v[j][1] + v[j][2] * v[j][2] + v[j][3] * v[j][3];
        ss = wave_sum(ss);
        const float inv = rsqrtf(ss * (1.f / 1024.f) + EPS);
#pragma unroll
        for (int j = 0; j < 4; ++j) {
            const int col = j * 256 + lane * 4;
            if (first) *(f32x4*)(lp + col) = v[j];
            const f32x4 gg = *(const f32x4*)(g + col), sh = *(const f32x4*)(md + col), sc = *(const f32x4*)(md + 1024 + col);
            const f32x4 o = v[j] * inv * gg * (1.f + sc) + sh;
            u32x2 w = {pk2(o[0], o[1]), pk2(o[2], o[3])};
            *(u32x2*)(h + (size_t)(b * RPB + rb) * DM + col) = w;
        }
    }
}

constexpr int BM = 256, BK = 64, HALF = 128, HTB = HALF * BK * 2, NXCD = 8, WGM = 8;
struct Unit { int pm, pn, k0, nt, split, ks; };
enum { EPI_F32 = 0, EPI_BF16 = 1, EPI_RES = 2, EPI_RELU2 = 3, EPI_GLU = 4, EPI_GATES = 5, EPI_GELUMUL = 6, EPI_QN = 8, EPI_KVN = 9, EPI_DQKV = 10 };
struct GemmD {
    const bf16_t* A; const bf16_t* Bt; int lda, ldb, K, nN; int latonly; int koff_shift, koff_mul;
    int kind; int rev; int splitk; float* slab;
    void* out; int ldc;
    const float* gate; int gate_off;
    int layer;
    const float* res_x;
    int final;
    const float* aux0; const float* aux1; const void* aux2; void* out2;
};
DI int lds_byte(int r, int c) { const int st = (r >> 4) * 2 + (c >> 5), rr = r & 15, cc = c & 31, ob = rr * 64 + cc * 2; return st * 1024 + (ob ^ (((ob >> 9) & 1) << 5)); }
DI void stage_rc(int b, int& R, int& C) { const int st = b / 1024, sb = b % 1024, swz = sb ^ (((sb >> 9) & 1) << 5); R = (st >> 1) * 16 + swz / 64; C = (st & 1) * 32 + (swz % 64) / 2; }

DI bool unit_next(const GemmD& g, int i, Unit& u) {
    const bool sk = g.splitk > 0 && !g.latonly;
    const int nM = (g.latonly || sk) ? 64 : 68, nN = g.nN, nwg = nM * nN, G = GDIM(), c = g.rev ? GDIM() - 1 - BIDX() : BIDX();
    const long L = (long)i * G + c;
    u.k0 = 0; u.nt = g.K / BK; u.split = 0; u.ks = 0;
    if (L >= nwg) {
        if (!sk) return false;
        const int tt = (int)(L - nwg); if (tt >= 4 * nN * g.splitk) return false;
        const int ks = tt / (4 * nN), r = tt - ks * 4 * nN;
        u.pm = 17 * (r & 3); u.pn = r >> 2; u.nt = g.K / BK / g.splitk; u.k0 = ks * u.nt * BK; u.split = 1; u.ks = ks; return true;
    }
    int wgid = (int)L; { const int q = nwg / NXCD, r = nwg % NXCD, xcd = wgid % NXCD, off = wgid / NXCD; wgid = (xcd < r ? xcd * (q + 1) : r * (q + 1) + (xcd - r) * q) + off; }
    const int nig = WGM * nN, gid = wgid / nig, fm = gid * WGM, gsz = (nM - fm) < WGM ? (nM - fm) : WGM;
    int pm = fm + ((wgid % nig) % gsz); u.pn = (wgid % nig) / gsz;
    if (nM == 64) pm = 17 * (pm >> 4) + 1 + (pm & 15);
    u.pm = pm; return true;
}

template <int KIND>
DI void epi_loop(const Params& p, const GemmD& g, const f32x4 (&acc)[2][2][4][2], const Unit& u, int wr, int wc, int fr, int fq) {
    const int b = u.pm / 17, tpm = u.pm - 17 * b, mi = tpm == 0 ? 4 : b;
    const float* gatep = nullptr;
    if (KIND == EPI_RES || KIND == EPI_GLU) gatep = g.gate + (size_t)(mi * 4 + g.layer) * 6144 + g.gate_off;
    f32x4 gbias[2][2], gsp[2];
    if (KIND == EPI_GATES) {
        const int dir = u.pn & 1;
#pragma unroll
        for (int n = 0; n < 2; ++n) {
            const int ch = (u.pn >> 1) * 128 + wc * 32 + n * 16 + fq * 4;
            gbias[n][0] = *(const f32x4*)(g.aux0 + (dir * 2 + 0) * LRUW + ch); gbias[n][1] = *(const f32x4*)(g.aux0 + (dir * 2 + 1) * LRUW + ch);
            const f32x4 lam = *(const f32x4*)(g.aux1 + dir * LRUW + ch);
#pragma unroll
            for (int e = 0; e < 4; ++e) gsp[n][e] = -8.f * log1pf(__expf(-lam[e]));
        }
    }
#pragma unroll
    for (int ai = 0; ai < 2; ++ai)
#pragma unroll
        for (int m = 0; m < 4; ++m) {
            const int rb = tpm * 256 + ai * 128 + wr * 64 + m * 16 + fr;
            const int row = b * RPB + rb;
            bf16_t* lb = nullptr; const size_t lrow = (size_t)(b * SEQ + rb - CTXL) * DM;
            if (KIND == EPI_RES || KIND == EPI_GLU) lb = (bf16_t*)(p.ws + WS_RL) + lrow;
#pragma unroll
            for (int n = 0; n < 2; ++n) {
                const int cw = wc * 32 + n * 16 + fq * 4;
                if (KIND == EPI_F32) {
#pragma unroll
                    for (int bj = 0; bj < 2; ++bj) *(f32x4*)((float*)g.out + (size_t)row * g.ldc + u.pn * 256 + bj * 128 + cw) = acc[ai][bj][m][n];
                } else if (KIND == EPI_BF16) {
#pragma unroll
                    for (int bj = 0; bj < 2; ++bj) { const f32x4 v = acc[ai][bj][m][n]; u32x2 w = {pk2(v[0], v[1]), pk2(v[2], v[3])};
                        *(u32x2*)((bf16_t*)g.out + (size_t)row * g.ldc + u.pn * 256 + bj * 128 + cw) = w; }
                } else if (KIND == EPI_RELU2) {
#pragma unroll
                    for (int bj = 0; bj < 2; ++bj) { f32x4 v = acc[ai][bj][m][n];
#pragma unroll
                        for (int e = 0; e < 4; ++e) { const float r = fmaxf(v[e], 0.f); v[e] = r * r; }
                        u32x2 w = {pk2(v[0], v[1]), pk2(v[2], v[3])};
                        *(u32x2*)((bf16_t*)g.out + (size_t)row * g.ldc + u.pn * 256 + bj * 128 + cw) = w; }
                } else if (KIND == EPI_RES) {
#pragma unroll
                    for (int bj = 0; bj < 2; ++bj) { const int col = u.pn * 256 + bj * 128 + cw;
                        const f32x4 gt = *(const f32x4*)(gatep + col);
                        f32x4 v;
                        if (g.res_x) v = *(const f32x4*)(g.res_x + lrow + col);
                        else { const u32x2 w = *(const u32x2*)(lb + col); v = (f32x4){bflo(w[0]), bfhi(w[0]), bflo(w[1]), bfhi(w[1])}; }
                        v += gt * acc[ai][bj][m][n];
                        if (g.final) *(f32x4*)(p.out + lrow + col) = v;
                        else { const u32x2 o = {pk2(v[0], v[1]), pk2(v[2], v[3])}; *(u32x2*)(lb + col) = o; } }
                } else if (KIND == EPI_GLU) {
                    const int col = u.pn * 128 + cw;
                    const f32x4 zv = acc[ai][0][m][n], zg = acc[ai][1][m][n];
                    const f32x4 gt = *(const f32x4*)(gatep + col); const u32x2 w = *(const u32x2*)(lb + col);
                    f32x4 v = {bflo(w[0]), bfhi(w[0]), bflo(w[1]), bfhi(w[1])};
#pragma unroll
                    for (int e = 0; e < 4; ++e) v[e] += gt[e] * zv[e] * sigmoidf_(zg[e]);
                    const u32x2 o = {pk2(v[0], v[1]), pk2(v[2], v[3])}; *(u32x2*)(lb + col) = o;
                } else if (KIND == EPI_GATES) {
                    const int dir = u.pn & 1;
                    const int ch = (u.pn >> 1) * 128 + cw;
                    const u32x2 xw = *(const u32x2*)((const bf16_t*)g.aux2 + (size_t)row * LRUW + ch);
                    const float xr[4] = {bflo(xw[0]), bfhi(xw[0]), bflo(xw[1]), bfhi(xw[1])};
                    float la[4], bb[4];
#pragma unroll
                    for (int e = 0; e < 4; ++e) {
                        const float r = __builtin_amdgcn_rcpf(1.f + __expf(-(acc[ai][0][m][n][e] + gbias[n][0][e]))), ig = __builtin_amdgcn_rcpf(1.f + __expf(-(acc[ai][1][m][n][e] + gbias[n][1][e])));
                        const float l = gsp[n][e] * r;
                        const float x = 2.f * l;
                        const float om = -x * (1.f + x * (0.5f + x * (0.16666667f + x * (0.041666668f + x * 0.008333334f))));
                        la[e] = l; bb[e] = __builtin_amdgcn_sqrtf(fmaxf(om, 0.f)) * (ig * xr[e]);
                    }
                    u32x2 wl = {pk2(la[0], la[1]), pk2(la[2], la[3])}, wb = {pk2(bb[0], bb[1]), pk2(bb[2], bb[3])};
                    *(u32x2*)((bf16_t*)((unsigned char*)g.out + dir * LRU_DIRSTRIDE) + (size_t)row * LRUW + ch) = wl;
                    *(u32x2*)((bf16_t*)((unsigned char*)g.out2 + dir * LRU_DIRSTRIDE) + (size_t)row * LRUW + ch) = wb;
                } else if (KIND == EPI_GELUMUL) {
#pragma unroll
                    for (int bj = 0; bj < 2; ++bj) { const int col = u.pn * 256 + bj * 128 + cw; f32x4 v = acc[ai][bj][m][n];
#pragma unroll
                        for (int e = 0; e < 4; ++e) v[e] = gelu_tanh(v[e]);
                        u32x2 w = {pk2(v[0], v[1]), pk2(v[2], v[3])};
                        *(u32x2*)((bf16_t*)g.out + (size_t)row * g.ldc + col) = w; }
                }
            }
        }
}

constexpr int XCH_OFF = 131072;
DI void epi_rowstats(const f32x4 (&acc)[2][2][4][2], float (&ps)[2][4][2]) {
#pragma unroll
    for (int ai = 0; ai < 2; ++ai)
#pragma unroll
        for (int m = 0; m < 4; ++m)
#pragma unroll
            for (int bj = 0; bj < 2; ++bj) {
                float s = 0.f;
#pragma unroll
                for (int n = 0; n < 2; ++n) { const f32x4 v = acc[ai][bj][m][n]; s += v[0] * v[0] + v[1] * v[1] + v[2] * v[2] + v[3] * v[3]; }
                s += __shfl_xor(s, 16); s += __shfl_xor(s, 32);
                ps[ai][m][bj] = s;
            }
}
DI void epi_exchange(LAS unsigned char* lds, const float (&ps)[2][4][2], float (&tot)[2][4][2], int wr, int wc, int fr, int fq) {
    LAS float* X = (LAS float*)(lds + XCH_OFF);
    if (fq == 0) {
#pragma unroll
        for (int ai = 0; ai < 2; ++ai)
#pragma unroll
            for (int m = 0; m < 4; ++m)
#pragma unroll
                for (int bj = 0; bj < 2; ++bj) X[((ai * 128 + wr * 64 + m * 16 + fr) * 2 + bj) * 4 + wc] = ps[ai][m][bj];
    }
    asm volatile("s_waitcnt lgkmcnt(0)" ::: "memory"); __builtin_amdgcn_s_barrier(); asm volatile("" ::: "memory");
#pragma unroll
    for (int ai = 0; ai < 2; ++ai)
#pragma unroll
        for (int m = 0; m < 4; ++m)
#pragma unroll
            for (int bj = 0; bj < 2; ++bj) { const f32x4 t = *(const LAS f32x4*)(X + ((ai * 128 + wr * 64 + m * 16 + fr) * 2 + bj) * 4); tot[ai][m][bj] = (t[0] + t[1]) + (t[2] + t[3]); }
}
DI void epi_qn(const Params& p, const GemmD& g, LAS unsigned char* lds, const f32x4 (&acc)[2][2][4][2], const Unit& u, int wr, int wc, int fr, int fq) {
    const int b = u.pm / 17, tpm = u.pm - 17 * b;
    float ps[2][4][2]; epi_rowstats(acc, ps);
    bf16_t* Q = (bf16_t*)g.out; const float* gqk = g.aux0;
    const float* DQSS = (const float*)(p.ws + WS_T + T_DQKV);
    if (u.pn < 4) {
        float tot[2][4][2]; epi_exchange(lds, ps, tot, wr, wc, fr, fq);
        f32x4 gn[2];
#pragma unroll
        for (int n = 0; n < 2; ++n) gn[n] = *(const f32x4*)(gqk + wc * 32 + n * 16 + fq * 4);
#pragma unroll
        for (int ai = 0; ai < 2; ++ai)
#pragma unroll
            for (int m = 0; m < 4; ++m) {
                const int row = b * RPB + tpm * 256 + ai * 128 + wr * 64 + m * 16 + fr;
                float epsq;
                { const f32x4 d0 = *(const f32x4*)(DQSS + (size_t)row * 16), d1 = *(const f32x4*)(DQSS + (size_t)row * 16 + 4), d2 = *(const f32x4*)(DQSS + (size_t)row * 16 + 8);
                  const float ms = (((d0[0] + d0[1]) + (d0[2] + d0[3])) + ((d1[0] + d1[1]) + (d1[2] + d1[3])) + ((d2[0] + d2[1]) + (d2[2] + d2[3]))) * (1.f / 384.f); epsq = EPS * (ms + EPS); }
#pragma unroll
                for (int bj = 0; bj < 2; ++bj) {
                    const float inv = rsqrtf(tot[ai][m][bj] * (1.f / 128.f) + epsq) * QSCALE;
#pragma unroll
                    for (int n = 0; n < 2; ++n) { const f32x4 v = acc[ai][bj][m][n] * inv * gn[n]; u32x2 w = {pk2(v[0], v[1]), pk2(v[2], v[3])};
                        *(u32x2*)(Q + (size_t)row * 1536 + (2 * u.pn + bj) * 192 + wc * 32 + n * 16 + fq * 4) = w; }
                }
            }
    } else {
        const int hh = 4 * (u.pn - 4) + wc; const float* tb = (const float*)(p.ws + WS_ROPE);
        f32x4 gr[2][2];
#pragma unroll
        for (int bj = 0; bj < 2; ++bj)
#pragma unroll
            for (int n = 0; n < 2; ++n) gr[bj][n] = *(const f32x4*)(gqk + 128 + bj * 32 + n * 16 + fq * 4);
#pragma unroll
        for (int ai = 0; ai < 2; ++ai)
#pragma unroll
            for (int m = 0; m < 4; ++m) {
                const int rb = tpm * 256 + ai * 128 + wr * 64 + m * 16 + fr, row = b * RPB + rb, t = rb - CTXL;
                float epsq;
                { const f32x4 d0 = *(const f32x4*)(DQSS + (size_t)row * 16), d1 = *(const f32x4*)(DQSS + (size_t)row * 16 + 4), d2 = *(const f32x4*)(DQSS + (size_t)row * 16 + 8);
                  const float ms = (((d0[0] + d0[1]) + (d0[2] + d0[3])) + ((d1[0] + d1[1]) + (d1[2] + d1[3])) + ((d2[0] + d2[1]) + (d2[2] + d2[3]))) * (1.f / 384.f); epsq = EPS * (ms + EPS); }
                const float inv = rsqrtf((ps[ai][m][0] + ps[ai][m][1]) * (1.f / 64.f) + epsq);
#pragma unroll
                for (int bj = 0; bj < 2; ++bj) {
                    f32x4 x0 = acc[ai][bj][m][0] * inv * gr[bj][0], x1 = acc[ai][bj][m][1] * inv * gr[bj][1];
                    if (tpm != 0) {
                        const int pos = bj == 0 ? (t >> 6) : (t & 63);
                        const f32x4 cs = *(const f32x4*)(tb + pos * 32 + fq * 4), sn = *(const f32x4*)(tb + pos * 32 + 16 + fq * 4);
                        const f32x4 y0 = x0 * cs - x1 * sn, y1 = x1 * cs + x0 * sn; x0 = y0; x1 = y1;
                    }
                    x0 = x0 * QSCALE; x1 = x1 * QSCALE;
                    u32x2 w0 = {pk2(x0[0], x0[1]), pk2(x0[2], x0[3])}, w1 = {pk2(x1[0], x1[1]), pk2(x1[2], x1[3])};
                    bf16_t* qd = Q + (size_t)row * 1536 + hh * 192 + 128 + bj * 32 + fq * 4;
                    *(u32x2*)qd = w0; *(u32x2*)(qd + 16) = w1;
                }
            }
    }
}

DI void epi_dqkv(const Params& p, const GemmD& g, LAS unsigned char* lds, const f32x4 (&acc)[2][2][4][2], const Unit& u, int wr, int wc, int fr, int fq) {
    const int b = u.pm / 17, tpm = u.pm - 17 * b;
    float ps[2][4][2]; epi_rowstats(acc, ps);
    bf16_t* CQ = (bf16_t*)(p.ws + WS_T + T_CQ); bf16_t* CKV = (bf16_t*)(p.ws + WS_T + T_CKV); bf16_t* KR = (bf16_t*)(p.ws + WS_T + T_KR);
    float* DQSS = (float*)(p.ws + WS_T + T_DQKV);
    float tot[2][4][2];
    if (u.pn != 0) epi_exchange(lds, ps, tot, wr, wc, fr, fq);
    f32x4 gk[2]; const float* tb = (const float*)(p.ws + WS_ROPE);
    if (u.pn == 1) { gk[0] = wc < 2 ? *(const f32x4*)(g.aux1 + wc * 32 + fq * 4) : (f32x4){0.f, 0.f, 0.f, 0.f}; gk[1] = wc < 2 ? *(const f32x4*)(g.aux1 + wc * 32 + 16 + fq * 4) : (f32x4){0.f, 0.f, 0.f, 0.f}; }
#pragma unroll
    for (int ai = 0; ai < 2; ++ai)
#pragma unroll
        for (int m = 0; m < 4; ++m) {
            const int rb = tpm * 256 + ai * 128 + wr * 64 + m * 16 + fr, row = b * RPB + rb;
            if (u.pn == 0 || u.pn == 1) {
                const int nh = u.pn == 0 ? 2 : 1;
#pragma unroll
                for (int bj = 0; bj < 2; ++bj) {
                    if (bj < nh) {
#pragma unroll
                        for (int n = 0; n < 2; ++n) { const f32x4 v = acc[ai][bj][m][n]; u32x2 w = {pk2(v[0], v[1]), pk2(v[2], v[3])};
                            *(u32x2*)(CQ + (size_t)row * 384 + u.pn * 256 + bj * 128 + wc * 32 + n * 16 + fq * 4) = w; }
                        if (fq == 0) DQSS[(size_t)row * 16 + u.pn * 8 + bj * 4 + wc] = ps[ai][m][bj];
                    }
                }
            }
            if (u.pn == 1 && wc < 2) {
                const float inv = rsqrtf(tot[ai][m][1] * (1.f / 64.f) + EPS);
                f32x4 x0 = acc[ai][1][m][0] * inv * gk[0], x1 = acc[ai][1][m][1] * inv * gk[1];
                if (tpm != 0) {
                    const int t = rb - CTXL, pos = wc == 0 ? (t >> 6) : (t & 63);
                    const f32x4 cs = *(const f32x4*)(tb + pos * 32 + fq * 4), sn = *(const f32x4*)(tb + pos * 32 + 16 + fq * 4);
                    const f32x4 y0 = x0 * cs - x1 * sn, y1 = x1 * cs + x0 * sn; x0 = y0; x1 = y1;
                }
                u32x2 w0 = {pk2(x0[0], x0[1]), pk2(x0[2], x0[3])}, w1 = {pk2(x1[0], x1[1]), pk2(x1[2], x1[3])};
                bf16_t* kd = KR + (size_t)row * 64 + wc * 32 + fq * 4;
                *(u32x2*)kd = w0; *(u32x2*)(kd + 16) = w1;
            }
            if (u.pn == 2) {
                const float inv = rsqrtf((tot[ai][m][0] + tot[ai][m][1]) * (1.f / 256.f) + EPS);
#pragma unroll
                for (int bj = 0; bj < 2; ++bj)
#pragma unroll
                    for (int n = 0; n < 2; ++n) { const int col = bj * 128 + wc * 32 + n * 16 + fq * 4;
                        const f32x4 v = acc[ai][bj][m][n] * inv * *(const f32x4*)(g.aux0 + col); u32x2 w = {pk2(v[0], v[1]), pk2(v[2], v[3])};
                        *(u32x2*)(CKV + (size_t)row * 256 + col) = w; }
            }
        }
}
DI void epi_kvn(const Params& p, const GemmD& g, LAS unsigned char* lds, const f32x4 (&acc)[2][2][4][2], const Unit& u, int wr, int wc, int fr, int fq) {
    const int b = u.pm / 17, tpm = u.pm - 17 * b;
    float ps[2][4][2], tot[2][4][2]; epi_rowstats(acc, ps); epi_exchange(lds, ps, tot, wr, wc, fr, fq);
    bf16_t* KV = (bf16_t*)g.out; const float* gk = g.aux0;
    f32x4 gn[2];
#pragma unroll
    for (int n = 0; n < 2; ++n) gn[n] = *(const f32x4*)(gk + wc * 32 + n * 16 + fq * 4);
#pragma unroll
    for (int ai = 0; ai < 2; ++ai)
#pragma unroll
        for (int m = 0; m < 4; ++m) {
            const int row = b * RPB + tpm * 256 + ai * 128 + wr * 64 + m * 16 + fr;
            const float inv = rsqrtf(tot[ai][m][0] * (1.f / 128.f) + EPS);
            bf16_t* kd = KV + (size_t)row * 2048 + u.pn * 256 + wc * 32 + fq * 4;
#pragma unroll
            for (int n = 0; n < 2; ++n) {
                const f32x4 k = acc[ai][0][m][n] * inv * gn[n], v = acc[ai][1][m][n];
                u32x2 wk = {pk2(k[0], k[1]), pk2(k[2], k[3])}, wv = {pk2(v[0], v[1]), pk2(v[2], v[3])};
                *(u32x2*)(kd + n * 16) = wk; *(u32x2*)(kd + 128 + n * 16) = wv;
            }
        }
}
DI void epilogue(const Params& p, const GemmD& g, LAS unsigned char* lds, const f32x4 (&acc)[2][2][4][2], const Unit& u, int wr, int wc, int fr, int fq) {
    asm volatile("" : "+v"(fr), "+v"(fq));
    if (u.split) {
        const int b = u.pm / 17;
#pragma unroll
        for (int ai = 0; ai < 2; ++ai)
#pragma unroll
            for (int m = 0; m < 4; ++m) {
                float* sp = g.slab + ((size_t)u.ks * 1024 + (b * CTXL + ai * 128 + wr * 64 + m * 16 + fr)) * (size_t)(g.nN * 256) + u.pn * 256 + wc * 32 + fq * 4;
#pragma unroll
                for (int bj = 0; bj < 2; ++bj)
#pragma unroll
                    for (int n = 0; n < 2; ++n) *(f32x4*)(sp + bj * 128 + n * 16) = acc[ai][bj][m][n];
            }
        return;
    }
    switch (g.kind) {
        case EPI_F32: epi_loop<EPI_F32>(p, g, acc, u, wr, wc, fr, fq); break;
        case EPI_BF16: epi_loop<EPI_BF16>(p, g, acc, u, wr, wc, fr, fq); break;
        case EPI_RES: epi_loop<EPI_RES>(p, g, acc, u, wr, wc, fr, fq); break;
        case EPI_RELU2: epi_loop<EPI_RELU2>(p, g, acc, u, wr, wc, fr, fq); break;
        case EPI_GLU: epi_loop<EPI_GLU>(p, g, acc, u, wr, wc, fr, fq); break;
        case EPI_GATES: epi_loop<EPI_GATES>(p, g, acc, u, wr, wc, fr, fq); break;
        case EPI_QN: epi_qn(p, g, lds, acc, u, wr, wc, fr, fq); break;
        case EPI_KVN: epi_kvn(p, g, lds, acc, u, wr, wc, fr, fq); break;
        case EPI_DQKV: epi_dqkv(p, g, lds, acc, u, wr, wc, fr, fq); break;
        default: epi_loop<EPI_GELUMUL>(p, g, acc, u, wr, wc, fr, fq); break;
    }
}

struct GemmD;
DI GemmD make_gemm(const Params& p, int gid, int layer, bool dry);
#if NAIVE_GEMM
DI void gemm_phase(const Params& p, LAS unsigned char* lds, const GemmD& g, int gid, int layer, bool dry) {
    const int tid = TIDX(), wid = tid >> 6, lane = tid & 63, wr = wid >> 2, wc = wid & 3, fr = lane & 15, fq = lane >> 4;
    Unit u;
    for (int ui = 0; unit_next(g, ui, u); ++ui) {
        f32x4 acc[2][2][4][2];
#pragma unroll
        for (int a = 0; a < 2; ++a)
#pragma unroll
            for (int b = 0; b < 2; ++b)
#pragma unroll
                for (int m = 0; m < 4; ++m)
#pragma unroll
                    for (int n = 0; n < 2; ++n) { const float z = ZF(); acc[a][b][m][n] = (f32x4){z, z, z, z}; }
        const bf16_t* A = g.A + (size_t)u.pm * 256 * g.lda + (size_t)((u.pn >> g.koff_shift) * g.koff_mul);
        const bf16_t* B = g.Bt + (size_t)u.pn * 256 * g.ldb;
        for (int k0 = u.k0; k0 < u.k0 + u.nt * BK; k0 += 32) {
            bf16x8 af[2][4], bfr[2][2];
#pragma unroll
            for (int ai = 0; ai < 2; ++ai)
#pragma unroll
                for (int m = 0; m < 4; ++m) af[ai][m] = *(const bf16x8*)(A + (size_t)(ai * 128 + wr * 64 + m * 16 + fr) * g.lda + k0 + fq * 8);
#pragma unroll
            for (int bj = 0; bj < 2; ++bj)
#pragma unroll
                for (int n = 0; n < 2; ++n) bfr[bj][n] = *(const bf16x8*)(B + (size_t)(bj * 128 + wc * 32 + n * 16 + fr) * g.ldb + k0 + fq * 8);
#pragma unroll
            for (int ai = 0; ai < 2; ++ai)
#pragma unroll
                for (int bj = 0; bj < 2; ++bj)
#pragma unroll
                    for (int m = 0; m < 4; ++m)
#pragma unroll
                        for (int n = 0; n < 2; ++n) acc[ai][bj][m][n] = __builtin_amdgcn_mfma_f32_16x16x32_bf16(bfr[bj][n], af[ai][m], acc[ai][bj][m][n], 0, 0, 0);
        }
        epilogue(p, g, lds, acc, u, wr, wc, fr, fq);
    }
}
#else
DI void gemm_phase(const Params& p, LAS unsigned char* lds, const GemmD& g, int gid, int layer, bool dry) {
    const int tid = TIDX(), wid = __builtin_amdgcn_readfirstlane(tid >> 6), lane = tid & 63, wr = wid >> 2, wc = wid & 3, fr = lane & 15, fq = lane >> 4;
    unsigned voffA[2], voffB[2];
#pragma unroll
    for (int i = 0; i < 2; ++i) { int R, C; stage_rc(tid * 16 + i * 8192, R, C); voffA[i] = (unsigned)(R * g.lda + C) * 2u; voffB[i] = (unsigned)(R * g.ldb + C) * 2u; }
    const size_t kstep = (size_t)(BK * 2);
    const size_t hstepA = (size_t)HALF * g.lda * 2, hstepB = (size_t)HALF * g.ldb * 2;
    const unsigned ldsw = (unsigned)wid * 1024u;
    const int aoff = lds_byte(wr * 64 + fr, fq * 8), boff = lds_byte(wc * 32 + fr, fq * 8);
#define PG8_SA(b, h) (((b) * 2 + (h)) * HTB)
#define PG8_SB(b, h) ((4 + (b) * 2 + (h)) * HTB)
#define PG8_STAGE(bufoff, gbase, voff) do { _Pragma("unroll") for (int _i = 0; _i < 2; ++_i) \
        __builtin_amdgcn_global_load_lds((const unsigned*)((const char*)(gbase) + (voff)[_i]), (LAS unsigned*)(lds + (bufoff) + ldsw + _i * 8192), 16, 0, 0); } while (0)
#define PG8_LDA(dst, b, h) do { _Pragma("unroll") for (int m = 0; m < 4; ++m) _Pragma("unroll") for (int k = 0; k < 2; ++k) dst[m][k] = *(const LAS bf16x8*)(lds + PG8_SA(b, h) + aoff + m * 2048 + k * 1024); } while (0)
#define PG8_LDB(dst, b, h) do { _Pragma("unroll") for (int n = 0; n < 2; ++n) _Pragma("unroll") for (int k = 0; k < 2; ++k) dst[n][k] = *(const LAS bf16x8*)(lds + PG8_SB(b, h) + boff + n * 2048 + k * 1024); } while (0)
#define PG8_MMA(ai, bj, At, Bt) do { __builtin_amdgcn_s_setprio(1); _Pragma("unroll") for (int m = 0; m < 4; ++m) _Pragma("unroll") for (int n = 0; n < 2; ++n) _Pragma("unroll") for (int k = 0; k < 2; ++k) \
        acc[ai][bj][m][n] = __builtin_amdgcn_mfma_f32_16x16x32_bf16(Bt[n][k], At[m][k], acc[ai][bj][m][n], 0, 0, 0); __builtin_amdgcn_s_setprio(0); } while (0)
#define PG8_WAIT_V(n) asm volatile("s_waitcnt vmcnt(" #n ")" ::: "memory")
#define PG8_WAIT_L(n) asm volatile("s_waitcnt lgkmcnt(" #n ")" ::: "memory")
#define PG8_BAR __builtin_amdgcn_s_barrier()
#define PG8_SCHED __builtin_amdgcn_sched_barrier(0)
    Unit cur, nxt; int ui = 0;
    if (!unit_next(g, 0, cur)) return;
    f32x4 acc[2][2][4][2];
#pragma unroll
    for (int a = 0; a < 2; ++a)
#pragma unroll
        for (int b = 0; b < 2; ++b)
#pragma unroll
            for (int m = 0; m < 4; ++m)
#pragma unroll
                for (int n = 0; n < 2; ++n) { const float z = ZF(); acc[a][b][m][n] = (f32x4){z, z, z, z}; }
    bf16x8 At[4][2], B0[2][2], B1[2][2];
    const char* cA = (const char*)g.A + (size_t)cur.pm * 2 * hstepA + (size_t)((cur.pn >> g.koff_shift) * g.koff_mul + cur.k0) * 2;
    const char* cB = (const char*)g.Bt + (size_t)cur.pn * 2 * hstepB + (size_t)cur.k0 * 2;
    PG8_STAGE(PG8_SB(0, 0), cB, voffB); PG8_STAGE(PG8_SB(0, 1), cB + hstepB, voffB); PG8_STAGE(PG8_SA(0, 0), cA, voffA); PG8_STAGE(PG8_SA(0, 1), cA + hstepA, voffA);
    if (wr == 1) PG8_BAR;
    PG8_WAIT_V(2); PG8_BAR;
    PG8_STAGE(PG8_SB(1, 0), cB + kstep, voffB); PG8_STAGE(PG8_SA(1, 0), cA + kstep, voffA); PG8_STAGE(PG8_SB(1, 1), cB + hstepB + kstep, voffB);
    PG8_WAIT_V(6); PG8_BAR;
    for (;;) {
        const bool has_next = unit_next(g, ui + 1, nxt);
        const char* nA = has_next ? (const char*)g.A + (size_t)nxt.pm * 2 * hstepA + (size_t)((nxt.pn >> g.koff_shift) * g.koff_mul + nxt.k0) * 2 : cA;
        const char* nB = has_next ? (const char*)g.Bt + (size_t)nxt.pn * 2 * hstepB + (size_t)nxt.k0 * 2 : cB;
        const int nt = cur.nt;
        for (int t = 0; t < nt; t += 2) {
            const bool last = (t == nt - 2);
            const char* a1 = cA + (size_t)(t + 1) * kstep;
            const char* a2 = last ? nA : cA + (size_t)(t + 2) * kstep; const char* b2 = last ? nB : cB + (size_t)(t + 2) * kstep;
            const char* a3 = a2 + kstep; const char* b3 = b2 + kstep;
            PG8_LDB(B0, 0, 0); PG8_LDB(B1, 0, 1); PG8_SCHED; PG8_LDA(At, 0, 0); PG8_STAGE(PG8_SA(1, 1), a1 + hstepA, voffA);
            PG8_WAIT_V(8); PG8_WAIT_L(0); PG8_BAR; PG8_MMA(0, 0, At, B0); PG8_MMA(0, 1, At, B1); PG8_BAR; PG8_SCHED;
            PG8_LDA(At, 0, 1); PG8_STAGE(PG8_SB(0, 0), b2, voffB); PG8_STAGE(PG8_SB(0, 1), b2 + hstepB, voffB); PG8_STAGE(PG8_SA(0, 0), a2, voffA);
            PG8_WAIT_V(8); PG8_WAIT_L(0); PG8_BAR; PG8_MMA(1, 0, At, B0); PG8_MMA(1, 1, At, B1); PG8_BAR; PG8_SCHED;
            PG8_LDB(B0, 1, 0); PG8_LDB(B1, 1, 1); PG8_SCHED; PG8_LDA(At, 1, 0); PG8_STAGE(PG8_SA(0, 1), a2 + hstepA, voffA);
            PG8_WAIT_V(8); PG8_WAIT_L(0); PG8_BAR; PG8_MMA(0, 0, At, B0); PG8_MMA(0, 1, At, B1); PG8_BAR; PG8_SCHED;
            PG8_LDA(At, 1, 1); PG8_STAGE(PG8_SB(1, 0), b3, voffB); PG8_STAGE(PG8_SB(1, 1), b3 + hstepB, voffB); PG8_STAGE(PG8_SA(1, 0), a3, voffA);
            PG8_WAIT_V(8); PG8_WAIT_L(0); PG8_BAR; PG8_MMA(1, 0, At, B0); PG8_MMA(1, 1, At, B1); PG8_BAR; PG8_SCHED;
        }
        if (wr == 0) PG8_BAR;
        { int g2 = gid; asm volatile("" : "+s"(g2));
          const GemmD ge = make_gemm(p, g2, layer, dry); epilogue(p, ge, lds, acc, cur, wr, wc, fr, fq); }
        if (!has_next) break;
#pragma unroll
        for (int a = 0; a < 2; ++a)
#pragma unroll
            for (int b = 0; b < 2; ++b)
#pragma unroll
                for (int m = 0; m < 4; ++m)
#pragma unroll
                    for (int n = 0; n < 2; ++n) { const float z = ZF(); acc[a][b][m][n] = (f32x4){z, z, z, z}; }
        cur = nxt; cA = nA; cB = nB; ++ui;
        if (wr == 1) PG8_BAR;
    }
    PG8_WAIT_V(0);
    PG8_BAR;
#undef PG8_SA
#undef PG8_SB
#undef PG8_STAGE
#undef PG8_LDA
#undef PG8_LDB
#undef PG8_MMA
#undef PG8_WAIT_V
#undef PG8_WAIT_L
#undef PG8_BAR
#undef PG8_SCHED
}
#endif

DI void rope_cs(int pos, int k, float& cs, float& sn) { const float f = exp2f(-(float)k * (13.287712379549449f / 16.f)); sincosf((float)pos * f, &sn, &cs); }

DI void rope_table(const Params& p) {
    const int gt = BIDX() * NTHREADS + TIDX();
    if (gt < 64 * 16) { const int pos = gt >> 4, k = gt & 15; float cs, sn; rope_cs(pos, k, cs, sn); float* tb = (float*)(p.ws + WS_ROPE); tb[pos * 32 + k] = cs; tb[pos * 32 + 16 + k] = sn; }
}
DI float sum8(float v) { v += __shfl_xor(v, 1); v += __shfl_xor(v, 2); v += __shfl_xor(v, 4); return v; }
DI void mla_rowop_a3(const Params& p, int j) {
    const int lane = TIDX() & 63, gw = BIDX() * NWAVES + (TIDX() >> 6), nw = GDIM() * NWAVES;
    const float* dq = (const float*)(p.ws + WS_T + T_DQKV);
    bf16_t* cq = (bf16_t*)(p.ws + WS_T + T_CQ); bf16_t* ckv = (bf16_t*)(p.ws + WS_T + T_CKV); bf16_t* kr = (bf16_t*)(p.ws + WS_T + T_KR);
    const float* tb = (const float*)(p.ws + WS_ROPE);
    const float* gq = IN(p, 8) + j * 384; const float* gkv = IN(p, 11) + j * 256; const float* gkr = IN(p, 13) + j * 384 + 192 + 128;
    const bool isq1 = lane < 32, iskr = lane >= 32 && lane < 48;
    const f32x4 g0 = *(const f32x4*)(gq + 4 * lane);
    const f32x4 g1 = isq1 ? *(const f32x4*)(gq + 256 + 4 * lane) : *(const f32x4*)(gkv + 4 * (lane - 32));
    f32x4 g2 = {0.f, 0.f, 0.f, 0.f}; if (lane < 32) g2 = *(const f32x4*)(gkv + 128 + 4 * lane); else if (iskr) g2 = *(const f32x4*)(gkr + 4 * (lane - 32));
    for (int r0 = gw * 2; r0 < MROWS; r0 += nw * 2) {
        f32x4 v[2][3]; float s0[2], s1[2], s2[2];
#pragma unroll
        for (int rr = 0; rr < 2; ++rr) {
            const float* s = dq + (size_t)(r0 + rr) * 768 + 4 * lane;
            v[rr][0] = *(const f32x4*)s; v[rr][1] = *(const f32x4*)(s + 256); v[rr][2] = lane < 48 ? *(const f32x4*)(s + 512) : (f32x4){0.f, 0.f, 0.f, 0.f};
        }
#pragma unroll
        for (int rr = 0; rr < 2; ++rr) {
            const float q0 = v[rr][0][0] * v[rr][0][0] + v[rr][0][1] * v[rr][0][1] + v[rr][0][2] * v[rr][0][2] + v[rr][0][3] * v[rr][0][3];
            const float q1 = v[rr][1][0] * v[rr][1][0] + v[rr][1][1] * v[rr][1][1] + v[rr][1][2] * v[rr][1][2] + v[rr][1][3] * v[rr][1][3];
            const float q2 = v[rr][2][0] * v[rr][2][0] + v[rr][2][1] * v[rr][2][1] + v[rr][2][2] * v[rr][2][2] + v[rr][2][3] * v[rr][2][3];
            s0[rr] = q0 + (isq1 ? q1 : 0.f); s1[rr] = (isq1 ? 0.f : q1) + (lane < 32 ? q2 : 0.f); s2[rr] = iskr ? q2 : 0.f;
        }
#pragma unroll
        for (int o = 32; o; o >>= 1) {
#pragma unroll
            for (int rr = 0; rr < 2; ++rr) { s0[rr] += __shfl_xor(s0[rr], o); s1[rr] += __shfl_xor(s1[rr], o); s2[rr] += __shfl_xor(s2[rr], o); }
        }
#pragma unroll
        for (int rr = 0; rr < 2; ++rr) {
            const int row = r0 + rr, b = row / RPB, rb = row - b * RPB;
            const float i0 = rsqrtf(s0[rr] * (1.f / 384.f) + EPS), i1 = rsqrtf(s1[rr] * (1.f / 256.f) + EPS), i2 = rsqrtf(s2[rr] * (1.f / 64.f) + EPS);
            { const f32x4 o = v[rr][0] * i0 * g0; u32x2 w = {pk2(o[0], o[1]), pk2(o[2], o[3])}; *(u32x2*)(cq + (size_t)row * 384 + 4 * lane) = w; }
            if (isq1) { const f32x4 o = v[rr][1] * i0 * g1; u32x2 w = {pk2(o[0], o[1]), pk2(o[2], o[3])}; *(u32x2*)(cq + (size_t)row * 384 + 256 + 4 * lane) = w; }
            else { const f32x4 o = v[rr][1] * i1 * g1; u32x2 w = {pk2(o[0], o[1]), pk2(o[2], o[3])}; *(u32x2*)(ckv + (size_t)row * 256 + 4 * (lane - 32)) = w; }
            if (lane < 32) { const f32x4 o = v[rr][2] * i1 * g2; u32x2 w = {pk2(o[0], o[1]), pk2(o[2], o[3])}; *(u32x2*)(ckv + (size_t)row * 256 + 128 + 4 * lane) = w; }
            f32x4 x = v[rr][2] * i2 * g2;
            f32x4 xp; xp[0] = __shfl_xor(x[0], 4); xp[1] = __shfl_xor(x[1], 4); xp[2] = __shfl_xor(x[2], 4); xp[3] = __shfl_xor(x[3], 4);
            if (iskr) {
                if (rb >= CTXL) {
                    const int t = rb - CTXL, d0 = 4 * (lane - 32), q4 = d0 >> 4, k0 = d0 & 15, pos = q4 < 2 ? (t >> 6) : (t & 63);
                    const f32x4 cs = *(const f32x4*)(tb + pos * 32 + k0), sn = *(const f32x4*)(tb + pos * 32 + 16 + k0);
                    x = x * cs + ((q4 & 1) ? xp : -xp) * sn;
                }
                u32x2 w = {pk2(x[0], x[1]), pk2(x[2], x[3])}; *(u32x2*)(kr + (size_t)row * 64 + 4 * (lane - 32)) = w;
            }
        }
    }
}
DI void mla_rowop_a5(const Params& p, int j, bool latonly) {
    const int lane = TIDX() & 63, gw = BIDX() * NWAVES + (TIDX() >> 6), nw = GDIM() * NWAVES;
    const int hg = lane >> 3, l8 = lane & 7, q4 = l8 >> 1, k0 = 8 * (l8 & 1);
    bf16_t* qp = (bf16_t*)(p.ws + WS_T + T_QPRE); bf16_t* kv = (bf16_t*)(p.ws + WS_T + T_KVPRE);
    const float* tb = (const float*)(p.ws + WS_ROPE);
    const float* gqk = IN(p, 13) + j * 384;
    f32x4 gqn[4], gqr[2], gkn[4];
#pragma unroll
    for (int i = 0; i < 4; ++i) { gqn[i] = *(const f32x4*)(gqk + 16 * l8 + 4 * i); gkn[i] = *(const f32x4*)(gqk + 192 + 16 * l8 + 4 * i); }
    gqr[0] = *(const f32x4*)(gqk + 128 + 8 * l8); gqr[1] = *(const f32x4*)(gqk + 128 + 8 * l8 + 4);
    for (int r0 = gw * 2; r0 < MROWS; r0 += nw * 2) {
        const int b = r0 / RPB, rb0 = r0 - b * RPB; const bool isctx = rb0 < CTXL;
        const bool doq = !(latonly && isctx);
        u32x4 qn[2][2], qrp[2], kn[2][2];
#pragma unroll
        for (int rr = 0; rr < 2; ++rr) {
            const bf16_t* qr = qp + (size_t)(r0 + rr) * 1536 + hg * 192; const bf16_t* kr_ = kv + (size_t)(r0 + rr) * 2048 + hg * 256 + 16 * l8;
            if (doq) { qn[rr][0] = *(const u32x4*)(qr + 16 * l8); qn[rr][1] = *(const u32x4*)(qr + 16 * l8 + 8); qrp[rr] = *(const u32x4*)(qr + 128 + 8 * l8); }
            else { qn[rr][0] = qn[rr][1] = qrp[rr] = (u32x4){0, 0, 0, 0}; }
            kn[rr][0] = *(const u32x4*)kr_; kn[rr][1] = *(const u32x4*)(kr_ + 8);
        }
#pragma unroll
        for (int rr = 0; rr < 2; ++rr) {
            const int row = r0 + rr;
            float a[16], r[8], k[16];
#pragma unroll
            for (int i = 0; i < 4; ++i) { a[2 * i] = bflo(qn[rr][0][i]); a[2 * i + 1] = bfhi(qn[rr][0][i]); a[8 + 2 * i] = bflo(qn[rr][1][i]); a[8 + 2 * i + 1] = bfhi(qn[rr][1][i]);
                r[2 * i] = bflo(qrp[rr][i]); r[2 * i + 1] = bfhi(qrp[rr][i]);
                k[2 * i] = bflo(kn[rr][0][i]); k[2 * i + 1] = bfhi(kn[rr][0][i]); k[8 + 2 * i] = bflo(kn[rr][1][i]); k[8 + 2 * i + 1] = bfhi(kn[rr][1][i]); }
            float sa = 0.f, sr = 0.f, sk = 0.f;
#pragma unroll
            for (int i = 0; i < 16; ++i) { sa += a[i] * a[i]; sk += k[i] * k[i]; }
#pragma unroll
            for (int i = 0; i < 8; ++i) sr += r[i] * r[i];
            sa = sum8(sa); sr = sum8(sr); sk = sum8(sk);
            const float ia = rsqrtf(sa * (1.f / 128.f) + EPS) * QSCALE, ir = rsqrtf(sr * (1.f / 64.f) + EPS), ik = rsqrtf(sk * (1.f / 128.f) + EPS);
            if (doq) {
                bf16_t* qr = qp + (size_t)row * 1536 + hg * 192;
                u32x4 w0, w1;
#pragma unroll
                for (int i = 0; i < 4; ++i) { w0[i] = pk2(a[2 * i] * ia * gqn[i >> 1][(2 * i) & 3], a[2 * i + 1] * ia * gqn[i >> 1][(2 * i + 1) & 3]);
                    w1[i] = pk2(a[8 + 2 * i] * ia * gqn[2 + (i >> 1)][(2 * i) & 3], a[8 + 2 * i + 1] * ia * gqn[2 + (i >> 1)][(2 * i + 1) & 3]); }
                *(u32x4*)(qr + 16 * l8) = w0; *(u32x4*)(qr + 16 * l8 + 8) = w1;
                float x[8];
#pragma unroll
                for (int i = 0; i < 8; ++i) x[i] = r[i] * ir * gqr[i >> 2][i & 3];
                if (!isctx) {
                    const int t = rb0 + rr - CTXL, pos = q4 < 2 ? (t >> 6) : (t & 63);
                    const f32x4 c0 = *(const f32x4*)(tb + pos * 32 + k0), c1 = *(const f32x4*)(tb + pos * 32 + k0 + 4), s0 = *(const f32x4*)(tb + pos * 32 + 16 + k0), s1 = *(const f32x4*)(tb + pos * 32 + 16 + k0 + 4);
#pragma unroll
                    for (int i = 0; i < 8; ++i) { const float xp = __shfl_xor(x[i], 2); const float cs = i < 4 ? c0[i & 3] : c1[i & 3], sn = i < 4 ? s0[i & 3] : s1[i & 3];
                        x[i] = x[i] * cs + ((q4 & 1) ? xp : -xp) * sn; }
                }
                u32x4 wr_;
#pragma unroll
                for (int i = 0; i < 4; ++i) wr_[i] = pk2(x[2 * i] * QSCALE, x[2 * i + 1] * QSCALE);
                *(u32x4*)(qr + 128 + 8 * l8) = wr_;
            }
            bf16_t* kr_ = kv + (size_t)row * 2048 + hg * 256 + 16 * l8;
            u32x4 k0w, k1w;
#pragma unroll
            for (int i = 0; i < 4; ++i) { k0w[i] = pk2(k[2 * i] * ik * gkn[i >> 1][(2 * i) & 3], k[2 * i + 1] * ik * gkn[i >> 1][(2 * i + 1) & 3]);
                k1w[i] = pk2(k[8 + 2 * i] * ik * gkn[2 + (i >> 1)][(2 * i) & 3], k[8 + 2 * i + 1] * ik * gkn[2 + (i >> 1)][(2 * i + 1) & 3]); }
            *(u32x4*)kr_ = k0w; *(u32x4*)(kr_ + 8) = k1w;
        }
    }
}

namespace attn {
constexpr int LDQ = 1536, LDKN = 2048, LDKR = 64, LDO = 1024, KVBLK = 64;
constexpr int SHM_V = KVBLK * 128 * 2, SHM_KN = KVBLK * 128 * 2, SHM_KR = KVBLK * 64 * 2;
constexpr int OFF_V = 0, OFF_KN = 2 * SHM_V, OFF_KR = OFF_KN + 2 * SHM_KN, OFF_WS = OFF_KR + 2 * SHM_KR, OFF_QR = OFF_WS + NWAVES * 64 * 4, LDS_BYTES = OFF_QR + NWAVES * 4096;
constexpr float THRL = 8.f * 1.4426950408889634f;
#define KSWZ(row, colB) ((row) * 256 + ((colB) ^ (((row) & 7) << 4)))
#define RSWZ(row, colB) ((row) * 128 + ((colB) ^ ((((row) >> 1) & 7) << 4)))
#define SBAR() __builtin_amdgcn_sched_barrier(0)
DI int crow(int r, int hi) { return (r & 3) + 8 * (r >> 2) + 4 * hi; }
DI unsigned cvtpk(float lo, float hi) { unsigned r; asm volatile("v_cvt_pk_bf16_f32 %0, %1, %2" : "=v"(r) : "v"(lo), "v"(hi)); return r; }

DI void partialSM(f32x16& p0, f32x16& p1, float& m_reg, float& mn, float& alpha) {
    float pmax = p0[0];
#pragma unroll
    for (int r = 1; r < 16; ++r) pmax = fmaxf(pmax, p0[r]);
#pragma unroll
    for (int r = 0; r < 16; ++r) pmax = fmaxf(pmax, p1[r]);
    { auto rr = __builtin_amdgcn_permlane32_swap(__float_as_uint(pmax), __float_as_uint(pmax), false, false);
      pmax = fmaxf(__uint_as_float(rr[0]), __uint_as_float(rr[1])); }
    if (__builtin_expect(__all(pmax - m_reg <= THRL), 1)) { mn = m_reg; alpha = 1.f; }
    else { mn = fmaxf(m_reg, pmax); alpha = __builtin_amdgcn_exp2f(m_reg - mn); m_reg = mn; }
#pragma unroll
    for (int r = 0; r < 16; ++r) p0[r] = p0[r] - mn;
#pragma unroll
    for (int r = 0; r < 16; ++r) p1[r] = p1[r] - mn;
#pragma unroll
    for (int r = 0; r < 16; ++r) p0[r] = __builtin_amdgcn_exp2f(p0[r]);
}
DI void finishSM(f32x16& p0, f32x16& p1, float alpha, float& l_reg, bf16x8& pa0, bf16x8& pa1, bf16x8& pa2, bf16x8& pa3) {
#pragma unroll
    for (int r = 0; r < 16; ++r) p1[r] = __builtin_amdgcn_exp2f(p1[r]);
    float ps = 0;
#pragma unroll
    for (int r = 0; r < 16; ++r) ps += p0[r];
#pragma unroll
    for (int r = 0; r < 16; ++r) ps += p1[r];
    { auto rr = __builtin_amdgcn_permlane32_swap(__float_as_uint(ps), __float_as_uint(ps), false, false);
      ps = __uint_as_float(rr[0]) + __uint_as_float(rr[1]); }
    l_reg = l_reg * alpha + ps;
#define PK4(P, BASE, OUT) do { unsigned a0 = cvtpk(P[BASE + 0], P[BASE + 1]), a1 = cvtpk(P[BASE + 2], P[BASE + 3]);   \
    unsigned b0 = cvtpk(P[BASE + 4], P[BASE + 5]), b1 = cvtpk(P[BASE + 6], P[BASE + 7]);                              \
    auto r0 = __builtin_amdgcn_permlane32_swap(a0, b0, false, false); auto r1 = __builtin_amdgcn_permlane32_swap(a1, b1, false, false); \
    u32x4 w = {r0[0], r1[0], r0[1], r1[1]}; OUT = *reinterpret_cast<bf16x8*>(&w); } while (0)
    PK4(p0, 0, pa0); PK4(p0, 8, pa1); PK4(p1, 0, pa2); PK4(p1, 8, pa3);
#undef PK4
}
DI void qkt(f32x16& p0, f32x16& p1, const char* Kn, const char* Kr, const bf16x8* qr, const char* qrl, int r32, int hi) {
    p0 = f32x16{}; p1 = f32x16{};
#pragma unroll
    for (int d0 = 0; d0 < 8; ++d0) { const int cb = (d0 * 16 + hi * 8) * 2;
        const bf16x8 b0 = *reinterpret_cast<const bf16x8*>(Kn + KSWZ(r32, cb));
        const bf16x8 b1 = *reinterpret_cast<const bf16x8*>(Kn + KSWZ(32 + r32, cb));
        p0 = __builtin_amdgcn_mfma_f32_32x32x16_bf16(b0, qr[d0], p0, 0, 0, 0);
        p1 = __builtin_amdgcn_mfma_f32_32x32x16_bf16(b1, qr[d0], p1, 0, 0, 0); }
#pragma unroll
    for (int d0 = 0; d0 < 4; ++d0) { const int cb = (d0 * 16 + hi * 8) * 2;
        const bf16x8 b0 = *reinterpret_cast<const bf16x8*>(Kr + RSWZ(r32, cb));
        const bf16x8 b1 = *reinterpret_cast<const bf16x8*>(Kr + RSWZ(32 + r32, cb));
        const bf16x8 qf = *reinterpret_cast<const bf16x8*>(qrl + d0 * 1024);
        p0 = __builtin_amdgcn_mfma_f32_32x32x16_bf16(b0, qf, p0, 0, 0, 0);
        p1 = __builtin_amdgcn_mfma_f32_32x32x16_bf16(b1, qf, p1, 0, 0, 0); }
}
DI int v_st(int k, int c) { const int kk = (k & ~0xC) | ((k & 4) << 1) | ((k & 8) >> 1); return ((kk >> 3) * 4 + (c >> 5)) * 512 + ((kk & 7) * 32 + (c & 31)) * 2; }
DI int v_rd_base(int lane) { return ((lane & 3) << 3) | (((lane >> 2) & 3) << 6) | (((lane >> 4) & 1) << 5) | (((lane >> 5) & 1) << 8); }
constexpr int v_rd_off(int d0, int ks, int half) { return d0 * 512 + ks * 4096 + half * 2048; }
template <int OFF> DI s16x4 tr_read(int vb) { s16x4 r; asm volatile("ds_read_b64_tr_b16 %0, %1 offset:%2" : "=&v"(r) : "v"(vb), "i"(OFF) : "memory"); return r; }
template <int D0> DI void pv_one(f32x16& od, int vb, bf16x8 pa0, bf16x8 pa1, bf16x8 pa2, bf16x8 pa3) {
    const s16x4 l0 = tr_read<v_rd_off(D0, 0, 0)>(vb), h0 = tr_read<v_rd_off(D0, 0, 1)>(vb), l1 = tr_read<v_rd_off(D0, 1, 0)>(vb), h1 = tr_read<v_rd_off(D0, 1, 1)>(vb);
    const s16x4 l2 = tr_read<v_rd_off(D0, 2, 0)>(vb), h2 = tr_read<v_rd_off(D0, 2, 1)>(vb), l3 = tr_read<v_rd_off(D0, 3, 0)>(vb), h3 = tr_read<v_rd_off(D0, 3, 1)>(vb);
    asm volatile("s_waitcnt lgkmcnt(0)" ::: "memory"); SBAR();
#define PK(L, H) (bf16x8){L[0], L[1], L[2], L[3], H[0], H[1], H[2], H[3]}
    od = __builtin_amdgcn_mfma_f32_32x32x16_bf16(pa0, PK(l0, h0), od, 0, 0, 0);
    od = __builtin_amdgcn_mfma_f32_32x32x16_bf16(pa1, PK(l1, h1), od, 0, 0, 0);
    od = __builtin_amdgcn_mfma_f32_32x32x16_bf16(pa2, PK(l2, h2), od, 0, 0, 0);
    od = __builtin_amdgcn_mfma_f32_32x32x16_bf16(pa3, PK(l3, h3), od, 0, 0, 0);
#undef PK
}
DI void pv_d0(f32x16* o, int vb, bf16x8 pa0, bf16x8 pa1, bf16x8 pa2, bf16x8 pa3) {
    pv_one<0>(o[0], vb, pa0, pa1, pa2, pa3); pv_one<1>(o[1], vb, pa0, pa1, pa2, pa3); pv_one<2>(o[2], vb, pa0, pa1, pa2, pa3); pv_one<3>(o[3], vb, pa0, pa1, pa2, pa3);
}
DI void attn_unit(const bf16_t* __restrict__ Qb, const bf16_t* __restrict__ Knb, const bf16_t* __restrict__ Krb, const bf16_t* __restrict__ Vb, bf16_t* __restrict__ Ob, int seq, char* lds) {
    const int tid = TIDX(), wid = tid >> 6, lane = tid & 63, r32 = lane & 31, hi = lane >> 5;
    char* V_lds = lds + OFF_V; char* Kn_lds = lds + OFF_KN; char* Kr_lds = lds + OFF_KR;
    float* ws = (float*)(lds + OFF_WS) + wid * 64; float* li_l = ws; float* al_l = ws + 32;
    float m_reg = -1e30f, l_reg = 0; f32x16 o[4] = {}; bf16x8 qr[8];
    const bf16_t* Qw = Qb + (long)(wid * 32 + r32) * LDQ + hi * 8;
    char* qrl = lds + OFF_QR + wid * 4096 + lane * 16;
#pragma unroll
    for (int d0 = 0; d0 < 8; ++d0) qr[d0] = *reinterpret_cast<const bf16x8*>(Qw + d0 * 16);
#pragma unroll
    for (int d0 = 0; d0 < 4; ++d0) *reinterpret_cast<bf16x8*>(qrl + d0 * 1024) = *reinterpret_cast<const bf16x8*>(Qw + 128 + d0 * 16);
    const int sr = tid >> 4, sc = (tid & 15) * 8, vst0 = v_st(sr, sc), vst1 = v_st(32 + sr, sc);
    const int rr_ = tid >> 3, rc_ = (tid & 7) * 8;
    const int vb0 = (int)(uintptr_t)V_lds + v_rd_base(lane);
    struct { bf16x8 vs0, vs1, ks0, ks1, kr; } sr_[1];
#define SLOAD(i, k0) do { sr_[i].vs0 = *(const bf16x8*)(&Vb[(long)((k0) + sr) * LDKN + sc]); sr_[i].vs1 = *(const bf16x8*)(&Vb[(long)((k0) + 32 + sr) * LDKN + sc]); \
    sr_[i].ks0 = *(const bf16x8*)(&Knb[(long)((k0) + sr) * LDKN + sc]); sr_[i].ks1 = *(const bf16x8*)(&Knb[(long)((k0) + 32 + sr) * LDKN + sc]); \
    sr_[i].kr = *(const bf16x8*)(&Krb[(long)((k0) + rr_) * LDKR + rc_]); } while (0)
#define SWRITE(b, i) do { *(bf16x8*)(V_lds + (b) * SHM_V + vst0) = sr_[i].vs0; *(bf16x8*)(V_lds + (b) * SHM_V + vst1) = sr_[i].vs1; const int kc = sc * 2; \
    *(bf16x8*)(Kn_lds + (b) * SHM_KN + KSWZ(sr, kc)) = sr_[i].ks0; *(bf16x8*)(Kn_lds + (b) * SHM_KN + KSWZ(32 + sr, kc)) = sr_[i].ks1; \
    *(bf16x8*)(Kr_lds + (b) * SHM_KR + RSWZ(rr_, rc_ * 2)) = sr_[i].kr; } while (0)
#define SWAIT() asm volatile("s_waitcnt vmcnt(0)" ::: "memory")
#define RESC(a) do { if (__any((a) < 1.f)) { if (hi == 0) al_l[r32] = (a); asm volatile("s_waitcnt lgkmcnt(0)" ::: "memory"); \
    _Pragma("unroll") for (int d = 0; d < 4; ++d) _Pragma("unroll") for (int r = 0; r < 16; ++r) o[d][r] *= al_l[crow(r, hi)]; } } while (0)
    f32x16 pA0, pA1, pB0, pB1; float mnA, mnB, alA, alB; bf16x8 pa0, pa1, pa2, pa3; const int NT = seq / KVBLK;
    constexpr int SE = 0, SO = 0;
    SLOAD(SE, 0); asm volatile("s_waitcnt vmcnt(0)" ::: "memory"); SWRITE(0, SE); __syncthreads();
    qkt(pA0, pA1, Kn_lds, Kr_lds, qr, qrl, r32, hi); partialSM(pA0, pA1, m_reg, mnA, alA);
    SLOAD(SO, KVBLK);
    SWAIT(); SWRITE(1, SO); __syncthreads();
    for (int j = 1; j + 1 < NT; j += 2) {
        SBAR(); qkt(pB0, pB1, Kn_lds + SHM_KN, Kr_lds + SHM_KR, qr, qrl, r32, hi);
        finishSM(pA0, pA1, alA, l_reg, pa0, pa1, pa2, pa3); SBAR();
        SLOAD(SE, (j + 1) * KVBLK); SBAR();
        pv_d0(o, vb0, pa0, pa1, pa2, pa3); partialSM(pB0, pB1, m_reg, mnB, alB);
        __syncthreads(); SWAIT(); SWRITE(0, SE);
        RESC(alB); __syncthreads();
        SBAR(); qkt(pA0, pA1, Kn_lds, Kr_lds, qr, qrl, r32, hi);
        finishSM(pB0, pB1, alB, l_reg, pa0, pa1, pa2, pa3); SBAR();
        SLOAD(SO, (j + 2) * KVBLK); SBAR();
        pv_d0(o, vb0 + SHM_V, pa0, pa1, pa2, pa3); partialSM(pA0, pA1, m_reg, mnA, alA);
        __syncthreads(); SWAIT(); SWRITE(1, SO);
        RESC(alA); __syncthreads();
    }
    SBAR(); qkt(pB0, pB1, Kn_lds + SHM_KN, Kr_lds + SHM_KR, qr, qrl, r32, hi);
    finishSM(pA0, pA1, alA, l_reg, pa0, pa1, pa2, pa3); SBAR();
    pv_d0(o, vb0, pa0, pa1, pa2, pa3); partialSM(pB0, pB1, m_reg, mnB, alB);
    __syncthreads(); RESC(alB);
    finishSM(pB0, pB1, alB, l_reg, pa0, pa1, pa2, pa3); SBAR();
    pv_d0(o, vb0 + SHM_V, pa0, pa1, pa2, pa3);
    if (hi == 0) li_l[r32] = l_reg; asm volatile("s_waitcnt lgkmcnt(0)" ::: "memory");
    float rli[16];
#pragma unroll
    for (int r = 0; r < 16; ++r) rli[r] = __builtin_amdgcn_rcpf(li_l[crow(r, hi)]);
    bf16_t* Ow = Ob + (long)(wid * 32) * LDO;
#pragma unroll
    for (int r = 0; r < 16; ++r) { const int orow = crow(r, hi);
#pragma unroll
        for (int d0 = 0; d0 < 4; ++d0) Ow[(long)orow * LDO + d0 * 32 + r32] = (bf16_t)f2bf(o[d0][r] * rli[r]); }
    __syncthreads();
#undef SLOAD
#undef SWRITE
#undef SWAIT
#undef RESC
}
}
DI void attn_phase(const Params& p, bool need_ctx, char* lds) {
    const bf16_t* qp = (const bf16_t*)(p.ws + WS_T + T_QPRE); const bf16_t* kv = (const bf16_t*)(p.ws + WS_T + T_KVPRE); const bf16_t* kr = (const bf16_t*)(p.ws + WS_T + T_KR);
    bf16_t* O = hbuf(p);
    const int G = GDIM(), bx = BIDX(), vcu = (G % 8 == 0) ? (bx % 8) * (G / 8) + bx / 8 : bx;
    const int nun = 512 + (need_ctx ? 32 : 0);
    for (int u = vcu; u < nun; u += G) {
        int b, h, qrow0, nkeys;
        if (u < 512) { const int bh = u >> 4, qb = u & 15; b = bh >> 3; h = bh & 7; qrow0 = b * RPB + CTXL + qb * 256; nkeys = RPB; }
        else { const int bh = u - 512; b = bh >> 3; h = bh & 7; qrow0 = b * RPB; nkeys = CTXL; }
        const size_t krow0 = (size_t)b * RPB;
        attn::attn_unit(qp + (size_t)qrow0 * 1536 + h * 192, kv + krow0 * 2048 + h * 256, kr + krow0 * 64, kv + krow0 * 2048 + h * 256 + 128,
                        O + (size_t)qrow0 * 1024 + h * 128, nkeys, lds);
    }
}

constexpr size_t S5_ABAR = 0, S5_A128 = 65536, S5_BFRAG = 131072, S5_CFRAG = 131072 + 1048576;
constexpr int S5_CH = 128, S5_NCH = RPB / S5_CH;
DI f32x2 cmul(f32x2 a, f32x2 b) { return (f32x2){a.x * b.x - a.y * b.y, a.x * b.y + a.y * b.x}; }
DI void s5_prep(const Params& p) {
    const int gt = BIDX() * NTHREADS + TIDX(), ntot = GDIM() * NTHREADS;
    unsigned char* base = p.ws + WS_S5C;
    for (int idx = gt; idx < 2 * 64 * 64; idx += ntot) {
        const int dir = idx >> 12, g = (idx >> 6) & 63, s = idx & 63;
        const float are = IN(p, 15)[idx], aim = IN(p, 16)[idx], dt = expf(IN(p, 17)[dir * 64 + g]);
        float sn, cs; sincosf(aim * dt, &sn, &cs); const float er = expf(are * dt);
        const f32x2 ab = {er * cs, er * sn};
        sincosf(aim * dt * (float)S5_CH, &sn, &cs); const float er2 = expf(are * dt * (float)S5_CH);
        ((f32x2*)(base + S5_ABAR))[idx] = ab; ((f32x2*)(base + S5_A128))[idx] = (f32x2){er2 * cs, er2 * sn};
    }
    for (int idx = gt; idx < 2 * 64 * 8 * 64; idx += ntot) {
        const int lane = idx & 63, blk = (idx >> 6) & 7, g = (idx >> 9) & 63, dir = idx >> 15;
        const int kp = 16 * blk + (lane & 15), q = lane >> 4, s = kp >> 1;
        u32x4 w = {0, 0, 0, 0};
        if (q < 2) {
            const int ai = (dir * 64 + g) * 64 + s;
            const float are = IN(p, 15)[ai], aim = IN(p, 16)[ai], dt = expf(IN(p, 17)[dir * 64 + g]);
            float sn, cs; sincosf(aim * dt, &sn, &cs); const float er = expf(are * dt);
            const f32x2 num = {er * cs - 1.f, er * sn}; const float den = are * are + aim * aim;
            const f32x2 coef = {(num.x * are + num.y * aim) / den, (num.y * are - num.x * aim) / den};
            float vals[8];
#pragma unroll
            for (int jj = 0; jj < 8; ++jj) { const int i = 8 * q + jj; const size_t bi = ((size_t)(dir * 64 + g) * 64 + s) * 16 + i;
                const f32x2 bb = cmul(coef, (f32x2){IN(p, 18)[bi], IN(p, 19)[bi]}); vals[jj] = (kp & 1) == 0 ? bb.x : bb.y; }
            w = (u32x4){pk2(vals[0], vals[1]), pk2(vals[2], vals[3]), pk2(vals[4], vals[5]), pk2(vals[6], vals[7])};
        }
        ((u32x4*)(base + S5_BFRAG))[idx] = w;
    }
    for (int idx = gt; idx < 2 * 64 * 4 * 64; idx += ntot) {
        const int lane = idx & 63, ks = (idx >> 6) & 3, g = (idx >> 8) & 63, dir = idx >> 14;
        const int i = lane & 15, q = lane >> 4; float vals[8];
#pragma unroll
        for (int jj = 0; jj < 8; ++jj) { const int kp = 32 * ks + 8 * q + jj, s = kp >> 1; const size_t ci = ((size_t)(dir * 64 + g) * 16 + i) * 64 + s;
            vals[jj] = (kp & 1) == 0 ? IN(p, 20)[ci] : -IN(p, 21)[ci]; }
        ((u32x4*)(base + S5_CFRAG))[idx] = (u32x4){pk2(vals[0], vals[1]), pk2(vals[2], vals[3]), pk2(vals[4], vals[5]), pk2(vals[6], vals[7])};
    }
}
constexpr int S5_L1S = 132, S5_L2S = 136, S5_WLDS = 12800;
template <bool PROJ, bool REV>
DI void s5_sub(const bf16x8 uf, const bf16x8 (&bf)[8], const bf16x8 (&cf)[4], f32x2 ab, f32x2& st, f32x4& yacc, char* wl, int lane) {
    float* L1 = (float*)wl; bf16_t* L2 = (bf16_t*)(wl + 8448);
    const int t = lane & 15, q = lane >> 4;
    const float zf = ZF(); const f32x4 zero4 = {zf, zf, zf, zf};
    LDS_FENCE();
#pragma unroll
    for (int blk = 0; blk < 8; ++blk) {
        const f32x4 d = __builtin_amdgcn_mfma_f32_16x16x32_bf16(bf[blk], uf, zero4, 0, 0, 0);
        *(f32x4*)(L1 + t * S5_L1S + 16 * blk + 4 * q) = d;
    }
    LDS_FENCE();
    f32x2 bu[16];
#pragma unroll
    for (int s = 0; s < 16; ++s) bu[s] = *(const f32x2*)(L1 + s * S5_L1S + 2 * lane);
#pragma unroll
    for (int s = 0; s < 16; ++s) {
        const int tt = REV ? 15 - s : s;
        const f32x2 b_ = bu[tt];
        const f32x2 n = {ab.x * st.x - ab.y * st.y + b_.x, ab.x * st.y + ab.y * st.x + b_.y};
        st = n;
        if (PROJ) ((unsigned*)L2)[tt * (S5_L2S / 2) + lane] = pk2(n.x, n.y);
    }
    if (PROJ) {
        LDS_FENCE();
#pragma unroll
        for (int ks = 0; ks < 4; ++ks) {
            const bf16x8 sf = *(const bf16x8*)(L2 + t * S5_L2S + 32 * ks + 8 * q);
            yacc = __builtin_amdgcn_mfma_f32_16x16x32_bf16(sf, cf[ks], yacc, 0, 0, 0);
        }
    }
}
DI void s5_load_frags(const Params& p, int dir, int g, int lane, bf16x8 (&bf)[8], bf16x8 (&cf)[4], f32x2& ab, f32x2& a128) {
    const unsigned char* base = p.ws + WS_S5C;
#pragma unroll
    for (int blk = 0; blk < 8; ++blk) bf[blk] = ((const bf16x8*)(base + S5_BFRAG))[((dir * 64 + g) * 8 + blk) * 64 + lane];
#pragma unroll
    for (int ks = 0; ks < 4; ++ks) cf[ks] = ((const bf16x8*)(base + S5_CFRAG))[((dir * 64 + g) * 4 + ks) * 64 + lane];
    ab = ((const f32x2*)(base + S5_ABAR))[(dir * 64 + g) * 64 + lane]; a128 = ((const f32x2*)(base + S5_A128))[(dir * 64 + g) * 64 + lane];
}
DI void s5_load_u(const bf16_t* h, int row0, int g, int lane, bf16x8 (&uf)[8]) {
    const int t = lane & 15, q = lane >> 4;
#pragma unroll
    for (int sb = 0; sb < 8; ++sb) { uf[sb] = (bf16x8){0, 0, 0, 0, 0, 0, 0, 0}; if (q < 2) uf[sb] = *(const bf16x8*)(h + (size_t)(row0 + 16 * sb + t) * DM + 16 * g + 8 * q); }
}
DI void s5_pass1(const Params& p, char* lds) {
    const int lane = TIDX() & 63, wave = TIDX() >> 6, gw = BIDX() * NWAVES + wave, nw = GDIM() * NWAVES;
    char* wl = lds + wave * S5_WLDS;
    const bf16_t* h = hbuf(p);
    f32x2* E = (f32x2*)(p.ws + WS_T + T_S5E);
    for (int task = gw; task < NB * S5_NCH * 64; task += nw) {
        const int g = task & 63, bc = task >> 6, c = bc % S5_NCH, b = bc / S5_NCH;
        const int row0 = b * RPB + c * S5_CH;
        bf16x8 uf[8]; s5_load_u(h, row0, g, lane, uf);
        for (int dir = 0; dir < 2; ++dir) {
            bf16x8 bf[8], cf[4]; f32x2 ab, a128; s5_load_frags(p, dir, g, lane, bf, cf, ab, a128);
            f32x2 st = {0.f, 0.f}; f32x4 dummy = {0, 0, 0, 0};
            if (dir == 0) {
#pragma unroll
                for (int sb = 0; sb < 8; ++sb) s5_sub<false, false>(uf[sb], bf, cf, ab, st, dummy, wl, lane);
            } else {
#pragma unroll
                for (int sb = 0; sb < 8; ++sb) s5_sub<false, true>(uf[7 - sb], bf, cf, ab, st, dummy, wl, lane);
            }
            E[(((size_t)(b * 64 + g) * 2 + dir) * S5_NCH + c) * 64 + lane] = st;
        }
    }
}
template <int DIR> DI void s5_chain(const f32x2* Eb, f32x2* Sb, f32x2 a128) {
    f32x2 e[S5_NCH];
#pragma unroll
    for (int k = 0; k < S5_NCH; ++k) e[k] = Eb[k * 64];
    float zz = 0.f; asm volatile("" : "+v"(zz));
    f32x2 st = {zz, zz};
#pragma unroll
    for (int k = 0; k < S5_NCH; ++k) {
        const int c = DIR == 0 ? k : (k < 2 ? 1 - k : S5_NCH + 1 - k);
        Sb[c * 64] = st;
        st = cmul(a128, st); st.x += e[c].x; st.y += e[c].y;
    }
}
DI void s5_carry(const Params& p) {
    const int lane = TIDX() & 63, gw = BIDX() * NWAVES + (TIDX() >> 6), nw = GDIM() * NWAVES;
    for (int w = gw; w < NB * 64 * 2; w += nw) {
        const int dir = w & 1, g = (w >> 1) & 63;
        const f32x2 a128 = ((const f32x2*)(p.ws + WS_S5C + S5_A128))[(dir * 64 + g) * 64 + lane];
        const f32x2* Eb = (const f32x2*)(p.ws + WS_T + T_S5E) + (size_t)w * S5_NCH * 64 + lane;
        f32x2* Sb = (f32x2*)(p.ws + WS_T + T_S5S) + (size_t)w * S5_NCH * 64 + lane;
        if (dir == 0) s5_chain<0>(Eb, Sb, a128); else s5_chain<1>(Eb, Sb, a128);
    }
}
DI void s5_pass3(const Params& p, int j, bool latonly, char* lds) {
    const int lane = TIDX() & 63, wave = TIDX() >> 6, gw = BIDX() * NWAVES + wave, nw = GDIM() * NWAVES;
    char* wl = lds + wave * S5_WLDS;
    const bf16_t* h = hbuf(p);
    const f32x2* S = (const f32x2*)(p.ws + WS_T + T_S5S);
    bf16_t* z = (bf16_t*)(p.ws + WS_T + T_Z);
    const float* dd = IN(p, 22) + j * 1024;
    for (int task = gw; task < NB * S5_NCH * 64; task += nw) {
        const int g = task & 63, bc = task >> 6, c = bc % S5_NCH, b = bc / S5_NCH;
        if (latonly && c < 2) continue;
        const int row0 = b * RPB + c * S5_CH;
        bf16x8 uf[8]; s5_load_u(h, row0, g, lane, uf);
        f32x4 yacc[8];
#pragma unroll
        for (int i = 0; i < 8; ++i) { const float z = ZF(); yacc[i] = (f32x4){z, z, z, z}; }
        for (int dir = 0; dir < 2; ++dir) {
            bf16x8 bf[8], cf[4]; f32x2 ab, a128; s5_load_frags(p, dir, g, lane, bf, cf, ab, a128);
            f32x2 st = S[(((size_t)(b * 64 + g) * 2 + dir) * S5_NCH + c) * 64 + lane];
            if (dir == 0) {
#pragma unroll
                for (int sb = 0; sb < 8; ++sb) s5_sub<true, false>(uf[sb], bf, cf, ab, st, yacc[sb], wl, lane);
            } else {
#pragma unroll
                for (int sb = 0; sb < 8; ++sb) s5_sub<true, true>(uf[7 - sb], bf, cf, ab, st, yacc[7 - sb], wl, lane);
            }
        }
        const int i = lane & 15, q = lane >> 4; const float dv = dd[16 * g + i];
#pragma unroll
        for (int sb = 0; sb < 8; ++sb)
#pragma unroll
            for (int r = 0; r < 4; ++r) {
                const size_t off = (size_t)(row0 + 16 * sb + 4 * q + r) * DM + 16 * g + i;
                const float y = bf2f(h[off]) * dv + yacc[sb][r];
                z[off] = (bf16_t)f2bf(gelu_tanh(y));
            }
    }
}


#ifndef S5_PROBE
#define S5_PROBE 0
#endif
#ifndef S5_REPS
#define S5_REPS 1
#endif
namespace s5v2 {
constexpr size_t C_APOW = 0, C_A128 = 589824, C_COEF = C_A128 + 65536;
constexpr size_t T_XS = 40 * MiB;
constexpr int L_WE = 0, L_CA = 0, L_TEND = 69632, L_CARRY = 69632  , L_BBAR = 69632  , L_KP = 104448, L_PW = 120832, L_APOW = 137216, L_C = 146432, RS = 136;
DI f32x2 cexp_(float re, float im) { float sn, cs; sincosf(im, &sn, &cs); const float e = expf(re); return (f32x2){e * cs, e * sn}; }
DI void prep(const Params& p) {
    const int gt = BIDX() * NTHREADS + TIDX(), ntot = GDIM() * NTHREADS;
    unsigned char* base = p.ws + WS_S5C;
    for (int idx = gt; idx < 2 * 64 * 64; idx += ntot) {
        const int dg = idx >> 6, s = idx & 63;
        const float are = IN(p, 15)[idx], aim = IN(p, 16)[idx], dt = expf(IN(p, 17)[dg]);
        for (int e = 0; e < 9; ++e) ((f32x2*)(base + C_APOW))[(dg * 9 + e) * 64 + s] = cexp_(are * dt * (float)e, aim * dt * (float)e);
        ((f32x2*)(base + C_A128))[idx] = cexp_(are * dt * 128.f, aim * dt * 128.f);
        const f32x2 ab = cexp_(are * dt, aim * dt); const f32x2 num = {ab.x - 1.f, ab.y}; const float den = are * are + aim * aim;
        ((f32x2*)(base + C_COEF))[idx] = (f32x2){(num.x * are + num.y * aim) / den, (num.y * are - num.x * aim) / den};
    }
}
template <int CTRL> DI float dppf(float v) { return __int_as_float(__builtin_amdgcn_update_dpp(0, __float_as_int(v), CTRL, 0xf, 0xf, false)); }
template <int DIR, int D> DI void scan_step(f32x4 (&e)[8], const char* lds, int q) {
    constexpr int CTRL = (DIR == 0 ? 0x110 : 0x100) + D;
    const f32x4* mk = (const f32x4*)(lds + L_PW) + (DIR * 16 + D) * 32;
#pragma unroll
    for (int blk = 0; blk < 8; ++blk) {
        const f32x4 m = mk[4 * blk + q];
        f32x4 sh; sh[0] = dppf<CTRL>(e[blk][0]); sh[1] = dppf<CTRL>(e[blk][1]); sh[2] = dppf<CTRL>(e[blk][2]); sh[3] = dppf<CTRL>(e[blk][3]);
        e[blk][0] += m[0] * sh[0] - m[1] * sh[1]; e[blk][1] += m[0] * sh[1] + m[1] * sh[0];
        e[blk][2] += m[2] * sh[2] - m[3] * sh[3]; e[blk][3] += m[2] * sh[3] + m[3] * sh[2];
    }
}
template <int DIR> DI void tile_stage1(const Params& p, int wgi, int g, int J, const bf16x8 (&uf)[4], char* lds, int lane) {
    const int n = lane & 15, q = lane >> 4;
    f32x4 e[8];
#pragma unroll
    for (int blk = 0; blk < 8; ++blk) { const float z = ZF(); e[blk] = (f32x4){z, z, z, z}; }
    const bf16_t* WE = (const bf16_t*)(lds + L_WE) + DIR * 128 * RS;
#pragma unroll
    for (int ks = 0; ks < 4; ++ks) {
        bf16x8 af[8];
#pragma unroll
        for (int blk = 0; blk < 8; ++blk) af[blk] = *(const bf16x8*)(WE + (16 * blk + n) * RS + 32 * ks + 8 * q);
        __builtin_amdgcn_sched_barrier(0);
#pragma unroll
        for (int blk = 0; blk < 8; ++blk) e[blk] = __builtin_amdgcn_mfma_f32_16x16x32_bf16(af[blk], uf[ks], e[blk], 0, 0, 0);
        __builtin_amdgcn_sched_barrier(0);
    }
    scan_step<DIR, 1>(e, lds, q); scan_step<DIR, 2>(e, lds, q); scan_step<DIR, 4>(e, lds, q); scan_step<DIR, 8>(e, lds, q);
    if (n == (DIR == 0 ? 15 : 0)) {
        float* te = (float*)(lds + L_TEND) + (DIR * 34 + J) * 128;
#pragma unroll
        for (int blk = 0; blk < 8; ++blk) *(f32x4*)(te + 16 * blk + 4 * q) = e[blk];
    }
    u32x4* xs = (u32x4*)(p.ws + WS_T + T_XS) + ((size_t)((wgi * 2 + DIR) * 34 + J) * 4) * 64 + lane;
    constexpr int C1 = (DIR == 0 ? 0x110 : 0x100) + 1;
#pragma unroll
    for (int ks = 0; ks < 4; ++ks) {
        u32x4 w;
#pragma unroll
        for (int hh = 0; hh < 2; ++hh) { const f32x4 v = e[2 * ks + hh];
            w[2 * hh] = pk2(dppf<C1>(v[0]), dppf<C1>(v[1])); w[2 * hh + 1] = pk2(dppf<C1>(v[2]), dppf<C1>(v[3])); }
        xs[ks * 64] = w;
    }
}
DI void load_u(const bf16_t* h, int row0, int g, int lane, bf16x8 (&uf)[4]) {
    const int n = lane & 15, q = lane >> 4;
#pragma unroll
    for (int ks = 0; ks < 4; ++ks) uf[ks] = *(const bf16x8*)(h + (size_t)(row0 + 8 * n + 2 * ks + (q >> 1)) * DM + 16 * g + 8 * (q & 1));
}
template <int DIR> DI void tile_stage3(const Params& p, int wgi, int J, const bf16x8 (&uf)[4], f32x4 (&Y)[8], char* lds, int lane) {
    const int n = lane & 15, q = lane >> 4;
    const u32x4* xs = (const u32x4*)(p.ws + WS_T + T_XS) + ((size_t)((wgi * 2 + DIR) * 34 + J) * 4) * 64 + lane;
    const f32x4* pw = (const f32x4*)(lds + L_PW) + (DIR * 16 + (DIR == 0 ? n : 15 - n)) * 32;
    const f32x4* cr = (const f32x4*)(lds + L_CARRY) + (DIR * 34 + J) * 32;
    bf16x8 sf[4];
#pragma unroll
    for (int ks = 0; ks < 4; ++ks) {
        const u32x4 xw = xs[ks * 64]; u32x4 w;
#pragma unroll
        for (int hh = 0; hh < 2; ++hh) {
            const int blk = 2 * ks + hh;
            const f32x4 a = pw[4 * blk + q], c = cr[4 * blk + q];
            const float s0 = bflo(xw[2 * hh]) + a[0] * c[0] - a[1] * c[1], s1 = bfhi(xw[2 * hh]) + a[0] * c[1] + a[1] * c[0];
            const float s2 = bflo(xw[2 * hh + 1]) + a[2] * c[2] - a[3] * c[3], s3 = bfhi(xw[2 * hh + 1]) + a[2] * c[3] + a[3] * c[2];
            w[2 * hh] = pk2(s0, s1); w[2 * hh + 1] = pk2(s2, s3);
        }
        sf[ks] = __builtin_bit_cast(bf16x8, w);
    }
    const bf16_t* CA = (const bf16_t*)(lds + L_CA) + DIR * 128 * RS;
    const bf16_t* KP = (const bf16_t*)(lds + L_KP) + DIR * 8 * 512;
#pragma unroll
    for (int t = 0; t < 8; ++t) {
        bf16x8 af[4], kf[4];
#pragma unroll
        for (int ks = 0; ks < 4; ++ks) {
            af[ks] = *(const bf16x8*)(CA + (16 * t + n) * RS + 32 * ks + 8 * q);
            const int idx = DIR == 0 ? t - 2 * ks : 2 * ks + 1 - t;
            if (idx >= 0) kf[ks] = *(const bf16x8*)(KP + idx * 512 + n * 32 + 8 * q);
        }
        __builtin_amdgcn_sched_barrier(0);
#pragma unroll
        for (int ks = 0; ks < 4; ++ks) {
            Y[t] = __builtin_amdgcn_mfma_f32_16x16x32_bf16(af[ks], sf[ks], Y[t], 0, 0, 0);
            const int idx = DIR == 0 ? t - 2 * ks : 2 * ks + 1 - t;
            if (idx >= 0) Y[t] = __builtin_amdgcn_mfma_f32_16x16x32_bf16(kf[ks], uf[ks], Y[t], 0, 0, 0);
        }
        __builtin_amdgcn_sched_barrier(0);
    }
}
DI void phase(const Params& p, int jl, char* lds) {
    const bf16_t* h = hbuf(p); bf16_t* z = (bf16_t*)(p.ws + WS_T + T_Z);
    const unsigned char* cb = p.ws + WS_S5C;
    for (int wg0 = BIDX(); wg0 < NB * 64; wg0 += GDIM()) {
        const int tid = TIDX(), lane = tid & 63, wave = __builtin_amdgcn_readfirstlane(tid >> 6);
        const int wgi = (GDIM() == NB * 64) ? (wg0 & 7) * 32 + (wg0 >> 3) : wg0;
        const int b = wgi >> 6, g = wgi & 63;
        f32x2* Lap = (f32x2*)(lds + L_APOW); f32x2* Lbb = (f32x2*)(lds + L_BBAR); f32x2* Lc = (f32x2*)(lds + L_C);
        for (int rep3 = 0; rep3 < (S5_PROBE == 3 ? S5_REPS : 1); ++rep3) {
        for (int idx = tid; idx < 2 * 9 * 64; idx += NTHREADS) { const int dir = idx / 576, r = idx - dir * 576; Lap[idx] = ((const f32x2*)(cb + C_APOW))[(dir * 64 + g) * 576 + r]; }
        for (int idx = tid; idx < 2 * 1024; idx += NTHREADS) {
            const int dir = idx >> 10, r = idx & 1023;
            const size_t gi = (size_t)(dir * 64 + g) * 1024 + r;
            Lbb[idx] = cmul(((const f32x2*)(cb + C_COEF))[(dir * 64 + g) * 64 + (r >> 4)], (f32x2){IN(p, 18)[gi], IN(p, 19)[gi]});
            Lc[idx] = (f32x2){IN(p, 20)[gi], IN(p, 21)[gi]};
        }
        __syncthreads();
        for (int idx = tid; idx < 2 * 128 * 64; idx += NTHREADS) {
            const int dir = idx >> 13, kp = (idx >> 6) & 127, c2 = (idx & 63) * 2, pp = kp >> 1, part = kp & 1, t = c2 >> 4, i = c2 & 15;
            const f32x2 ap = Lap[(dir * 9 + (dir == 0 ? 7 - t : t)) * 64 + pp];
            const f32x2 b0 = cmul(ap, Lbb[(dir * 64 + pp) * 16 + i]), b1 = cmul(ap, Lbb[(dir * 64 + pp) * 16 + i + 1]);
            *(unsigned*)((bf16_t*)(lds + L_WE) + (dir * 128 + kp) * RS + c2) = part == 0 ? pk2(b0.x, b1.x) : pk2(b0.y, b1.y);
        }
        {
            const int dir = tid >> 8, ip = (tid >> 4) & 15, i = tid & 15;
            float acc[8];
#pragma unroll
            for (int t = 0; t < 8; ++t) acc[t] = 0.f;
#pragma unroll 4
            for (int pp = 0; pp < 64; ++pp) {
                const f32x2 a1 = Lap[(dir * 9 + 1) * 64 + pp];
                f32x2 w = cmul(Lc[(dir * 16 + ip) * 64 + pp], Lbb[(dir * 64 + pp) * 16 + i]);
#pragma unroll
                for (int t = 0; t < 8; ++t) { acc[t] += w.x; w = cmul(w, a1); }
            }
            bf16_t* KP = (bf16_t*)(lds + L_KP) + dir * 8 * 512;
#pragma unroll
            for (int t = 0; t < 8; ++t) {
                const bf16_t v = (bf16_t)f2bf(acc[t]);
                if (dir == 0) { KP[t * 512 + ip * 32 + i] = v; if (t < 7) KP[(t + 1) * 512 + ip * 32 + 16 + i] = v; }
                else { KP[t * 512 + ip * 32 + 16 + i] = v; if (t < 7) KP[(t + 1) * 512 + ip * 32 + i] = v; }
            }
            if (dir == 0) KP[0 * 512 + ip * 32 + 16 + i] = 0; else KP[0 * 512 + ip * 32 + i] = 0;
            if (tid < 128) {
                const int d2 = tid >> 6, s = tid & 63; const f32x2 a8 = Lap[(d2 * 9 + 8) * 64 + s];
                f32x2 w = {1.f, 0.f}; f32x2* pwt = (f32x2*)(lds + L_PW) + d2 * 16 * 64 + s;
#pragma unroll 1
                for (int nn = 0; nn < 16; ++nn) { pwt[nn * 64] = w; w = cmul(w, a8); }
            }
        }
        __syncthreads();
        }
        for (int rep = 0; rep < (S5_PROBE == 1 ? S5_REPS : 1); ++rep)
        for (int J = wave; J < 34; J += NWAVES) {
            const int ln = TIDX() & 63;
            bf16x8 uf[4]; load_u(h, b * RPB + 128 * J, g, ln, uf);
            tile_stage1<0>(p, wgi, g, J, uf, lds, ln);
            __builtin_amdgcn_sched_barrier(0);
            tile_stage1<1>(p, wgi, g, J, uf, lds, ln);
            __builtin_amdgcn_sched_barrier(0);
        }
        __syncthreads();
        if (wave < 2) {
            const int dir = wave;
            const f32x2 a128 = ((const f32x2*)(cb + C_A128))[(dir * 64 + g) * 64 + lane];
            f32x2* cr = (f32x2*)(lds + L_CARRY) + dir * 34 * 64 + lane;
            float zz = ZF(); f32x2 c = {zz, zz};
#pragma unroll 1
            for (int k = 0; k < 34; ++k) { const int J = dir == 0 ? k : (k < 2 ? 1 - k : 35 - k); const f32x2 e = cr[J * 64]; cr[J * 64] = c; c = cmul(a128, c); c.x += e.x; c.y += e.y; }
        } else {
            for (int idx = tid - 128; idx < 2 * 128 * 64; idx += NTHREADS - 128) {
                const int dir = idx >> 13, r = (idx >> 6) & 127, kpos = (idx & 63) * 2, t = r >> 4, ip = r & 15;
                const int ks = kpos >> 5, q = (kpos >> 3) & 3, jj = kpos & 7, kk = 32 * ks + 16 * (jj >> 2) + 4 * q + (jj & 3), pp = kk >> 1;
                const f32x2 cc = cmul(Lc[(dir * 16 + ip) * 64 + pp], Lap[(dir * 9 + (dir == 0 ? t + 1 : 8 - t)) * 64 + pp]);
                *(unsigned*)((bf16_t*)(lds + L_CA) + (dir * 128 + r) * RS + kpos) = pk2(cc.x, -cc.y);
            }
        }
        __syncthreads();
        const float* dd = IN(p, 22) + jl * 1024;
        for (int rep = 0; rep < (S5_PROBE == 2 ? S5_REPS : 1); ++rep)
        for (int J = wave; J < 34; J += NWAVES) {
            const int lane = TIDX() & 63;
            const int row0 = b * RPB + 128 * J;
            bf16x8 uf[4]; load_u(h, row0, g, lane, uf);
            f32x4 Y[8];
#pragma unroll
            for (int t = 0; t < 8; ++t) { const float zf = ZF(); Y[t] = (f32x4){zf, zf, zf, zf}; }
            tile_stage3<0>(p, wgi, J, uf, Y, lds, lane);
            __builtin_amdgcn_sched_barrier(0);
            tile_stage3<1>(p, wgi, J, uf, Y, lds, lane);
            __builtin_amdgcn_sched_barrier(0);
            const int n = lane & 15, q = lane >> 4; const f32x4 dv = *(const f32x4*)(dd + 16 * g + 4 * q);
#pragma unroll
            for (int t = 0; t < 8; ++t) {
                const size_t off = (size_t)(row0 + 8 * n + t) * DM + 16 * g + 4 * q;
                const u32x2 hw = *(const u32x2*)(h + off);
                const float y0 = bflo(hw[0]) * dv[0] + Y[t][0], y1 = bfhi(hw[0]) * dv[1] + Y[t][1], y2 = bflo(hw[1]) * dv[2] + Y[t][2], y3 = bfhi(hw[1]) * dv[3] + Y[t][3];
                u32x2 w = {pk2(gelu_tanh(y0), gelu_tanh(y1)), pk2(gelu_tanh(y2), gelu_tanh(y3))};
                *(u32x2*)(z + off) = w;
            }
        }
        __syncthreads();
    }
}
}

DI void lru_conv(const Params& p, int j) {
    const int lane = TIDX() & 63, gw = BIDX() * NWAVES + (TIDX() >> 6), nw = GDIM() * NWAVES;
    const bf16_t* xp = (const bf16_t*)(p.ws + WS_T + T_XPRE); bf16_t* xr = (bf16_t*)(p.ws + WS_T + T_XR);
    const float* cw = IN(p, 25) + j * 4 * LRUW; const float* cb = IN(p, 26) + j * LRUW;
    for (int row = gw; row < MROWS; row += nw) {
        const int b = row / RPB, rb = row - b * RPB; const bool isctx = rb < CTXL;
        const int t = isctx ? rb : rb - CTXL, L = isctx ? CTXL : SEQ;
        for (int cc = lane * 4; cc < LRUW; cc += 256) {
            f32x4 acc = *(const f32x4*)(cb + cc);
#pragma unroll
            for (int k = 0; k < 4; ++k) { const int tt = t + k - 1; if (tt < 0 || tt >= L) continue;
                const u32x2 w = *(const u32x2*)(xp + (size_t)(row + k - 1) * LRUW + cc); const f32x4 wk = *(const f32x4*)(cw + k * LRUW + cc);
                acc[0] += wk[0] * bflo(w[0]); acc[1] += wk[1] * bfhi(w[0]); acc[2] += wk[2] * bflo(w[1]); acc[3] += wk[3] * bfhi(w[1]); }
            u32x2 o = {pk2(acc[0], acc[1]), pk2(acc[2], acc[3])};
            *(u32x2*)(xr + (size_t)row * LRUW + cc) = o;
        }
    }
}
constexpr int LR_CH = 64, LR_NCH = RPB / LR_CH;
DI int lr_chain_chunk(int dir, int k) { return dir == 0 ? k : (k < 4 ? 3 - k : 71 - k); }
DI int lr_chain_pos(int dir, int c) { return dir == 0 ? c : (c < 4 ? 3 - c : 71 - c); }
DI void lru_pass1(const Params& p) {
    const int gt = BIDX() * NTHREADS + TIDX(), ntot = GDIM() * NTHREADS;
    float* P = (float*)(p.ws + WS_T + T_LP); float* E = (float*)(p.ws + WS_T + T_LE);
    for (int it = gt; it < NB * 2 * LR_NCH * 160; it += ntot) {
        const int c8 = it % 160, r1 = it / 160, c = r1 % LR_NCH, r2 = r1 / LR_NCH, dir = r2 & 1, b = r2 >> 1;
        const bf16_t* la = (const bf16_t*)(p.ws + WS_T + T_LA + dir * LRU_DIRSTRIDE) + (size_t)(b * RPB + c * LR_CH) * LRUW + c8 * 8;
        const bf16_t* bb = (const bf16_t*)(p.ws + WS_T + T_BB + dir * LRU_DIRSTRIDE) + (size_t)(b * RPB + c * LR_CH) * LRUW + c8 * 8;
        float s[8], ps[8];
#pragma unroll
        for (int e = 0; e < 8; ++e) { s[e] = 0.f; ps[e] = 0.f; }
        for (int k0 = 0; k0 < LR_CH; k0 += 8) {
            u32x4 lw[8], bw[8];
#pragma unroll
            for (int u = 0; u < 8; ++u) { const int t = dir ? LR_CH - 1 - (k0 + u) : k0 + u; lw[u] = *(const u32x4*)(la + (size_t)t * LRUW); bw[u] = *(const u32x4*)(bb + (size_t)t * LRUW); }
#pragma unroll
            for (int u = 0; u < 8; ++u)
#pragma unroll
                for (int e = 0; e < 4; ++e) {
                    const float l0 = bflo(lw[u][e]), l1 = bfhi(lw[u][e]);
                    ps[2 * e] += l0; ps[2 * e + 1] += l1;
                    s[2 * e] = __expf(l0) * s[2 * e] + bflo(bw[u][e]); s[2 * e + 1] = __expf(l1) * s[2 * e + 1] + bfhi(bw[u][e]);
                }
        }
        const size_t o = ((size_t)((b * 2 + dir) * LR_NCH + c)) * LRUW + c8 * 8;
        *(f32x4*)(P + o) = (f32x4){ps[0], ps[1], ps[2], ps[3]}; *(f32x4*)(P + o + 4) = (f32x4){ps[4], ps[5], ps[6], ps[7]};
        *(f32x4*)(E + o) = (f32x4){s[0], s[1], s[2], s[3]}; *(f32x4*)(E + o + 4) = (f32x4){s[4], s[5], s[6], s[7]};
    }
}
DI void lru_carry(const Params& p) {
    const int gt = BIDX() * NTHREADS + TIDX(), ntot = GDIM() * NTHREADS;
    const float* P = (const float*)(p.ws + WS_T + T_LP); const float* E = (const float*)(p.ws + WS_T + T_LE); float* S = (float*)(p.ws + WS_T + T_LS);
    for (int it = gt; it < NB * 2 * LRUW; it += ntot) {
        const int ch = it % LRUW, bd = it / LRUW, dir = bd & 1;
        const size_t base = (size_t)bd * LR_NCH * LRUW + ch;
        float s = 0.f;
        for (int k0 = 0; k0 < LR_NCH; k0 += 17) {
            float pv[17], ev[17];
#pragma unroll
            for (int u = 0; u < 17; ++u) { const size_t o = base + (size_t)lr_chain_chunk(dir, k0 + u) * LRUW; pv[u] = P[o]; ev[u] = E[o]; }
#pragma unroll
            for (int u = 0; u < 17; ++u) { S[base + (size_t)lr_chain_chunk(dir, k0 + u) * LRUW] = s; s = __expf(pv[u]) * s + ev[u]; }
        }
    }
}
DI void lru_pass3(const Params& p, bool latonly) {
    const int gt = BIDX() * NTHREADS + TIDX(), ntot = GDIM() * NTHREADS;
    const float* S = (const float*)(p.ws + WS_T + T_LS);
    const bf16_t* gx = (const bf16_t*)(p.ws + WS_T + T_GX); bf16_t* gh = (bf16_t*)(p.ws + WS_T + T_GH);
    for (int it = gt; it < NB * LR_NCH * 640; it += ntot) {
        const int c2 = it % 640, r1 = it / 640, c = r1 % LR_NCH, b = r1 / LR_NCH;
        if (latonly && c < 4) continue;
        const size_t rowoff = (size_t)(b * RPB + c * LR_CH) * LRUW + c2 * 2;
        f32x2 fw[LR_CH];
        {
            const size_t o = ((size_t)((b * 2 + 0) * LR_NCH + c)) * LRUW + c2 * 2;
            f32x2 s = *(const f32x2*)(S + o);
            const bf16_t* la = (const bf16_t*)(p.ws + WS_T + T_LA) + rowoff; const bf16_t* bb = (const bf16_t*)(p.ws + WS_T + T_BB) + rowoff;
#pragma unroll
            for (int k0 = 0; k0 < LR_CH; k0 += 16) {
                unsigned lw[16], bw[16];
#pragma unroll
                for (int u = 0; u < 16; ++u) { lw[u] = *(const unsigned*)(la + (size_t)(k0 + u) * LRUW); bw[u] = *(const unsigned*)(bb + (size_t)(k0 + u) * LRUW); }
#pragma unroll
                for (int u = 0; u < 16; ++u) { s.x = __expf(bflo(lw[u])) * s.x + bflo(bw[u]); s.y = __expf(bfhi(lw[u])) * s.y + bfhi(bw[u]); fw[k0 + u] = s; }
            }
        }
        {
            const size_t o = ((size_t)((b * 2 + 1) * LR_NCH + c)) * LRUW + c2 * 2;
            f32x2 s = *(const f32x2*)(S + o);
            const bf16_t* la = (const bf16_t*)(p.ws + WS_T + T_LA + LRU_DIRSTRIDE) + rowoff; const bf16_t* bb = (const bf16_t*)(p.ws + WS_T + T_BB + LRU_DIRSTRIDE) + rowoff;
#pragma unroll
            for (int k0 = 0; k0 < LR_CH; k0 += 16) {
                unsigned lw[16], bw[16], gw_[16];
#pragma unroll
                for (int u = 0; u < 16; ++u) { const int t = LR_CH - 1 - (k0 + u); lw[u] = *(const unsigned*)(la + (size_t)t * LRUW); bw[u] = *(const unsigned*)(bb + (size_t)t * LRUW); gw_[u] = *(const unsigned*)(gx + rowoff + (size_t)t * LRUW); }
#pragma unroll
                for (int u = 0; u < 16; ++u) { const int t = LR_CH - 1 - (k0 + u);
                    s.x = __expf(bflo(lw[u])) * s.x + bflo(bw[u]); s.y = __expf(bfhi(lw[u])) * s.y + bfhi(bw[u]);
                    *(unsigned*)(gh + rowoff + (size_t)t * LRUW) = pk2(bflo(gw_[u]) * (fw[t].x + s.x), bfhi(gw_[u]) * (fw[t].y + s.y)); }
            }
        }
    }
}

#define XB_TMO      128
#define XB_XCNT(j)  (256  + 64 * (j))
#define XB_XSUB(j)  (1280 + 64 * (j))
#define XB_XGEN(j)  (2304 + 64 * (j))
#define XB_TOP      3328
#define XB_TOPGEN   3392
#define XCD_BAR_WORDS 3456
#define XB_SPIN_CAP (1u << 24)
DI unsigned xb_ld(unsigned* p)              { return __hip_atomic_load(p, __ATOMIC_RELAXED, __HIP_MEMORY_SCOPE_AGENT); }
DI unsigned xb_add(unsigned* p, unsigned v) { return __hip_atomic_fetch_add(p, v, __ATOMIC_RELAXED, __HIP_MEMORY_SCOPE_AGENT); }
DI unsigned xb_xcc_id() { return (unsigned)__builtin_amdgcn_s_getreg((3 << 11) | 20) & 0xFu; }
#define XB_SPIN(cond, bar) do { unsigned _sp = 0; while (cond) { __builtin_amdgcn_s_sleep(1); \
    if ((++_sp & 255u) == 0u) { if (xb_ld(&(bar)[XB_TMO])) break; if (_sp > XB_SPIN_CAP) { atomicAdd(&(bar)[XB_TMO], 1u); break; } } } } while (0)
struct XcdBarrier { unsigned* bar; unsigned x; volatile LAS unsigned* st; };
DI XcdBarrier xcd_barrier_post(unsigned* bar, volatile LAS unsigned* st) {
    XcdBarrier b; b.bar = bar; b.x = xb_xcc_id(); b.st = st;
    if (threadIdx.x == 0) (void)xb_add(&bar[XB_XCNT(b.x)], 1u);
    return b;
}
DI void xcd_barrier_complete(unsigned* bar, unsigned x, unsigned& nloc, unsigned& nx) {
    const unsigned G = gridDim.x * gridDim.y * gridDim.z;
    unsigned sum, cnt, mine, sp = 0u;
    for (;;) {
        sum = 0u; cnt = 0u; mine = 0u;
#pragma unroll
        for (unsigned j = 0; j < 16; ++j) { const unsigned c = xb_ld(&bar[XB_XCNT(j)]); sum += c; cnt += (c > 0u) ? 1u : 0u; mine = (j == x) ? c : mine; }
        if (sum == G) break;
        __builtin_amdgcn_s_sleep(1);
        if ((++sp & 255u) == 0u) { if (xb_ld(&bar[XB_TMO])) break; if (sp > XB_SPIN_CAP) { atomicAdd(&bar[XB_TMO], 1u); break; } }
    }
    nloc = mine > 0u ? mine : 1u; nx = cnt > 0u ? cnt : 1u;
}
DI void xcd_barrier(const XcdBarrier& b) {
    asm volatile("s_waitcnt vmcnt(0)" ::: "memory");
    __syncthreads();
    if (threadIdx.x == 0) {
        unsigned* bar = b.bar;
        __builtin_amdgcn_s_waitcnt(0);
        unsigned nloc = b.st[0], nx = b.st[1];
        if (nloc == 0u) { xcd_barrier_complete(bar, b.x, nloc, nx); b.st[0] = nloc; b.st[1] = nx; }
        const unsigned old = xb_add(&bar[XB_XSUB(b.x)], 1u);
        const unsigned gen = old / nloc;
        if (old + 1u == (gen + 1u) * nloc) {
            __builtin_amdgcn_fence(__ATOMIC_RELEASE, "agent");
            asm volatile("s_waitcnt vmcnt(0)" ::: "memory");
            const unsigned og = xb_add(&bar[XB_TOP], 1u);
            const unsigned tg = og / nx;
            if (og + 1u == (tg + 1u) * nx) xb_add(&bar[XB_TOPGEN], 1u);
            else XB_SPIN(xb_ld(&bar[XB_TOPGEN]) == tg, bar);
            __builtin_amdgcn_fence(__ATOMIC_ACQUIRE, "agent");
            xb_add(&bar[XB_XGEN(b.x)], 1u);
            asm volatile("s_waitcnt vmcnt(0)" ::: "memory");
        } else {
            XB_SPIN(xb_ld(&bar[XB_XGEN(b.x)]) == gen, bar);
            __builtin_amdgcn_fence(__ATOMIC_ACQUIRE, "agent");
            asm volatile("s_waitcnt vmcnt(0)" ::: "memory");
        }
    }
    __syncthreads();
}

enum { ST_INIT = 0, ST_NORM0, ST_NORM1, ST_GEMM, ST_A3, ST_A5, ST_ATTN, ST_S5P1, ST_S5P3, ST_CONV, ST_LRU1, ST_LRU3, ST_S5C, ST_LRUC, ST_S5 };
enum { G_DQKV = 0, G_UQ, G_UKV, G_WO, G_GLU, G_WX, G_WG, G_GATES, G_WOUT, G_W1, G_W2 };
struct Step { unsigned char type, layer, gid, ng; };
#define MLA_STEPS(L) {ST_NORM0, L, 0, 0}, {ST_GEMM, L, G_DQKV, 1}, {ST_GEMM, L, G_UQ, 2}, {ST_ATTN, L, 0, 0}, {ST_GEMM, L, G_WO, 1}, \
                     {ST_NORM1, L, 0, 0}, {ST_GEMM, L, G_W1, 1}, {ST_GEMM, L, G_W2, 1}
#define S5_STEPS(L)  {ST_NORM0, L, 0, 0}, {ST_S5, L, 0, 0}, {ST_GEMM, L, G_GLU, 1}, {ST_NORM1, L, 0, 0}, {ST_GEMM, L, G_W1, 1}, {ST_GEMM, L, G_W2, 1}
#define LRU_STEPS(L) {ST_NORM0, L, 0, 0}, {ST_GEMM, L, G_WX, 2}, {ST_CONV, L, 0, 0}, {ST_GEMM, L, G_GATES, 1}, {ST_LRU1, L, 0, 0}, {ST_LRUC, L, 0, 0}, {ST_LRU3, L, 0, 0}, {ST_GEMM, L, G_WOUT, 1}, \
                     {ST_NORM1, L, 0, 0}, {ST_GEMM, L, G_W1, 1}, {ST_GEMM, L, G_W2, 1}
__constant__ Step PROGRAM[] = { {ST_INIT, 0, 0, 0}, MLA_STEPS(0), S5_STEPS(1), LRU_STEPS(2), MLA_STEPS(3) };
constexpr int NSTEPS = 1 + 8 + 6 + 11 + 8;

#ifndef PROBE_MASK
#define PROBE_MASK 0
#endif
#ifndef PROBE_GMASK
#define PROBE_GMASK 0
#endif
#ifndef PROBE_REPS
#define PROBE_REPS 2
#endif
DI GemmD make_gemm(const Params& p, int gid, int layer, bool dry) {
    unsigned char* ws = p.ws; unsigned char* T = ws + WS_T; unsigned char* wm = ws + WS_WMIX;
    const bf16_t* H = hbuf(p); const float* modv = (const float*)(ws + WS_MOD);
    const int lo = layer < 3 ? 0 : 1, j = layer / 3;
    GemmD g; g.koff_shift = 30; g.koff_mul = 0; g.out = nullptr; g.ldc = 0; g.gate = modv; g.gate_off = 2 * 1024; g.layer = layer; g.aux0 = nullptr; g.aux1 = nullptr; g.aux2 = nullptr; g.out2 = nullptr; g.latonly = lo; g.rev = 0; g.splitk = 0; g.slab = nullptr; g.res_x = nullptr; g.final = 0;
    switch (gid) {
        case G_DQKV: g.A = H; g.lda = 1024; g.Bt = (const bf16_t*)(wm + WM_D); g.ldb = 1024; g.K = 1024; g.nN = 3; g.latonly = 0; g.kind = EPI_DQKV; g.aux0 = IN(p, 11) + j * 256; g.aux1 = IN(p, 13) + j * 384 + 192 + 128; break;
        case G_UQ: g.A = (const bf16_t*)(T + T_CQ); g.lda = 384; g.Bt = (const bf16_t*)(wm + WM_UQ); g.ldb = 384; g.K = 384; g.nN = 6; g.kind = EPI_QN; g.out = T + T_QPRE; g.ldc = 1536; g.aux0 = IN(p, 13) + j * 384; break;
        case G_UKV: g.A = (const bf16_t*)(T + T_CKV); g.lda = 256; g.Bt = (const bf16_t*)(wm + WM_UKV); g.ldb = 256; g.K = 256; g.nN = 8; g.latonly = 0; g.rev = 1; g.kind = EPI_KVN; g.out = T + T_KVPRE; g.ldc = 2048; g.aux0 = IN(p, 13) + j * 384 + 192; break;
        case G_WO: if (layer == 0) g.res_x = IN(p, 0); g.A = H; g.lda = 1024; g.Bt = (const bf16_t*)(wm + WM_O); g.ldb = 1024; g.K = 1024; g.nN = 4; g.kind = EPI_RES; g.splitk = 4; g.slab = (float*)(T + T_SLAB_A); break;
        case G_GLU: g.A = (const bf16_t*)(T + T_Z); g.lda = 1024; g.Bt = (const bf16_t*)(wm + WM_GLU); g.ldb = 1024; g.K = 1024; g.nN = 8; g.kind = EPI_GLU; g.splitk = 4; g.slab = (float*)(T + T_SLAB_A); break;
        case G_WX: g.A = H; g.lda = 1024; g.Bt = (const bf16_t*)(wm + WM_X); g.ldb = 1024; g.K = 1024; g.nN = 5; g.latonly = 0; g.kind = EPI_BF16; g.out = T + T_XPRE; g.ldc = LRUW; break;
        case G_GATES: g.A = (const bf16_t*)(T + T_XR); g.lda = LRUW; g.Bt = (const bf16_t*)(wm + WM_GATE); g.ldb = 256; g.K = 256; g.nN = 20; g.latonly = 0; g.kind = EPI_GATES; g.koff_shift = 2; g.koff_mul = 256;
            g.out = T + T_LA; g.out2 = T + T_BB; g.aux0 = IN(p, 28) + j * 4 * LRUW; g.aux1 = IN(p, 29) + j * 2 * LRUW; g.aux2 = T + T_XR; break;
        case G_WG: g.A = H; g.lda = 1024; g.Bt = (const bf16_t*)(wm + WM_G); g.ldb = 1024; g.K = 1024; g.nN = 5; g.latonly = 0; g.rev = 1; g.kind = EPI_GELUMUL; g.out = T + T_GX; g.ldc = LRUW; break;
        case G_WOUT: g.A = (const bf16_t*)(T + T_GH); g.lda = LRUW; g.Bt = (const bf16_t*)(wm + WM_OUT); g.ldb = LRUW; g.K = LRUW; g.nN = 4; g.kind = EPI_RES; g.splitk = 5; g.slab = (float*)(T + T_SLAB_A_LRU); break;
        case G_W1: g.A = H; g.lda = 1024; g.Bt = mlp_wbuf(p, layer); g.ldb = 1024; g.K = 1024; g.nN = 16; g.kind = EPI_RELU2; g.out = T + T_HID; g.ldc = 4096; break;
        default: g.A = (const bf16_t*)(T + T_HID); g.lda = 4096; g.Bt = mlp_wbuf(p, layer) + (size_t)4096 * 1024; g.ldb = 4096; g.K = 4096; g.nN = 4; g.kind = EPI_RES; g.gate_off = 5 * 1024; g.splitk = 16; g.slab = (float*)(T + T_SLAB_M); g.final = layer == 3; break;
    }
    if (dry && (g.kind == EPI_RES || g.kind == EPI_GLU)) { g.kind = EPI_RELU2; g.out = T + 204 * MiB; g.ldc = 1024; }
    return g;
}
constexpr int LDS_BYTES = 163840;

__global__ void __launch_bounds__(NTHREADS, 2) hybrid_fwd(KArgs ka) {
    extern __shared__ __attribute__((aligned(16))) unsigned char lds_raw[];
    char* lds = (char*)lds_raw;
    LAS unsigned char* ldsl = (LAS unsigned char*)lds_raw;
    if (threadIdx.x < 33) ((LAS unsigned long long*)(ldsl + PTAB_OFF))[threadIdx.x] = (unsigned long long)ka.in[threadIdx.x];
    if (threadIdx.x < 4) ((LAS unsigned*)(ldsl + PTAB_OFF + 512))[threadIdx.x] = 0u;
    __syncthreads();
    const XcdBarrier xbar = xcd_barrier_post((unsigned*)ka.ws, (volatile LAS unsigned*)(ldsl + PTAB_OFF + 512));
    for (int step = 0; step < NSTEPS; ++step) {
        Params p; p.tab = (const LAS unsigned long long*)(ldsl + PTAB_OFF);
        { unsigned long long oi = (unsigned long long)ka.out, wi = (unsigned long long)ka.ws;
          asm volatile("" : "+s"(oi), "+s"(wi));
          p.out = (float*)(__attribute__((address_space(1))) float*)oi; p.ws = (unsigned char*)(__attribute__((address_space(1))) unsigned char*)wi; }
        const Step st = PROGRAM[step];
        const int layer = st.layer, j = layer / 3; const bool need_ctx = layer < 3;
        const int nrep = (PROBE_MASK != 0 && ((PROBE_MASK >> st.type) & 1) && (st.type != ST_GEMM || ((PROBE_GMASK >> st.gid) & 1))) ? PROBE_REPS : 1;
        for (int rr = 0; rr < nrep; ++rr) {
        switch (st.type) {
#ifndef NO_INIT
            case ST_INIT: mod_phase(p, lds); rope_table(p); s5v2::prep(p); prep_mixer(p, 0, lds); prep_mlp(p, 0, lds); break;
#endif
#ifndef NO_NORM
            case ST_NORM0: norm_phase(p, layer, 0, layer == 0, false, (layer > 0 && rr == 0) ? 16 : 0, (const float*)(p.ws + WS_T + T_SLAB_M), (const float*)(p.ws + WS_MOD) + (size_t)(4 * 4 + layer - 1) * 6144 + 5 * 1024, false); break;
            case ST_NORM1: norm_phase(p, layer, 1, false, !need_ctx, (need_ctx && rr == 0) ? (layer % 3 == 2 ? 5 : 4) : 0, (const float*)(p.ws + WS_T + (layer % 3 == 2 ? T_SLAB_A_LRU : T_SLAB_A)), (const float*)(p.ws + WS_MOD) + (size_t)(4 * 4 + layer) * 6144 + 2 * 1024, layer % 3 == 1); break;
#endif
#ifndef NO_GEMM
            case ST_GEMM: for (int gi = 0; gi < st.ng; ++gi) { const GemmD g = make_gemm(p, st.gid + gi, layer, rr != 0); gemm_phase(p, ldsl, g, st.gid + gi, layer, rr != 0); }
                if (st.gid == G_W1 && layer < 3 && rr == 0 && BIDX() >= 64) { prep_mixer(p, layer + 1, lds, 64); prep_mlp(p, layer + 1, lds, 64); }
                break;
#endif
#ifndef NO_ROWOP
            case ST_A3: mla_rowop_a3(p, j); break;
            case ST_A5: mla_rowop_a5(p, j, !need_ctx); break;
#endif
#ifndef NO_ATTN
            case ST_ATTN: attn_phase(p, need_ctx, lds); break;
#endif
#ifndef NO_S5
            case ST_S5: s5v2::phase(p, j, lds); break;
#endif
#ifndef NO_LRU
            case ST_CONV: lru_conv(p, j); break;
            case ST_LRU1: lru_pass1(p); break;
            case ST_LRUC: lru_carry(p); break;
            case ST_LRU3: lru_pass3(p, false); break;
#endif
            default: break;
        }
        if (step + 1 < NSTEPS) xcd_barrier(xbar);
        }
    }
}

extern "C" void kernel_launch(void* const* d_in, const int* in_sizes, int n_in, void* d_out, int out_size, void* d_ws, size_t ws_size, hipStream_t stream) {
    static int grid_blocks = 0;
    if (grid_blocks == 0) {
        if (n_in != 33 || out_size != NB * SEQ * DM || ws_size < WS_END) { fprintf(stderr, "kernel_launch: unexpected shapes n_in %d out %d ws %zu (need %zu)\n", n_in, out_size, ws_size, (size_t)WS_END); grid_blocks = -1; return; }
        int dev = 0, cus = 0, per_cu = 0;
        hipGetDevice(&dev);
        hipDeviceGetAttribute(&cus, hipDeviceAttributeMultiprocessorCount, dev);
        if (hipFuncSetAttribute((const void*)hybrid_fwd, hipFuncAttributeMaxDynamicSharedMemorySize, LDS_BYTES) != hipSuccess) { fprintf(stderr, "kernel_launch: hipFuncSetAttribute failed\n"); grid_blocks = -1; return; }
        if (hipOccupancyMaxActiveBlocksPerMultiprocessor(&per_cu, (const void*)hybrid_fwd, NTHREADS, LDS_BYTES) != hipSuccess || per_cu < 1) { fprintf(stderr, "kernel_launch: occupancy query failed (%d)\n", per_cu); per_cu = 1; (void)hipGetLastError(); }
        if (per_cu > 1) per_cu = 1;
        grid_blocks = cus * per_cu;
    }
    if (grid_blocks < 0) return;
    KArgs p{};
    for (int i = 0; i < 33; ++i) p.in[i] = (const float*)d_in[i];
    p.out = (float*)d_out; p.ws = (unsigned char*)d_ws;
    if (hipMemsetAsync(d_ws, 0, 16384, stream) != hipSuccess) { fprintf(stderr, "kernel_launch: memset of the barrier words failed\n"); return; }
    void* args[] = {&p};
    hipError_t e = hipLaunchCooperativeKernel((const void*)hybrid_fwd, dim3(grid_blocks), dim3(NTHREADS), args, LDS_BYTES, stream);
    if (e != hipSuccess) fprintf(stderr, "cooperative launch failed: %s (grid %d)\n", hipGetErrorString(e), grid_blocks);
}
```

```cpp
#include <hip/hip_runtime.h>
#include <hip/hip_cooperative_groups.h>
#include <cstdio>
#include <cstdint>
namespace cg = cooperative_groups;

#ifndef NAIVE_GEMM
#define NAIVE_GEMM 0
#endif

#define DI __device__ __forceinline__
#define LAS __attribute__((address_space(3)))
typedef unsigned short bf16_t;
typedef short bf16x8 __attribute__((ext_vector_type(8)));
typedef short s16x4 __attribute__((ext_vector_type(4)));
typedef float f32x4 __attribute__((ext_vector_type(4)));
typedef float f32x2 __attribute__((ext_vector_type(2)));
typedef float f32x16 __attribute__((ext_vector_type(16)));
typedef unsigned u32x4 __attribute__((ext_vector_type(4)));
typedef unsigned u32x2 __attribute__((ext_vector_type(2)));

constexpr int DM = 1024, NB = 4, SEQ = 4096, CTXL = 256, RPB = SEQ + CTXL  , MROWS = NB * RPB  ;
constexpr int NTHREADS = 512, NWAVES = 8;
constexpr int LRUW = 1280;
constexpr float EPS = 1e-6f;
constexpr float QSCALE = 0.07216878364870323f * 1.4426950408889634f;

constexpr size_t MiB = 1u << 20;
constexpr size_t WS_MOD = 1 * MiB;
constexpr size_t WS_ROPE = 1 * MiB + 512 * 1024;
constexpr size_t WS_S5C = 2 * MiB;
constexpr size_t WS_CTXLAT = 4 * MiB;
constexpr size_t WS_WMIX = 8 * MiB;
constexpr size_t WS_WMLP = 19 * MiB;
constexpr size_t WS_RL = 35 * MiB;
constexpr size_t WS_T = 69 * MiB;
constexpr size_t WS_END = WS_T + 270 * MiB;
constexpr size_t T_DQKV = 0, T_CQ = 51 * MiB, T_CKV = 64 * MiB, T_KR = 73 * MiB, T_QPRE = 76 * MiB, T_KVPRE = 127 * MiB;
constexpr size_t T_Z = 0, T_S5E = 40 * MiB, T_S5S = 50 * MiB;
constexpr size_t T_GX = 0  , T_LA = 43 * MiB  , T_BB = 129 * MiB, T_XPRE = 43 * MiB  ,
                 T_XR = 215 * MiB, T_GH = 215 * MiB  , T_LP = 258 * MiB, T_LE = 261 * MiB, T_LS = 264 * MiB;
constexpr size_t LRU_DIRSTRIDE = 43 * MiB;
constexpr size_t T_HID = 0;
constexpr size_t T_SLAB_M = 140 * MiB  , T_SLAB_A = 200 * MiB  , T_SLAB_A_LRU = 172 * MiB  ;
constexpr size_t WM_D = 0  , WM_UQ = 1572864  , WM_UKV = WM_UQ + 1179648  , WM_O = WM_UKV + 1048576  ;
constexpr size_t WM_GLU = 0;
constexpr size_t WM_X = 0  , WM_G = 2621440, WM_GATE = 2 * 2621440  , WM_OUT = 3 * 2621440  ;

struct KArgs {
    const float* in[33];
    float* out;
    unsigned char* ws;
};
constexpr int PTAB_OFF = 163072;
struct Params {
    float* out;
    unsigned char* ws;
    const LAS unsigned long long* tab;
};
__device__ __forceinline__ const float* IN(const Params& p, int k) {
    const unsigned long long v = p.tab[k];
    const unsigned lo = __builtin_amdgcn_readfirstlane((unsigned)v), hi = __builtin_amdgcn_readfirstlane((unsigned)(v >> 32));
    return (const float*)(const __attribute__((address_space(1))) float*)(((unsigned long long)hi << 32) | lo);
}

DI float ZF() { float z; asm volatile("v_mov_b32 %0, 0" : "=v"(z)); return z; }
DI int TIDX() { int t = threadIdx.x; asm volatile("" : "+v"(t)); return t; }
DI int BIDX() { int t = blockIdx.x; asm volatile("" : "+s"(t)); return t; }
DI int GDIM() { int t = gridDim.x; asm volatile("" : "+s"(t)); return t; }
typedef __bf16 bf16x2_t __attribute__((ext_vector_type(2)));
DI unsigned pk2(float lo, float hi) { f32x2 v = {lo, hi}; bf16x2_t b = __builtin_convertvector(v, bf16x2_t); return __builtin_bit_cast(unsigned, b); }
DI unsigned f2bf(float f) { return pk2(f, 0.f) & 0xffffu; }
DI float bflo(unsigned w) { return __uint_as_float(w << 16); }
DI float bfhi(unsigned w) { return __uint_as_float(w & 0xffff0000u); }
DI float bf2f(bf16_t h) { return __uint_as_float((unsigned)h << 16); }
DI float wave_sum(float v) {
#pragma unroll
    for (int o = 32; o; o >>= 1) v += __shfl_xor(v, o);
    return v;
}
DI float sigmoidf_(float x) { return __builtin_amdgcn_rcpf(1.f + __builtin_amdgcn_exp2f(-1.4426950408889634f * x)); }
DI float gelu_tanh(float x) {
    const float t = fmaf(x * x, 0.10294324f, 2.3022082f); return x * __builtin_amdgcn_rcpf(1.f + __builtin_amdgcn_exp2f(-x * t));
}
#define LDS_FENCE() asm volatile("s_waitcnt lgkmcnt(0)" ::: "memory")

DI bf16_t* hbuf(const Params& p) { return (bf16_t*)p.out; }

DI void mod_phase(const Params& p, char* lds, int ml, int rank, int nr) {
    float* sv = (float*)lds;
    float* red = (float*)(lds + 20480);
    const int tid = TIDX();
    __syncthreads();
    for (int i = tid; i < 5 * 1024; i += NTHREADS) { const int mi = i >> 10, k = i & 1023; const float x = mi < 4 ? IN(p, 1)[mi * 1024 + k] : IN(p, 3)[k]; sv[i] = x / (1.f + __expf(-x)); }
    __syncthreads();
    float* modv = (float*)(p.ws + WS_MOD);
    for (int grp = ml * 64 + rank; grp < ml * 64 + 64; grp += nr) {
        const int ks = tid / 24, cq = tid % 24;
        const int col = grp * 96 + cq * 4, layer = col / 6144, cc = col % 6144;
        if (ks < 16) {
            const float* w = IN(p, 4) + (size_t)layer * 1024 * 6144 + cc;
            f32x4 a0 = {0, 0, 0, 0}, a1 = a0, a2 = a0, a3 = a0, a4 = a0;
            for (int k0 = ks * 64; k0 < ks * 64 + 64; k0 += 16) {
                f32x4 wv[16];
#pragma unroll
                for (int u = 0; u < 16; ++u) wv[u] = *(const f32x4*)(w + (size_t)(k0 + u) * 6144);
#pragma unroll
                for (int u = 0; u < 16; ++u) { const int k = k0 + u; a0 += sv[k] * wv[u]; a1 += sv[1024 + k] * wv[u]; a2 += sv[2048 + k] * wv[u]; a3 += sv[3072 + k] * wv[u]; a4 += sv[4096 + k] * wv[u]; }
            }
            f32x4* r = (f32x4*)red + (ks * 24 + cq) * 5;
            r[0] = a0; r[1] = a1; r[2] = a2; r[3] = a3; r[4] = a4;
        }
        __syncthreads();
        if (tid < 120) {
            const int q = tid / 5, mi = tid % 5; const int c2 = grp * 96 + q * 4, l2 = c2 / 6144, cc2 = c2 % 6144;
            f32x4 s = *(const f32x4*)(IN(p, 5) + l2 * 6144 + cc2);
            for (int k2 = 0; k2 < 16; ++k2) s += ((const f32x4*)red)[(k2 * 24 + q) * 5 + mi];
            *(f32x4*)(modv + (size_t)(mi * 4 + l2) * 6144 + cc2) = s;
        }
        __syncthreads();
    }
}

struct PrepCtx { char* ldsw; int gw, nw, lane, tcount; };
DI void prep_T(PrepCtx& c, const float* src, int lds_, int K, int N, bf16_t* dst, int ldd, int zero_delta = 0, int hi_stride = 32, const float* kscale = nullptr, bool rp = false) {
    const int ntn = N / 64, nt = (K / 64) * ntn;
    unsigned* T = (unsigned*)c.ldsw;
    const int lane = c.lane, c4 = (lane & 15) * 4, r = lane >> 4, rr = lane >> 3, kc = lane & 7;
    int first = (c.gw - c.tcount) % c.nw; if (first < 0) first += c.nw;
    for (int t = first; t < nt; t += c.nw) {
        const int kt = t / ntn, nn = t - kt * ntn;
        const float* s = src + (size_t)(kt * 64 + 2 * r) * lds_ + nn * 64 + c4;
        f32x4 v0[8], v1[8];
#pragma unroll
        for (int i = 0; i < 8; ++i) { v0[i] = *(const f32x4*)(s + (size_t)(8 * i) * lds_); v1[i] = *(const f32x4*)(s + (size_t)(8 * i + 1) * lds_); }
        if (kscale) {
#pragma unroll
            for (int i = 0; i < 8; ++i) { v0[i] = v0[i] * kscale[kt * 64 + 2 * r + 8 * i]; v1[i] = v1[i] * kscale[kt * 64 + 2 * r + 8 * i + 1]; }
        }
        LDS_FENCE();
#pragma unroll
        for (int i = 0; i < 8; ++i)
#pragma unroll
            for (int e = 0; e < 4; ++e) T[(c4 + e) * 33 + 4 * i + r] = pk2(v0[i][e], v1[i][e]);
        LDS_FENCE();
#pragma unroll
        for (int i = 0; i < 8; ++i) {
            const unsigned* Tr = T + (8 * i + rr) * 33 + 4 * kc;
            const u32x4 w = {Tr[0], Tr[1], Tr[2], Tr[3]};
            const int nrow = 8 * i + rr;
            const int r31 = nrow & 31, rin = rp ? 8 * ((r31 & 15) >> 2) + 4 * (r31 >> 4) + (r31 & 3) : r31;
            bf16_t* d = dst + (size_t)(nn * 64 + (nrow >> 5) * hi_stride + rin) * ldd + kt * 64 + 8 * kc;
            *(u32x4*)d = w;
            if (zero_delta) { const unsigned z = __float_as_uint(ZF()); *(u32x4*)(d + zero_delta) = (u32x4){z, z, z, z}; }
        }
    }
    c.tcount += nt;
}
DI void prep_zero_rows(bf16_t* dst, size_t nelem, int first_block = 0) {
    const size_t n8 = nelem / 8; const unsigned z0 = __float_as_uint(ZF()); const u32x4 z = {z0, z0, z0, z0};
    for (size_t i = (size_t)(BIDX() - first_block) * NTHREADS + TIDX(); i < n8; i += (size_t)(GDIM() - first_block) * NTHREADS) ((u32x4*)dst)[i] = z;
}
DI PrepCtx prep_ctx(char* lds, int first_block = 0) {
    PrepCtx c; const int wave = TIDX() >> 6; c.lane = TIDX() & 63; c.ldsw = lds + wave * 8448; c.gw = (BIDX() - first_block) * NWAVES + wave; c.nw = (GDIM() - first_block) * NWAVES; c.tcount = 0; return c;
}
DI void prep_mixer(const Params& p, int layer, char* lds, int first_block = 0) {
    PrepCtx c = prep_ctx(lds, first_block);
    unsigned char* wm = p.ws + WS_WMIX;
    const int kind = layer % 3, j = layer / 3;
    if (kind == 0) {
        bf16_t* Wd = (bf16_t*)(wm + WM_D);
        prep_T(c, IN(p, 7) + (size_t)j * 1024 * 384, 384, 1024, 384, Wd, 1024);
        prep_T(c, IN(p, 10) + (size_t)j * 1024 * 320, 320, 1024, 256, Wd + (size_t)512 * 1024, 1024);
        prep_T(c, IN(p, 10) + (size_t)j * 1024 * 320 + 256, 320, 1024, 64, Wd + (size_t)384 * 1024, 1024, 0, 32, nullptr, true);
        prep_zero_rows(Wd + (size_t)448 * 1024, 64 * 1024, first_block);
        for (int hh = 0; hh < 8; ++hh) {
            const float* wsrc = IN(p, 9) + (size_t)j * 384 * 1536 + hh * 192;
            prep_T(c, wsrc, 1536, 384, 128, (bf16_t*)(wm + WM_UQ) + (size_t)(256 * (hh >> 1) + 128 * (hh & 1)) * 384, 384, 0, 32, IN(p, 8) + j * 384);
            prep_T(c, wsrc + 128, 1536, 384, 64, (bf16_t*)(wm + WM_UQ) + (size_t)(256 * (4 + (hh >> 2)) + 32 * (hh & 3)) * 384, 384, 0, 128, IN(p, 8) + j * 384, true);
        }
        prep_T(c, IN(p, 12) + (size_t)j * 256 * 2048, 2048, 256, 2048, (bf16_t*)(wm + WM_UKV), 256);
        prep_T(c, IN(p, 14) + (size_t)j * 1024 * 1024, 1024, 1024, 1024, (bf16_t*)(wm + WM_O), 1024);
    } else if (kind == 1) {
        bf16_t* Wg = (bf16_t*)(wm + WM_GLU);
        for (int pn = 0; pn < 8; ++pn)
            for (int bj = 0; bj < 2; ++bj)
                prep_T(c, IN(p, 23) + (size_t)j * 1024 * 2048 + bj * 1024 + 128 * pn, 2048, 1024, 128, Wg + (size_t)(256 * pn + 128 * bj) * 1024, 1024);
    } else {
        const float* win = IN(p, 24) + (size_t)j * 1024 * 2560;
        prep_T(c, win + 1280, 2560, 1024, 1280, (bf16_t*)(wm + WM_X), 1024);
        prep_T(c, win, 2560, 1024, 1280, (bf16_t*)(wm + WM_G), 1024);
        bf16_t* Wt = (bf16_t*)(wm + WM_GATE);
        const float* wg = IN(p, 27) + (size_t)j * 2 * 2 * 10 * 128 * 128;
        for (int pr = 0; pr < 5; ++pr)
            for (int bip = 0; bip < 2; ++bip)
                for (int dir = 0; dir < 2; ++dir)
                    for (int gate = 0; gate < 2; ++gate)
                        prep_T(c, wg + (size_t)(((dir * 2 + gate) * 10) + 2 * pr + bip) * 128 * 128, 128, 128, 128,
                               Wt + (size_t)(1024 * pr + ((bip * 2 + dir) * 2 + gate) * 128) * 256 + 128 * bip, 256, bip ? -128 : 128);
        prep_T(c, IN(p, 30) + (size_t)j * 1280 * 1024, 1024, 1280, 1024, (bf16_t*)(wm + WM_OUT), 1280);
    }
}
constexpr size_t T_WMLP1 = 250 * MiB;
DI bf16_t* mlp_wbuf(const Params& p, int layer) { return (bf16_t*)((layer & 1) ? p.ws + WS_T + T_WMLP1 : p.ws + WS_WMLP); }
DI void prep_mlp(const Params& p, int layer, char* lds, int first_block = 0) {
    PrepCtx c = prep_ctx(lds, first_block);
    bf16_t* W1 = mlp_wbuf(p, layer); bf16_t* W2 = W1 + (size_t)4096 * 1024;
    prep_T(c, IN(p, 31) + (size_t)layer * 1024 * 4096, 4096, 1024, 4096, W1, 1024);
    prep_T(c, IN(p, 32) + (size_t)layer * 4096 * 1024, 1024, 4096, 1024, W2, 4096);
}

DI void norm_phase(const Params& p, int layer, int which, bool first, bool latonly, int nslab, const float* slab, const float* sgate, bool glu, char* lds) {
    const int lane = TIDX() & 63, gw = BIDX() * NWAVES + (TIDX() >> 6), nw = GDIM() * NWAVES;
    const float* modv = (const float*)(p.ws + WS_MOD);
    const float* g = IN(p, 6) + (size_t)(layer * 2 + which) * 1024;
    bf16_t* h = hbuf(p);
    if (first) {
        for (int od = gw; od < NB * SEQ / 8; od += nw) {
            const int b = od / (SEQ / 8), t0 = (od - b * (SEQ / 8)) * 8;
            const float* src = IN(p, 0) + (size_t)(b * SEQ + t0) * DM;
            const float* md = modv + (size_t)(b * 4 + layer) * 6144 + which * 3072;
            f32x4 v[8][4]; float ss[8];
#pragma unroll
            for (int r = 0; r < 8; ++r)
#pragma unroll
                for (int j = 0; j < 4; ++j) v[r][j] = *(const f32x4*)(src + (size_t)r * DM + j * 256 + lane * 4);
            f32x4 mul[4], sh[4];
#pragma unroll
            for (int j = 0; j < 4; ++j) { const int col = j * 256 + lane * 4; mul[j] = *(const f32x4*)(g + col) * (1.f + *(const f32x4*)(md + 1024 + col)); sh[j] = *(const f32x4*)(md + col); }
#pragma unroll
            for (int r = 0; r < 8; ++r) { float a = 0.f;
#pragma unroll
                for (int j = 0; j < 4; ++j) a += v[r][j][0] * v[r][j][0] + v[r][j][1] * v[r][j][1] + v[r][j][2] * v[r][j][2] + v[r][j][3] * v[r][j][3];
                ss[r] = a; }
#pragma unroll
            for (int o = 32; o; o >>= 1) {
#pragma unroll
                for (int r = 0; r < 8; ++r) ss[r] += __shfl_xor(ss[r], o);
            }
            const size_t hrow = (size_t)(b * RPB + CTXL + t0);
#pragma unroll
            for (int r = 0; r < 8; ++r) {
                const float inv = rsqrtf(ss[r] * (1.f / 1024.f) + EPS);
#pragma unroll
                for (int j = 0; j < 4; ++j) {
                    const int col = j * 256 + lane * 4;
                    const f32x4 o = v[r][j] * inv * mul[j] + sh[j];
                    u32x2 w = {pk2(o[0], o[1]), pk2(o[2], o[3])};
                    *(u32x2*)(h + (hrow + r) * DM + col) = w;
                }
            }
        }
    } else {
        for (int od = gw; od < NB * SEQ / 8; od += nw) {
            const int b = od / (SEQ / 8), t0 = (od - b * (SEQ / 8)) * 8;
            const bf16_t* rl = (const bf16_t*)(p.ws + WS_RL) + (size_t)(b * SEQ + t0) * DM;
            const float* md = modv + (size_t)(b * 4 + layer) * 6144 + which * 3072;
            u32x2 w[8][4]; float ss[8];
#pragma unroll
            for (int r = 0; r < 8; ++r)
#pragma unroll
                for (int j = 0; j < 4; ++j) w[r][j] = *(const u32x2*)(rl + (size_t)r * DM + j * 256 + lane * 4);
            f32x4 mul[4], sh[4];
#pragma unroll
            for (int j = 0; j < 4; ++j) { const int col = j * 256 + lane * 4; mul[j] = *(const f32x4*)(g + col) * (1.f + *(const f32x4*)(md + 1024 + col)); sh[j] = *(const f32x4*)(md + col); }
#pragma unroll
            for (int r = 0; r < 8; ++r) { float a = 0.f;
#pragma unroll
                for (int j = 0; j < 4; ++j) { const float x0 = bflo(w[r][j][0]), x1 = bfhi(w[r][j][0]), x2 = bflo(w[r][j][1]), x3 = bfhi(w[r][j][1]); a += x0 * x0 + x1 * x1 + x2 * x2 + x3 * x3; }
                ss[r] = a; }
#pragma unroll
            for (int o = 32; o; o >>= 1) {
#pragma unroll
                for (int r = 0; r < 8; ++r) ss[r] += __shfl_xor(ss[r], o);
            }
            const size_t hrow = (size_t)(b * RPB + CTXL + t0);
#pragma unroll
            for (int r = 0; r < 8; ++r) {
                const float inv = rsqrtf(ss[r] * (1.f / 1024.f) + EPS);
#pragma unroll
                for (int j = 0; j < 4; ++j) {
                    const int col = j * 256 + lane * 4;
                    const f32x4 v = {bflo(w[r][j][0]), bfhi(w[r][j][0]), bflo(w[r][j][1]), bfhi(w[r][j][1])};
                    const f32x4 o = v * inv * mul[j] + sh[j];
                    u32x2 wo = {pk2(o[0], o[1]), pk2(o[2], o[3])};
                    *(u32x2*)(h + (hrow + r) * DM + col) = wo;
                }
            }
        }
    }
    if (latonly) return;
    const float* md = modv + (size_t)(4 * 4 + layer) * 6144 + which * 3072;
    float* red = (float*)lds;
    const int wave = TIDX() >> 6, col = (wave & 3) * 256 + lane * 4;
    for (int pr = BIDX(); pr * 2 < NB * CTXL; pr += GDIM()) {
        const int cr = pr * 2 + (wave >> 2), b = cr / CTXL, rb = cr - b * CTXL;
        float* lp = (float*)(p.ws + WS_CTXLAT) + (size_t)cr * DM;
        const float* src = first ? IN(p, 2) + (size_t)cr * DM : lp;
        f32x4 v = *(const f32x4*)(src + col);
        if (nslab) {
            f32x4 a = {0.f, 0.f, 0.f, 0.f};
            if (glu) {
                const float* sp = slab + (size_t)cr * 2048 + (col >> 7) * 256 + (col & 127); f32x4 gz = {0.f, 0.f, 0.f, 0.f};
                f32x4 sv_[4], sg_[4];
#pragma unroll
                for (int ks = 0; ks < 4; ++ks) { sv_[ks] = *(const f32x4*)(sp + (size_t)ks * 1024 * 2048); sg_[ks] = *(const f32x4*)(sp + (size_t)ks * 1024 * 2048 + 128); }
#pragma unroll
                for (int ks = 0; ks < 4; ++ks) { a += sv_[ks]; gz += sg_[ks]; }
#pragma unroll
                for (int e = 0; e < 4; ++e) a[e] *= sigmoidf_(gz[e]);
            } else {
                const float* sp = slab + (size_t)cr * 1024 + col;
                f32x4 sl[16];
#pragma unroll
                for (int ks = 0; ks < 16; ++ks) { const float zf = ZF(); sl[ks] = (f32x4){zf, zf, zf, zf}; if (ks < nslab) sl[ks] = *(const f32x4*)(sp + (size_t)ks * 1024 * 1024); }
#pragma unroll
                for (int ks = 0; ks < 16; ++ks) a += sl[ks];
            }
            v += *(const f32x4*)(sgate + col) * a;
            *(f32x4*)(lp + col) = v;
        }
        float ss = wave_sum(v[0] * v[0] + v[1] * v[1] + v[2] * v[2] + v[3] * v[3]);
        __syncthreads();
        if (lane == 0) red[wave] = ss;
        __syncthreads();
        const float* rq = red + (wave & 4);
        const float inv = rsqrtf(((rq[0] + rq[1]) + (rq[2] + rq[3])) * (1.f / 1024.f) + EPS);
        if (first) *(f32x4*)(lp + col) = v;
        const f32x4 gg = *(const f32x4*)(g + col), sh = *(const f32x4*)(md + col), sc = *(const f32x4*)(md + 1024 + col);
        const f32x4 o = v * inv * gg * (1.f + sc) + sh;
        u32x2 w = {pk2(o[0], o[1]), pk2(o[2], o[3])};
        *(u32x2*)(h + (size_t)(b * RPB + rb) * DM + col) = w;
    }
}

constexpr int BM = 256, BK = 64, HALF = 128, HTB = HALF * BK * 2, NXCD = 8, WGM = 8;
struct Unit { int pm, pn, k0, nt, split, ks; };
enum { EPI_F32 = 0, EPI_BF16 = 1, EPI_RES = 2, EPI_RELU2 = 3, EPI_GLU = 4, EPI_GATES = 5, EPI_GELUMUL = 6, EPI_QN = 8, EPI_KVN = 9, EPI_DQKV = 10 };
struct GemmD {
    const bf16_t* A; const bf16_t* Bt; int lda, ldb, K, nN; int latonly; int koff_shift, koff_mul, kb_mul;
    int kind; int rev; int splitk; float* slab;
    void* out; int ldc;
    const float* gate; int gate_off;
    int layer;
    const float* res_x;
    int final;
    int perm;
    const float* aux0; const float* aux1; const void* aux2; void* out2;
};
DI int lds_byte(int r, int c) { const int st = (r >> 4) * 2 + (c >> 5), rr = r & 15, cc = c & 31, ob = rr * 64 + cc * 2; return st * 1024 + (ob ^ (((ob >> 9) & 1) << 5)); }
DI int perm32(int rho) { const int n = rho >> 4, i = rho & 15; return 8 * (i >> 2) + 4 * n + (i & 3); }
DI void stage_rc(int b, int& R, int& C) { const int st = b / 1024, sb = b % 1024, swz = sb ^ (((sb >> 9) & 1) << 5); R = (st >> 1) * 16 + swz / 64; C = (st & 1) * 32 + (swz % 64) / 2; }

DI bool unit_next(const GemmD& g, int i, Unit& u) {
    const bool sk = g.splitk > 0 && !g.latonly;
    const int nM = (g.latonly || sk) ? 64 : 68, nN = g.nN, nwg = nM * nN, G = GDIM(), c = g.rev ? GDIM() - 1 - BIDX() : BIDX();
    const long L = (long)i * G + c;
    u.k0 = 0; u.nt = g.K / BK; u.split = 0; u.ks = 0;
    if (L >= nwg) {
        if (!sk) return false;
        const int tt = (int)(L - nwg); if (tt >= 4 * nN * g.splitk) return false;
        const int ks = tt / (4 * nN), r = tt - ks * 4 * nN;
        u.pm = 17 * (r & 3); u.pn = r >> 2; u.nt = g.K / BK / g.splitk; u.k0 = ks * u.nt * BK; u.split = 1; u.ks = ks; return true;
    }
    int wgid = (int)L; { const int q = nwg / NXCD, r = nwg % NXCD, xcd = wgid % NXCD, off = wgid / NXCD; wgid = (xcd < r ? xcd * (q + 1) : r * (q + 1) + (xcd - r) * q) + off; }
    const int nig = WGM * nN, gid = wgid / nig, fm = gid * WGM, gsz = (nM - fm) < WGM ? (nM - fm) : WGM;
    int pm = fm + ((wgid % nig) % gsz); u.pn = (wgid % nig) / gsz;
    if (nM == 64) pm = 17 * (pm >> 4) + 1 + (pm & 15);
    u.pm = pm; return true;
}

constexpr int XCH_OFF = 131072;
template <int KIND>
DI void epi_loop(const Params& p, const GemmD& g, LAS unsigned char* lds, const f32x4 (&acc)[2][2][4][2], const Unit& u, int wr, int wc, int fr, int fq) {
    const int b = u.pm / 17, tpm = u.pm - 17 * b, mi = tpm == 0 ? 4 : b;
    const float* gatep = nullptr;
    if (KIND == EPI_RES || KIND == EPI_GLU) gatep = g.gate + (size_t)(mi * 4 + g.layer) * 6144 + g.gate_off;
    LAS f32x4* cst = (LAS f32x4*)(lds + XCH_OFF + (wr * 4 + wc) * 1024);
    if (KIND == EPI_GATES) {
        const int dir = u.pn & 1;
#pragma unroll
        for (int n = 0; n < 2; ++n) {
            const int ch = (u.pn >> 1) * 128 + wc * 32 + n * 16 + fq * 4;
            const f32x4 b0 = *(const f32x4*)(g.aux0 + (dir * 2 + 0) * LRUW + ch), b1 = *(const f32x4*)(g.aux0 + (dir * 2 + 1) * LRUW + ch);
            const f32x4 lam = *(const f32x4*)(g.aux1 + dir * LRUW + ch); f32x4 sp;
#pragma unroll
            for (int e = 0; e < 4; ++e) sp[e] = -8.f * log1pf(__expf(-lam[e]));
            if (fr == 0) { cst[(n * 3 + 0) * 4 + fq] = b0 * -1.4426950408889634f; cst[(n * 3 + 1) * 4 + fq] = b1 * -1.4426950408889634f; cst[(n * 3 + 2) * 4 + fq] = sp; }
        }
        LDS_FENCE();
    }
    const bool use_x = KIND == EPI_RES && g.res_x != nullptr;
    if (KIND == EPI_RES || KIND == EPI_GLU) {
#pragma unroll
        for (int n = 0; n < 2; ++n)
#pragma unroll
            for (int bj = 0; bj < (KIND == EPI_RES ? 2 : 1); ++bj) {
                const f32x4 gv = *(const f32x4*)(gatep + (KIND == EPI_RES ? u.pn * 256 + bj * 128 : u.pn * 128) + wc * 32 + n * 16 + fq * 4);
                if (fr == 0) cst[(n * 2 + bj) * 4 + fq] = gv;
            }
        LDS_FENCE();
    }
#pragma unroll
    for (int ai = 0; ai < 2; ++ai) {
        u32x2 pre[4][2][2];
        if ((KIND == EPI_RES && !use_x) || KIND == EPI_GLU || KIND == EPI_GATES) {
#pragma unroll
            for (int m = 0; m < 4; ++m) {
                const int rb = tpm * 256 + ai * 128 + wr * 64 + m * 16 + fr;
                const bf16_t* src = KIND == EPI_GATES ? (const bf16_t*)g.aux2 + (size_t)(b * RPB + rb) * LRUW + (u.pn >> 1) * 128
                                                      : (const bf16_t*)(p.ws + WS_RL) + (size_t)(b * SEQ + rb - CTXL) * DM + (KIND == EPI_RES ? u.pn * 256 : u.pn * 128);
#pragma unroll
                for (int n = 0; n < 2; ++n)
#pragma unroll
                    for (int bj = 0; bj < (KIND == EPI_RES ? 2 : 1); ++bj) pre[m][n][bj] = *(const u32x2*)(src + bj * 128 + wc * 32 + n * 16 + fq * 4);
            }
        }
#pragma unroll
        for (int m = 0; m < 4; ++m) {
            const int rb = tpm * 256 + ai * 128 + wr * 64 + m * 16 + fr;
            const int row = b * RPB + rb;
            bf16_t* lb = nullptr; const size_t lrow = (size_t)(b * SEQ + rb - CTXL) * DM;
            if (KIND == EPI_RES || KIND == EPI_GLU) lb = (bf16_t*)(p.ws + WS_RL) + lrow;
            f32x4 px[2][2];
            if (KIND == EPI_RES) { if (use_x) {
#pragma unroll
                for (int n = 0; n < 2; ++n)
#pragma unroll
                    for (int bj = 0; bj < 2; ++bj) px[n][bj] = *(const f32x4*)(g.res_x + lrow + u.pn * 256 + bj * 128 + wc * 32 + n * 16 + fq * 4);
            } }
#pragma unroll
            for (int n = 0; n < 2; ++n) {
                const int cw = wc * 32 + n * 16 + fq * 4;
                if (KIND == EPI_F32) {
#pragma unroll
                    for (int bj = 0; bj < 2; ++bj) *(f32x4*)((float*)g.out + (size_t)row * g.ldc + u.pn * 256 + bj * 128 + cw) = acc[ai][bj][m][n];
                } else if (KIND == EPI_BF16) {
#pragma unroll
                    for (int bj = 0; bj < 2; ++bj) { const f32x4 v = acc[ai][bj][m][n]; u32x2 w = {pk2(v[0], v[1]), pk2(v[2], v[3])};
                        *(u32x2*)((bf16_t*)g.out + (size_t)row * g.ldc + u.pn * 256 + bj * 128 + cw) = w; }
                } else if (KIND == EPI_RELU2) {
#pragma unroll
                    for (int bj = 0; bj < 2; ++bj) { f32x4 v = acc[ai][bj][m][n];
#pragma unroll
                        for (int e = 0; e < 4; ++e) { const float r = fmaxf(v[e], 0.f); v[e] = r * r; }
                        u32x2 w = {pk2(v[0], v[1]), pk2(v[2], v[3])};
                        *(u32x2*)((bf16_t*)g.out + (size_t)row * g.ldc + u.pn * 256 + bj * 128 + cw) = w; }
                } else if (KIND == EPI_RES) {
#pragma unroll
                    for (int bj = 0; bj < 2; ++bj) { const int col = u.pn * 256 + bj * 128 + cw;
                        const f32x4 gt = cst[(n * 2 + bj) * 4 + fq];
                        f32x4 v;
                        if (use_x) v = px[n][bj];
                        else { const u32x2 w = pre[m][n][bj]; v = (f32x4){bflo(w[0]), bfhi(w[0]), bflo(w[1]), bfhi(w[1])}; }
                        v += gt * acc[ai][bj][m][n];
                        if (g.final) *(f32x4*)(p.out + lrow + col) = v;
                        else { const u32x2 o = {pk2(v[0], v[1]), pk2(v[2], v[3])}; *(u32x2*)(lb + col) = o; } }
                } else if (KIND == EPI_GLU) {
                    const int col = u.pn * 128 + cw;
                    const f32x4 zv = acc[ai][0][m][n], zg = acc[ai][1][m][n];
                    const f32x4 gt = cst[(n * 2) * 4 + fq]; const u32x2 w = pre[m][n][0];
                    f32x4 v = {bflo(w[0]), bfhi(w[0]), bflo(w[1]), bfhi(w[1])};
#pragma unroll
                    for (int e = 0; e < 4; ++e) v[e] += gt[e] * zv[e] * sigmoidf_(zg[e]);
                    const u32x2 o = {pk2(v[0], v[1]), pk2(v[2], v[3])}; *(u32x2*)(lb + col) = o;
                } else if (KIND == EPI_GATES) {
                    const int dir = u.pn & 1;
                    const int ch = (u.pn >> 1) * 128 + cw;
                    const u32x2 xw = pre[m][n][0];
                    const f32x4 xr = {bflo(xw[0]), bfhi(xw[0]), bflo(xw[1]), bfhi(xw[1])};
                    const f32x4 gb0 = cst[(n * 3 + 0) * 4 + fq], gb1 = cst[(n * 3 + 1) * 4 + fq], gs = cst[(n * 3 + 2) * 4 + fq];
                    const f32x4 t0 = acc[ai][0][m][n] * -1.4426950408889634f + gb0, t1 = acc[ai][1][m][n] * -1.4426950408889634f + gb1;
                    f32x4 d0, d1;
#pragma unroll
                    for (int e = 0; e < 4; ++e) { d0[e] = __builtin_amdgcn_exp2f(t0[e]); d1[e] = __builtin_amdgcn_exp2f(t1[e]); }
                    d0 = d0 + 1.f; d1 = d1 + 1.f;
                    f32x4 r, ig;
#pragma unroll
                    for (int e = 0; e < 4; ++e) { r[e] = __builtin_amdgcn_rcpf(d0[e]); ig[e] = __builtin_amdgcn_rcpf(d1[e]); }
                    const f32x4 la = gs * r;
                    const f32x4 x = la + la;
                    f32x4 q = x * -0.008333334f + -0.041666668f; q = x * q + -0.16666667f; q = x * q + -0.5f; q = x * q + -1.f;
                    const f32x4 om = x * q;
                    f32x4 sq;
#pragma unroll
                    for (int e = 0; e < 4; ++e) sq[e] = __builtin_amdgcn_sqrtf(om[e]);
                    const f32x4 bb = sq * (ig * xr);
                    u32x2 wl = {pk2(la[0], la[1]), pk2(la[2], la[3])}, wb = {pk2(bb[0], bb[1]), pk2(bb[2], bb[3])};
                    *(u32x2*)((bf16_t*)((unsigned char*)g.out + dir * LRU_DIRSTRIDE) + (size_t)row * LRUW + ch) = wl;
                    *(u32x2*)((bf16_t*)((unsigned char*)g.out2 + dir * LRU_DIRSTRIDE) + (size_t)row * LRUW + ch) = wb;
                } else if (KIND == EPI_GELUMUL) {
#pragma unroll
                    for (int bj = 0; bj < 2; ++bj) { const int col = u.pn * 256 + bj * 128 + cw; f32x4 v = acc[ai][bj][m][n];
#pragma unroll
                        for (int e = 0; e < 4; ++e) v[e] = gelu_tanh(v[e]);
                        u32x2 w = {pk2(v[0], v[1]), pk2(v[2], v[3])};
                        *(u32x2*)((bf16_t*)g.out + (size_t)row * g.ldc + col) = w; }
                }
            }
        }
    }
}

DI u32x4 lane_tr(u32x4 w, int srcaddr) {
    u32x4 r;
#pragma unroll
    for (int k = 0; k < 4; ++k) r[k] = (unsigned)__builtin_amdgcn_ds_bpermute(srcaddr, (int)w[k]);
    return r;
}
template <int KIND>
DI void epi_loop_p(const Params& p, const GemmD& g, LAS unsigned char* lds, const f32x4 (&acc)[2][2][4][2], const Unit& u, int wr, int wc, int fr, int fq) {
    const int b = u.pm / 17, tpm = u.pm - 17 * b, mi = tpm == 0 ? 4 : b;
    const int c8 = wc * 32 + fq * 8;
    const int ln = fq * 16 + fr, sfr = ln >> 2, sfq = ln & 3, c8s = wc * 32 + sfq * 8;
    const int to_mem = (sfq * 16 + sfr) * 4, to_acc = (fr * 4 + fq) * 4;
    LAS f32x4* cst = (LAS f32x4*)(lds + XCH_OFF + (wr * 4 + wc) * 1024);
    if (KIND == EPI_GATES) {
        const int dir = u.pn & 1;
#pragma unroll
        for (int n = 0; n < 2; ++n) {
            const int ch = (u.pn >> 1) * 128 + c8 + 4 * n;
            const f32x4 b0 = *(const f32x4*)(g.aux0 + (dir * 2 + 0) * LRUW + ch), b1 = *(const f32x4*)(g.aux0 + (dir * 2 + 1) * LRUW + ch);
            const f32x4 lam = *(const f32x4*)(g.aux1 + dir * LRUW + ch); f32x4 sp;
#pragma unroll
            for (int e = 0; e < 4; ++e) sp[e] = -8.f * log1pf(__expf(-lam[e]));
            if (fr == 0) { cst[(n * 3 + 0) * 4 + fq] = b0 * -1.4426950408889634f; cst[(n * 3 + 1) * 4 + fq] = b1 * -1.4426950408889634f; cst[(n * 3 + 2) * 4 + fq] = sp; }
        }
        LDS_FENCE();
    }
    if (KIND == EPI_RES || KIND == EPI_GLU) {
        const float* gatep = g.gate + (size_t)(mi * 4 + g.layer) * 6144 + g.gate_off;
#pragma unroll
        for (int n = 0; n < 2; ++n)
#pragma unroll
            for (int bj = 0; bj < (KIND == EPI_RES ? 2 : 1); ++bj) {
                const f32x4 gv = *(const f32x4*)(gatep + (KIND == EPI_RES ? u.pn * 256 + bj * 128 : u.pn * 128) + c8 + 4 * n);
                if (fr == 0) cst[(n * 2 + bj) * 4 + fq] = gv;
            }
        LDS_FENCE();
    }
    const bool use_x = KIND == EPI_RES && g.res_x != nullptr;
#pragma unroll
    for (int ai = 0; ai < 2; ++ai) {
        u32x4 pre[4][2];
        if ((KIND == EPI_RES && !use_x) || KIND == EPI_GLU || KIND == EPI_GATES) {
#pragma unroll
            for (int m = 0; m < 4; ++m) {
                const int rb = tpm * 256 + ai * 128 + wr * 64 + m * 16 + sfr;
                const bf16_t* src = KIND == EPI_GATES ? (const bf16_t*)g.aux2 + (size_t)(b * RPB + rb) * LRUW + (u.pn >> 1) * 128
                                                      : (const bf16_t*)(p.ws + WS_RL) + (size_t)(b * SEQ + rb - CTXL) * DM + (KIND == EPI_RES ? u.pn * 256 : u.pn * 128);
#pragma unroll
                for (int bj = 0; bj < (KIND == EPI_RES ? 2 : 1); ++bj) pre[m][bj] = *(const u32x4*)(src + bj * 128 + c8s);
            }
        }
#pragma unroll
        for (int m = 0; m < 4; ++m) {
            const int rb = tpm * 256 + ai * 128 + wr * 64 + m * 16 + sfr;
            const int row = b * RPB + rb;
            const size_t lrow = (size_t)(b * SEQ + rb - CTXL) * DM;
            const size_t lrow_a = (size_t)(b * SEQ + tpm * 256 + ai * 128 + wr * 64 + m * 16 + fr - CTXL) * DM;
            if (KIND == EPI_BF16 || KIND == EPI_RELU2 || KIND == EPI_GELUMUL) {
#pragma unroll
                for (int bj = 0; bj < 2; ++bj) {
                    f32x4 v0 = acc[ai][bj][m][0], v1 = acc[ai][bj][m][1];
                    if (KIND == EPI_RELU2) {
#pragma unroll
                        for (int e = 0; e < 4; ++e) { const float r0 = fmaxf(v0[e], 0.f), r1 = fmaxf(v1[e], 0.f); v0[e] = r0 * r0; v1[e] = r1 * r1; }
                    }
                    if (KIND == EPI_GELUMUL) {
#pragma unroll
                        for (int e = 0; e < 4; ++e) { v0[e] = gelu_tanh(v0[e]); v1[e] = gelu_tanh(v1[e]); }
                    }
                    const u32x4 w = {pk2(v0[0], v0[1]), pk2(v0[2], v0[3]), pk2(v1[0], v1[1]), pk2(v1[2], v1[3])};
                    *(u32x4*)((bf16_t*)g.out + (size_t)row * g.ldc + u.pn * 256 + bj * 128 + c8s) = lane_tr(w, to_mem);
                }
            } else if (KIND == EPI_RES) {
                bf16_t* lb = (bf16_t*)(p.ws + WS_RL) + lrow;
                f32x4 px[2][2];
                if (use_x) {
#pragma unroll
                    for (int n = 0; n < 2; ++n)
#pragma unroll
                        for (int bj = 0; bj < 2; ++bj) px[n][bj] = *(const f32x4*)(g.res_x + lrow_a + u.pn * 256 + bj * 128 + c8 + 4 * n);
                }
#pragma unroll
                for (int bj = 0; bj < 2; ++bj) {
                    const int col = u.pn * 256 + bj * 128 + c8;
                    f32x4 v0, v1;
                    if (use_x) { v0 = px[0][bj]; v1 = px[1][bj]; }
                    else { const u32x4 w = lane_tr(pre[m][bj], to_acc); v0 = (f32x4){bflo(w[0]), bfhi(w[0]), bflo(w[1]), bfhi(w[1])}; v1 = (f32x4){bflo(w[2]), bfhi(w[2]), bflo(w[3]), bfhi(w[3])}; }
                    v0 += cst[(0 * 2 + bj) * 4 + fq] * acc[ai][bj][m][0]; v1 += cst[(1 * 2 + bj) * 4 + fq] * acc[ai][bj][m][1];
                    if (g.final) { *(f32x4*)(p.out + lrow_a + col) = v0; *(f32x4*)(p.out + lrow_a + col + 4) = v1; }
                    else { const u32x4 o = {pk2(v0[0], v0[1]), pk2(v0[2], v0[3]), pk2(v1[0], v1[1]), pk2(v1[2], v1[3])}; *(u32x4*)(lb + u.pn * 256 + bj * 128 + c8s) = lane_tr(o, to_mem); }
                }
            } else if (KIND == EPI_GLU) {
                bf16_t* lb = (bf16_t*)(p.ws + WS_RL) + lrow;
                const int col = u.pn * 128 + c8;
                const u32x4 w = lane_tr(pre[m][0], to_acc);
                f32x4 v0 = {bflo(w[0]), bfhi(w[0]), bflo(w[1]), bfhi(w[1])}, v1 = {bflo(w[2]), bfhi(w[2]), bflo(w[3]), bfhi(w[3])};
                const f32x4 g0 = cst[(0 * 2) * 4 + fq], g1 = cst[(1 * 2) * 4 + fq];
#pragma unroll
                for (int e = 0; e < 4; ++e) { v0[e] += g0[e] * acc[ai][0][m][0][e] * sigmoidf_(acc[ai][1][m][0][e]); v1[e] += g1[e] * acc[ai][0][m][1][e] * sigmoidf_(acc[ai][1][m][1][e]); }
                const u32x4 o = {pk2(v0[0], v0[1]), pk2(v0[2], v0[3]), pk2(v1[0], v1[1]), pk2(v1[2], v1[3])}; *(u32x4*)(lb + u.pn * 128 + c8s) = lane_tr(o, to_mem);
            } else if (KIND == EPI_GATES) {
                const int dir = u.pn & 1;
                const int ch = (u.pn >> 1) * 128 + c8s;
                const u32x4 xw = lane_tr(pre[m][0], to_acc);
                u32x4 wl, wb;
#pragma unroll
                for (int n = 0; n < 2; ++n) {
                    const f32x4 xr = {bflo(xw[2 * n]), bfhi(xw[2 * n]), bflo(xw[2 * n + 1]), bfhi(xw[2 * n + 1])};
                    const f32x4 gb0 = cst[(n * 3 + 0) * 4 + fq], gb1 = cst[(n * 3 + 1) * 4 + fq], gs = cst[(n * 3 + 2) * 4 + fq];
                    const f32x4 t0 = acc[ai][0][m][n] * -1.4426950408889634f + gb0, t1 = acc[ai][1][m][n] * -1.4426950408889634f + gb1;
                    f32x4 d0, d1;
#pragma unroll
                    for (int e = 0; e < 4; ++e) { d0[e] = __builtin_amdgcn_exp2f(t0[e]); d1[e] = __builtin_amdgcn_exp2f(t1[e]); }
                    d0 = d0 + 1.f; d1 = d1 + 1.f;
                    f32x4 r, ig;
#pragma unroll
                    for (int e = 0; e < 4; ++e) { r[e] = __builtin_amdgcn_rcpf(d0[e]); ig[e] = __builtin_amdgcn_rcpf(d1[e]); }
                    const f32x4 la = gs * r;
                    const f32x4 x = la + la;
                    f32x4 q = x * -0.008333334f + -0.041666668f; q = x * q + -0.16666667f; q = x * q + -0.5f; q = x * q + -1.f;
                    const f32x4 om = x * q;
                    f32x4 sq;
#pragma unroll
                    for (int e = 0; e < 4; ++e) sq[e] = __builtin_amdgcn_sqrtf(om[e]);
                    const f32x4 bb = sq * (ig * xr);
                    wl[2 * n] = pk2(la[0], la[1]); wl[2 * n + 1] = pk2(la[2], la[3]); wb[2 * n] = pk2(bb[0], bb[1]); wb[2 * n + 1] = pk2(bb[2], bb[3]);
                }
                *(u32x4*)((bf16_t*)((unsigned char*)g.out + dir * LRU_DIRSTRIDE) + (size_t)row * LRUW + ch) = lane_tr(wl, to_mem);
                *(u32x4*)((bf16_t*)((unsigned char*)g.out2 + dir * LRU_DIRSTRIDE) + (size_t)row * LRUW + ch) = lane_tr(wb, to_mem);
            }
        }
    }
}

DI void epi_rowstats(const f32x4 (&acc)[2][2][4][2], float (&ps)[2][4][2]) {
#pragma unroll
    for (int ai = 0; ai < 2; ++ai)
#pragma unroll
        for (int m = 0; m < 4; ++m)
#pragma unroll
            for (int bj = 0; bj < 2; ++bj) {
                float s = 0.f;
#pragma unroll
                for (int n = 0; n < 2; ++n) { const f32x4 v = acc[ai][bj][m][n]; s += v[0] * v[0] + v[1] * v[1] + v[2] * v[2] + v[3] * v[3]; }
                { auto r16 = __builtin_amdgcn_permlane16_swap(__float_as_uint(s), __float_as_uint(s), false, false); s = __uint_as_float(r16[0]) + __uint_as_float(r16[1]); }
                { auto r32 = __builtin_amdgcn_permlane32_swap(__float_as_uint(s), __float_as_uint(s), false, false); s = __uint_as_float(r32[0]) + __uint_as_float(r32[1]); }
                ps[ai][m][bj] = s;
            }
}
DI void epi_exchange(LAS unsigned char* lds, const float (&ps)[2][4][2], float (&tot)[2][4][2], int wr, int wc, int fr, int fq) {
    LAS float* X = (LAS float*)(lds + XCH_OFF);
    if (fq == 0) {
#pragma unroll
        for (int ai = 0; ai < 2; ++ai)
#pragma unroll
            for (int m = 0; m < 4; ++m)
#pragma unroll
                for (int bj = 0; bj < 2; ++bj) X[((ai * 128 + wr * 64 + m * 16 + fr) * 2 + bj) * 4 + wc] = ps[ai][m][bj];
    }
    asm volatile("s_waitcnt lgkmcnt(0)" ::: "memory"); __builtin_amdgcn_s_barrier(); asm volatile("" ::: "memory");
#pragma unroll
    for (int ai = 0; ai < 2; ++ai)
#pragma unroll
        for (int m = 0; m < 4; ++m)
#pragma unroll
            for (int bj = 0; bj < 2; ++bj) { const f32x4 t = *(const LAS f32x4*)(X + ((ai * 128 + wr * 64 + m * 16 + fr) * 2 + bj) * 4); tot[ai][m][bj] = (t[0] + t[1]) + (t[2] + t[3]); }
}
DI void epi_qn(const Params& p, const GemmD& g, LAS unsigned char* lds, const f32x4 (&acc)[2][2][4][2], const Unit& u, int wr, int wc, int fr, int fq) {
    const int b = u.pm / 17, tpm = u.pm - 17 * b;
    float ps[2][4][2]; epi_rowstats(acc, ps);
    bf16_t* Q = (bf16_t*)g.out; const float* gqk = g.aux0;
    const int ln_ = fq * 16 + fr, sfr = ln_ >> 2, sfq = ln_ & 3, to_mem = (sfq * 16 + sfr) * 4;
    const float* DQSS = (const float*)(p.ws + WS_T + T_DQKV);
    float epsqv[2][4];
#pragma unroll
    for (int ai = 0; ai < 2; ++ai)
#pragma unroll
        for (int m = 0; m < 4; ++m) {
            const int row = b * RPB + tpm * 256 + ai * 128 + wr * 64 + m * 16 + fr;
            const f32x4 d0 = *(const f32x4*)(DQSS + (size_t)row * 16), d1 = *(const f32x4*)(DQSS + (size_t)row * 16 + 4), d2 = *(const f32x4*)(DQSS + (size_t)row * 16 + 8);
            const float ms = (((d0[0] + d0[1]) + (d0[2] + d0[3])) + ((d1[0] + d1[1]) + (d1[2] + d1[3])) + ((d2[0] + d2[1]) + (d2[2] + d2[3]))) * (1.f / 384.f); epsqv[ai][m] = EPS * (ms + EPS);
        }
    if (u.pn < 4) {
        float tot[2][4][2]; epi_exchange(lds, ps, tot, wr, wc, fr, fq);
        f32x4 gn[2];
#pragma unroll
        for (int n = 0; n < 2; ++n) gn[n] = *(const f32x4*)(gqk + wc * 32 + fq * 8 + n * 4);
#pragma unroll
        for (int ai = 0; ai < 2; ++ai)
#pragma unroll
            for (int m = 0; m < 4; ++m) {
                const int row = b * RPB + tpm * 256 + ai * 128 + wr * 64 + m * 16 + fr;
                const float epsq = epsqv[ai][m];
#pragma unroll
                for (int bj = 0; bj < 2; ++bj) {
                    const float inv = rsqrtf(tot[ai][m][bj] * (1.f / 128.f) + epsq) * QSCALE;
                    const f32x4 v0 = acc[ai][bj][m][0] * inv * gn[0], v1 = acc[ai][bj][m][1] * inv * gn[1];
                    const u32x4 w = {pk2(v0[0], v0[1]), pk2(v0[2], v0[3]), pk2(v1[0], v1[1]), pk2(v1[2], v1[3])};
                    *(u32x4*)(Q + (size_t)(row - fr + sfr) * 1536 + (2 * u.pn + bj) * 192 + wc * 32 + sfq * 8) = lane_tr(w, to_mem);
                }
            }
    } else {
        const int hh = 4 * (u.pn - 4) + wc; const float* tb = (const float*)(p.ws + WS_ROPE);
        f32x4 gr[2][2];
#pragma unroll
        for (int bj = 0; bj < 2; ++bj)
#pragma unroll
            for (int n = 0; n < 2; ++n) gr[bj][n] = *(const f32x4*)(gqk + 128 + bj * 32 + n * 16 + fq * 4);
#pragma unroll
        for (int ai = 0; ai < 2; ++ai)
#pragma unroll
            for (int m = 0; m < 4; ++m) {
                const int rb = tpm * 256 + ai * 128 + wr * 64 + m * 16 + fr, row = b * RPB + rb, t = rb - CTXL;
                const float epsq = epsqv[ai][m];
                const float inv = rsqrtf((ps[ai][m][0] + ps[ai][m][1]) * (1.f / 64.f) + epsq);
#pragma unroll
                for (int bj = 0; bj < 2; ++bj) {
                    f32x4 x0 = acc[ai][bj][m][0] * inv * gr[bj][0], x1 = acc[ai][bj][m][1] * inv * gr[bj][1];
                    if (tpm != 0) {
                        const int pos = bj == 0 ? (t >> 6) : (t & 63);
                        const f32x4 cs = *(const f32x4*)(tb + pos * 32 + fq * 4), sn = *(const f32x4*)(tb + pos * 32 + 16 + fq * 4);
                        const f32x4 y0 = x0 * cs - x1 * sn, y1 = x1 * cs + x0 * sn; x0 = y0; x1 = y1;
                    }
                    x0 = x0 * QSCALE; x1 = x1 * QSCALE;
                    const u32x4 w01 = {pk2(x0[0], x0[1]), pk2(x0[2], x0[3]), pk2(x1[0], x1[1]), pk2(x1[2], x1[3])};
                    *(u32x4*)(Q + (size_t)(row - fr + sfr) * 1536 + hh * 192 + 128 + bj * 32 + sfq * 8) = lane_tr(w01, to_mem);
                }
            }
    }
}

DI void epi_dqkv(const Params& p, const GemmD& g, LAS unsigned char* lds, const f32x4 (&acc)[2][2][4][2], const Unit& u, int wr, int wc, int fr, int fq) {
    const int b = u.pm / 17, tpm = u.pm - 17 * b;
    float ps[2][4][2]; epi_rowstats(acc, ps);
    bf16_t* CQ = (bf16_t*)(p.ws + WS_T + T_CQ); bf16_t* CKV = (bf16_t*)(p.ws + WS_T + T_CKV); bf16_t* KR = (bf16_t*)(p.ws + WS_T + T_KR);
    float* DQSS = (float*)(p.ws + WS_T + T_DQKV);
    const int ln_ = fq * 16 + fr, sfr = ln_ >> 2, sfq = ln_ & 3, to_mem = (sfq * 16 + sfr) * 4;
    float tot[2][4][2];
    if (u.pn != 0) epi_exchange(lds, ps, tot, wr, wc, fr, fq);
    f32x4 gk[2]; const float* tb = (const float*)(p.ws + WS_ROPE);
    if (u.pn == 1) { gk[0] = wc < 2 ? *(const f32x4*)(g.aux1 + wc * 32 + fq * 4) : (f32x4){0.f, 0.f, 0.f, 0.f}; gk[1] = wc < 2 ? *(const f32x4*)(g.aux1 + wc * 32 + 16 + fq * 4) : (f32x4){0.f, 0.f, 0.f, 0.f}; }
#pragma unroll
    for (int ai = 0; ai < 2; ++ai)
#pragma unroll
        for (int m = 0; m < 4; ++m) {
            const int rb = tpm * 256 + ai * 128 + wr * 64 + m * 16 + fr, row = b * RPB + rb;
            if (u.pn == 0 || u.pn == 1) {
                const int nh = u.pn == 0 ? 2 : 1;
#pragma unroll
                for (int bj = 0; bj < 2; ++bj) {
                    if (bj < nh) {
                        { const f32x4 v0 = acc[ai][bj][m][0], v1 = acc[ai][bj][m][1]; const u32x4 w = {pk2(v0[0], v0[1]), pk2(v0[2], v0[3]), pk2(v1[0], v1[1]), pk2(v1[2], v1[3])};
                            *(u32x4*)(CQ + (size_t)(row - fr + sfr) * 384 + u.pn * 256 + bj * 128 + wc * 32 + sfq * 8) = lane_tr(w, to_mem); }
                        if (fq == 0) DQSS[(size_t)row * 16 + u.pn * 8 + bj * 4 + wc] = ps[ai][m][bj];
                    }
                }
            }
            if (u.pn == 1 && wc < 2) {
                const float inv = rsqrtf(tot[ai][m][1] * (1.f / 64.f) + EPS);
                f32x4 x0 = acc[ai][1][m][0] * inv * gk[0], x1 = acc[ai][1][m][1] * inv * gk[1];
                if (tpm != 0) {
                    const int t = rb - CTXL, pos = wc == 0 ? (t >> 6) : (t & 63);
                    const f32x4 cs = *(const f32x4*)(tb + pos * 32 + fq * 4), sn = *(const f32x4*)(tb + pos * 32 + 16 + fq * 4);
                    const f32x4 y0 = x0 * cs - x1 * sn, y1 = x1 * cs + x0 * sn; x0 = y0; x1 = y1;
                }
                const u32x4 w01 = {pk2(x0[0], x0[1]), pk2(x0[2], x0[3]), pk2(x1[0], x1[1]), pk2(x1[2], x1[3])};
                *(u32x4*)(KR + (size_t)(row - fr + sfr) * 64 + wc * 32 + sfq * 8) = lane_tr(w01, to_mem);
            }
            if (u.pn == 2) {
                const float inv = rsqrtf((tot[ai][m][0] + tot[ai][m][1]) * (1.f / 256.f) + EPS);
#pragma unroll
                for (int bj = 0; bj < 2; ++bj)
                    { const int col = bj * 128 + wc * 32 + fq * 8;
                        const f32x4 v0 = acc[ai][bj][m][0] * inv * *(const f32x4*)(g.aux0 + col), v1 = acc[ai][bj][m][1] * inv * *(const f32x4*)(g.aux0 + col + 4);
                        const u32x4 w = {pk2(v0[0], v0[1]), pk2(v0[2], v0[3]), pk2(v1[0], v1[1]), pk2(v1[2], v1[3])};
                        *(u32x4*)(CKV + (size_t)(row - fr + sfr) * 256 + bj * 128 + wc * 32 + sfq * 8) = lane_tr(w, to_mem); }
            }
        }
}
DI void epi_kvn(const Params& p, const GemmD& g, LAS unsigned char* lds, const f32x4 (&acc)[2][2][4][2], const Unit& u, int wr, int wc, int fr, int fq) {
    const int b = u.pm / 17, tpm = u.pm - 17 * b;
    float ps[2][4][2], tot[2][4][2]; epi_rowstats(acc, ps); epi_exchange(lds, ps, tot, wr, wc, fr, fq);
    bf16_t* KV = (bf16_t*)g.out; const float* gk = g.aux0;
    const int ln_ = fq * 16 + fr, sfr = ln_ >> 2, sfq = ln_ & 3, to_mem = (sfq * 16 + sfr) * 4;
    f32x4 gn[2];
#pragma unroll
    for (int n = 0; n < 2; ++n) gn[n] = *(const f32x4*)(gk + wc * 32 + fq * 8 + n * 4);
#pragma unroll
    for (int ai = 0; ai < 2; ++ai)
#pragma unroll
        for (int m = 0; m < 4; ++m) {
            const int row = b * RPB + tpm * 256 + ai * 128 + wr * 64 + m * 16 + fr;
            const float inv = rsqrtf(tot[ai][m][0] * (1.f / 128.f) + EPS);
            bf16_t* kd = KV + (size_t)(row - fr + sfr) * 2048 + u.pn * 256 + wc * 32 + sfq * 8;
            const f32x4 k0 = acc[ai][0][m][0] * inv * gn[0], k1 = acc[ai][0][m][1] * inv * gn[1], v0 = acc[ai][1][m][0], v1 = acc[ai][1][m][1];
            const u32x4 wk = {pk2(k0[0], k0[1]), pk2(k0[2], k0[3]), pk2(k1[0], k1[1]), pk2(k1[2], k1[3])}, wv = {pk2(v0[0], v0[1]), pk2(v0[2], v0[3]), pk2(v1[0], v1[1]), pk2(v1[2], v1[3])};
            *(u32x4*)kd = lane_tr(wk, to_mem); *(u32x4*)(kd + 128) = lane_tr(wv, to_mem);
        }
}
DI void epilogue(const Params& p, const GemmD& g, LAS unsigned char* lds, const f32x4 (&acc)[2][2][4][2], const Unit& u, int wr, int wc, int fr, int fq) {
    asm volatile("" : "+v"(fr), "+v"(fq));
    if (u.split) {
        const int b = u.pm / 17;
#pragma unroll
        for (int ai = 0; ai < 2; ++ai)
#pragma unroll
            for (int m = 0; m < 4; ++m) {
                float* sp = g.slab + ((size_t)u.ks * 1024 + (b * CTXL + ai * 128 + wr * 64 + m * 16 + fr)) * (size_t)(g.nN * 256) + u.pn * 256 + wc * 32 + (g.perm ? fq * 8 : fq * 4);
#pragma unroll
                for (int bj = 0; bj < 2; ++bj)
#pragma unroll
                    for (int n = 0; n < 2; ++n) *(f32x4*)(sp + bj * 128 + (g.perm ? n * 4 : n * 16)) = acc[ai][bj][m][n];
            }
        return;
    }
    switch (g.kind) {
        case EPI_F32: epi_loop<EPI_F32>(p, g, lds, acc, u, wr, wc, fr, fq); break;
        case EPI_BF16: epi_loop_p<EPI_BF16>(p, g, lds, acc, u, wr, wc, fr, fq); break;
        case EPI_RES: epi_loop_p<EPI_RES>(p, g, lds, acc, u, wr, wc, fr, fq); break;
        case EPI_RELU2: epi_loop_p<EPI_RELU2>(p, g, lds, acc, u, wr, wc, fr, fq); break;
        case EPI_GLU: epi_loop_p<EPI_GLU>(p, g, lds, acc, u, wr, wc, fr, fq); break;
        case EPI_GATES: epi_loop_p<EPI_GATES>(p, g, lds, acc, u, wr, wc, fr, fq); break;
        case EPI_QN: epi_qn(p, g, lds, acc, u, wr, wc, fr, fq); break;
        case EPI_KVN: epi_kvn(p, g, lds, acc, u, wr, wc, fr, fq); break;
        case EPI_DQKV: epi_dqkv(p, g, lds, acc, u, wr, wc, fr, fq); break;
        default: epi_loop_p<EPI_GELUMUL>(p, g, lds, acc, u, wr, wc, fr, fq); break;
    }
}

struct GemmD;
DI GemmD make_gemm(const Params& p, int gid, int layer, bool dry);
#if NAIVE_GEMM
DI void gemm_phase(const Params& p, LAS unsigned char* lds, const GemmD& g, int gid, int layer, bool dry) {
    const int tid = TIDX(), wid = tid >> 6, lane = tid & 63, wr = wid >> 2, wc = wid & 3, fr = lane & 15, fq = lane >> 4;
    Unit u;
    for (int ui = 0; unit_next(g, ui, u); ++ui) {
        f32x4 acc[2][2][4][2];
#pragma unroll
        for (int a = 0; a < 2; ++a)
#pragma unroll
            for (int b = 0; b < 2; ++b)
#pragma unroll
                for (int m = 0; m < 4; ++m)
#pragma unroll
                    for (int n = 0; n < 2; ++n) { const float z = ZF(); acc[a][b][m][n] = (f32x4){z, z, z, z}; }
        const bf16_t* A = g.A + (size_t)u.pm * 256 * g.lda + (size_t)((u.pn >> g.koff_shift) * g.koff_mul);
        const bf16_t* B = g.Bt + (size_t)u.pn * 256 * g.ldb;
        for (int k0 = u.k0; k0 < u.k0 + u.nt * BK; k0 += 32) {
            bf16x8 af[2][4], bfr[2][2];
#pragma unroll
            for (int ai = 0; ai < 2; ++ai)
#pragma unroll
                for (int m = 0; m < 4; ++m) af[ai][m] = *(const bf16x8*)(A + (size_t)(ai * 128 + wr * 64 + m * 16 + fr) * g.lda + k0 + fq * 8);
#pragma unroll
            for (int bj = 0; bj < 2; ++bj)
#pragma unroll
                for (int n = 0; n < 2; ++n) bfr[bj][n] = *(const bf16x8*)(B + (size_t)(bj * 128 + wc * 32 + n * 16 + fr) * g.ldb + k0 + fq * 8);
#pragma unroll
            for (int ai = 0; ai < 2; ++ai)
#pragma unroll
                for (int bj = 0; bj < 2; ++bj)
#pragma unroll
                    for (int m = 0; m < 4; ++m)
#pragma unroll
                        for (int n = 0; n < 2; ++n) acc[ai][bj][m][n] = __builtin_amdgcn_mfma_f32_16x16x32_bf16(bfr[bj][n], af[ai][m], acc[ai][bj][m][n], 0, 0, 0);
        }
        epilogue(p, g, lds, acc, u, wr, wc, fr, fq);
    }
}
#else
DI void gemm_phase(const Params& p, LAS unsigned char* lds, const GemmD& g, int gid, int layer, bool dry) {
    const int tid = TIDX(), wid = __builtin_amdgcn_readfirstlane(tid >> 6), lane = tid & 63, wr = wid >> 2, wc = wid & 3, fr = lane & 15, fq = lane >> 4;
    unsigned voffA[2], voffB[2];
#pragma unroll
    for (int i = 0; i < 2; ++i) { int R, C; stage_rc(tid * 16 + i * 8192, R, C); voffA[i] = (unsigned)(R * g.lda + C) * 2u; const int Rb = g.perm ? (R & ~31) + perm32(R & 31) : R; voffB[i] = (unsigned)(Rb * g.ldb + C) * 2u; }
    const size_t kstep = (size_t)(BK * 2);
    const size_t hstepA = (size_t)HALF * g.lda * 2, hstepB = (size_t)HALF * g.ldb * 2;
    const unsigned ldsw = (unsigned)wid * 1024u;
    const int aoff = lds_byte(wr * 64 + fr, fq * 8), boff = lds_byte(wc * 32 + fr, fq * 8);
#define PG8_SA(b, h) (((b) * 2 + (h)) * HTB)
#define PG8_SB(b, h) ((4 + (b) * 2 + (h)) * HTB)
#define PG8_STAGE(bufoff, gbase, voff) do { _Pragma("unroll") for (int _i = 0; _i < 2; ++_i) \
        __builtin_amdgcn_global_load_lds((const unsigned*)((const char*)(gbase) + (voff)[_i]), (LAS unsigned*)(lds + (bufoff) + ldsw + _i * 8192), 16, 0, 0); } while (0)
#define PG8_LDA(dst, b, h) do { _Pragma("unroll") for (int m = 0; m < 4; ++m) _Pragma("unroll") for (int k = 0; k < 2; ++k) dst[m][k] = *(const LAS bf16x8*)(lds + PG8_SA(b, h) + aoff + m * 2048 + k * 1024); } while (0)
#define PG8_LDB(dst, b, h) do { _Pragma("unroll") for (int n = 0; n < 2; ++n) _Pragma("unroll") for (int k = 0; k < 2; ++k) dst[n][k] = *(const LAS bf16x8*)(lds + PG8_SB(b, h) + boff + n * 2048 + k * 1024); } while (0)
#define PG8_MMA(ai, bj, At, Bt) do { __builtin_amdgcn_s_setprio(1); _Pragma("unroll") for (int m = 0; m < 4; ++m) _Pragma("unroll") for (int n = 0; n < 2; ++n) _Pragma("unroll") for (int k = 0; k < 2; ++k) \
        acc[ai][bj][m][n] = __builtin_amdgcn_mfma_f32_16x16x32_bf16(Bt[n][k], At[m][k], acc[ai][bj][m][n], 0, 0, 0); __builtin_amdgcn_s_setprio(0); } while (0)
#define PG8_WAIT_V(n) asm volatile("s_waitcnt vmcnt(" #n ")" ::: "memory")
#define PG8_WAIT_L(n) asm volatile("s_waitcnt lgkmcnt(" #n ")" ::: "memory")
#define PG8_BAR __builtin_amdgcn_s_barrier()
#define PG8_SCHED __builtin_amdgcn_sched_barrier(0)
    const bool pf_on = (g.kind == EPI_RES && g.res_x == nullptr) || g.kind == EPI_GLU; const int pf_w = g.kind == EPI_RES ? 256 : 128;
    Unit cur, nxt; int ui = 0;
    if (!unit_next(g, 0, cur)) return;
    f32x4 acc[2][2][4][2];
#pragma unroll
    for (int a = 0; a < 2; ++a)
#pragma unroll
        for (int b = 0; b < 2; ++b)
#pragma unroll
            for (int m = 0; m < 4; ++m)
#pragma unroll
                for (int n = 0; n < 2; ++n) { const float z = ZF(); acc[a][b][m][n] = (f32x4){z, z, z, z}; }
    bf16x8 At[4][2], B0[2][2], B1[2][2];
    const char* cA = (const char*)g.A + (size_t)cur.pm * 2 * hstepA + (size_t)((cur.pn >> g.koff_shift) * g.koff_mul + cur.k0) * 2;
    const char* cB = (const char*)g.Bt + (size_t)cur.pn * 2 * hstepB + (size_t)(cur.k0 + ((cur.pn >> 1) & 1) * g.kb_mul) * 2;
    PG8_STAGE(PG8_SB(0, 0), cB, voffB); PG8_STAGE(PG8_SB(0, 1), cB + hstepB, voffB); PG8_STAGE(PG8_SA(0, 0), cA, voffA); PG8_STAGE(PG8_SA(0, 1), cA + hstepA, voffA);
    if (wr == 1) PG8_BAR;
    PG8_WAIT_V(2); PG8_BAR;
    PG8_STAGE(PG8_SB(1, 0), cB + kstep, voffB); PG8_STAGE(PG8_SA(1, 0), cA + kstep, voffA); PG8_STAGE(PG8_SB(1, 1), cB + hstepB + kstep, voffB);
    PG8_WAIT_V(6); PG8_BAR;
    for (;;) {
        const bool has_next = unit_next(g, ui + 1, nxt);
        const char* nA = has_next ? (const char*)g.A + (size_t)nxt.pm * 2 * hstepA + (size_t)((nxt.pn >> g.koff_shift) * g.koff_mul + nxt.k0) * 2 : cA;
        const char* nB = has_next ? (const char*)g.Bt + (size_t)nxt.pn * 2 * hstepB + (size_t)(nxt.k0 + ((nxt.pn >> 1) & 1) * g.kb_mul) * 2 : cB;
        const int nt = cur.nt;
        for (int t = 0; t < nt; t += 2) {
            const bool last = (t == nt - 2);
            const char* a1 = cA + (size_t)(t + 1) * kstep;
            const char* a2 = last ? nA : cA + (size_t)(t + 2) * kstep; const char* b2 = last ? nB : cB + (size_t)(t + 2) * kstep;
            const char* a3 = a2 + kstep; const char* b3 = b2 + kstep;
            if (last && pf_on && !has_next && !cur.split) {
                const int b_ = cur.pm / 17, tp_ = cur.pm - 17 * b_;
                const char* rbase = (const char*)((const bf16_t*)(p.ws + WS_RL) + (size_t)(b_ * SEQ + tp_ * 256 - CTXL) * DM + cur.pn * pf_w);
                const unsigned pvo = (unsigned)(TIDX() >> 1) * (unsigned)(DM * 2) + (unsigned)(TIDX() & 1) * (unsigned)pf_w;
                __builtin_amdgcn_global_load_lds((const unsigned*)(rbase + pvo), (LAS unsigned*)(lds + 139264 + wid * 256), 4, 0, 0);
                if (pf_w == 256) __builtin_amdgcn_global_load_lds((const unsigned*)(rbase + pvo + 128), (LAS unsigned*)(lds + 139264 + 2048 + wid * 256), 4, 0, 0);
            }
            PG8_LDB(B0, 0, 0); PG8_LDB(B1, 0, 1); PG8_SCHED; PG8_LDA(At, 0, 0); PG8_STAGE(PG8_SA(1, 1), a1 + hstepA, voffA);
            PG8_WAIT_V(8); PG8_WAIT_L(0); PG8_BAR; PG8_MMA(0, 0, At, B0); PG8_MMA(0, 1, At, B1); PG8_BAR; PG8_SCHED;
            PG8_LDA(At, 0, 1); PG8_STAGE(PG8_SB(0, 0), b2, voffB); PG8_STAGE(PG8_SB(0, 1), b2 + hstepB, voffB); PG8_STAGE(PG8_SA(0, 0), a2, voffA);
            PG8_WAIT_V(8); PG8_WAIT_L(0); PG8_BAR; PG8_MMA(1, 0, At, B0); PG8_MMA(1, 1, At, B1); PG8_BAR; PG8_SCHED;
            PG8_LDB(B0, 1, 0); PG8_LDB(B1, 1, 1); PG8_SCHED; PG8_LDA(At, 1, 0); PG8_STAGE(PG8_SA(0, 1), a2 + hstepA, voffA);
            PG8_WAIT_V(8); PG8_WAIT_L(0); PG8_BAR; PG8_MMA(0, 0, At, B0); PG8_MMA(0, 1, At, B1); PG8_BAR; PG8_SCHED;
            PG8_LDA(At, 1, 1); PG8_STAGE(PG8_SB(1, 0), b3, voffB); PG8_STAGE(PG8_SB(1, 1), b3 + hstepB, voffB); PG8_STAGE(PG8_SA(1, 0), a3, voffA);
            PG8_WAIT_V(8); PG8_WAIT_L(0); PG8_BAR; PG8_MMA(1, 0, At, B0); PG8_MMA(1, 1, At, B1); PG8_BAR; PG8_SCHED;
        }
        if (wr == 0) PG8_BAR;
        { int g2 = gid; asm volatile("" : "+s"(g2));
          const GemmD ge = make_gemm(p, g2, layer, dry); epilogue(p, ge, lds, acc, cur, wr, wc, fr, fq); }
        if (!has_next) break;
#pragma unroll
        for (int a = 0; a < 2; ++a)
#pragma unroll
            for (int b = 0; b < 2; ++b)
#pragma unroll
                for (int m = 0; m < 4; ++m)
#pragma unroll
                    for (int n = 0; n < 2; ++n) { const float z = ZF(); acc[a][b][m][n] = (f32x4){z, z, z, z}; }
        cur = nxt; cA = nA; cB = nB; ++ui;
        if (wr == 1) PG8_BAR;
    }
    PG8_WAIT_V(0);
    PG8_BAR;
#undef PG8_SA
#undef PG8_SB
#undef PG8_STAGE
#undef PG8_LDA
#undef PG8_LDB
#undef PG8_MMA
#undef PG8_WAIT_V
#undef PG8_WAIT_L
#undef PG8_BAR
#undef PG8_SCHED
}
#endif

DI void rope_cs(int pos, int k, float& cs, float& sn) { const float f = exp2f(-(float)k * (13.287712379549449f / 16.f)); sincosf((float)pos * f, &sn, &cs); }

DI void rope_table(const Params& p) {
    const int gt = BIDX() * NTHREADS + TIDX();
    if (gt < 64 * 16) { const int pos = gt >> 4, k = gt & 15; float cs, sn; rope_cs(pos, k, cs, sn); float* tb = (float*)(p.ws + WS_ROPE); tb[pos * 32 + k] = cs; tb[pos * 32 + 16 + k] = sn; }
}
DI float sum8(float v) { v += __shfl_xor(v, 1); v += __shfl_xor(v, 2); v += __shfl_xor(v, 4); return v; }
DI void mla_rowop_a3(const Params& p, int j) {
    const int lane = TIDX() & 63, gw = BIDX() * NWAVES + (TIDX() >> 6), nw = GDIM() * NWAVES;
    const float* dq = (const float*)(p.ws + WS_T + T_DQKV);
    bf16_t* cq = (bf16_t*)(p.ws + WS_T + T_CQ); bf16_t* ckv = (bf16_t*)(p.ws + WS_T + T_CKV); bf16_t* kr = (bf16_t*)(p.ws + WS_T + T_KR);
    const float* tb = (const float*)(p.ws + WS_ROPE);
    const float* gq = IN(p, 8) + j * 384; const float* gkv = IN(p, 11) + j * 256; const float* gkr = IN(p, 13) + j * 384 + 192 + 128;
    const bool isq1 = lane < 32, iskr = lane >= 32 && lane < 48;
    const f32x4 g0 = *(const f32x4*)(gq + 4 * lane);
    const f32x4 g1 = isq1 ? *(const f32x4*)(gq + 256 + 4 * lane) : *(const f32x4*)(gkv + 4 * (lane - 32));
    f32x4 g2 = {0.f, 0.f, 0.f, 0.f}; if (lane < 32) g2 = *(const f32x4*)(gkv + 128 + 4 * lane); else if (iskr) g2 = *(const f32x4*)(gkr + 4 * (lane - 32));
    for (int r0 = gw * 2; r0 < MROWS; r0 += nw * 2) {
        f32x4 v[2][3]; float s0[2], s1[2], s2[2];
#pragma unroll
        for (int rr = 0; rr < 2; ++rr) {
            const float* s = dq + (size_t)(r0 + rr) * 768 + 4 * lane;
            v[rr][0] = *(const f32x4*)s; v[rr][1] = *(const f32x4*)(s + 256); v[rr][2] = lane < 48 ? *(const f32x4*)(s + 512) : (f32x4){0.f, 0.f, 0.f, 0.f};
        }
#pragma unroll
        for (int rr = 0; rr < 2; ++rr) {
            const float q0 = v[rr][0][0] * v[rr][0][0] + v[rr][0][1] * v[rr][0][1] + v[rr][0][2] * v[rr][0][2] + v[rr][0][3] * v[rr][0][3];
            const float q1 = v[rr][1][0] * v[rr][1][0] + v[rr][1][1] * v[rr][1][1] + v[rr][1][2] * v[rr][1][2] + v[rr][1][3] * v[rr][1][3];
            const float q2 = v[rr][2][0] * v[rr][2][0] + v[rr][2][1] * v[rr][2][1] + v[rr][2][2] * v[rr][2][2] + v[rr][2][3] * v[rr][2][3];
            s0[rr] = q0 + (isq1 ? q1 : 0.f); s1[rr] = (isq1 ? 0.f : q1) + (lane < 32 ? q2 : 0.f); s2[rr] = iskr ? q2 : 0.f;
        }
#pragma unroll
        for (int o = 32; o; o >>= 1) {
#pragma unroll
            for (int rr = 0; rr < 2; ++rr) { s0[rr] += __shfl_xor(s0[rr], o); s1[rr] += __shfl_xor(s1[rr], o); s2[rr] += __shfl_xor(s2[rr], o); }
        }
#pragma unroll
        for (int rr = 0; rr < 2; ++rr) {
            const int row = r0 + rr, b = row / RPB, rb = row - b * RPB;
            const float i0 = rsqrtf(s0[rr] * (1.f / 384.f) + EPS), i1 = rsqrtf(s1[rr] * (1.f / 256.f) + EPS), i2 = rsqrtf(s2[rr] * (1.f / 64.f) + EPS);
            { const f32x4 o = v[rr][0] * i0 * g0; u32x2 w = {pk2(o[0], o[1]), pk2(o[2], o[3])}; *(u32x2*)(cq + (size_t)row * 384 + 4 * lane) = w; }
            if (isq1) { const f32x4 o = v[rr][1] * i0 * g1; u32x2 w = {pk2(o[0], o[1]), pk2(o[2], o[3])}; *(u32x2*)(cq + (size_t)row * 384 + 256 + 4 * lane) = w; }
            else { const f32x4 o = v[rr][1] * i1 * g1; u32x2 w = {pk2(o[0], o[1]), pk2(o[2], o[3])}; *(u32x2*)(ckv + (size_t)row * 256 + 4 * (lane - 32)) = w; }
            if (lane < 32) { const f32x4 o = v[rr][2] * i1 * g2; u32x2 w = {pk2(o[0], o[1]), pk2(o[2], o[3])}; *(u32x2*)(ckv + (size_t)row * 256 + 128 + 4 * lane) = w; }
            f32x4 x = v[rr][2] * i2 * g2;
            f32x4 xp; xp[0] = __shfl_xor(x[0], 4); xp[1] = __shfl_xor(x[1], 4); xp[2] = __shfl_xor(x[2], 4); xp[3] = __shfl_xor(x[3], 4);
            if (iskr) {
                if (rb >= CTXL) {
                    const int t = rb - CTXL, d0 = 4 * (lane - 32), q4 = d0 >> 4, k0 = d0 & 15, pos = q4 < 2 ? (t >> 6) : (t & 63);
                    const f32x4 cs = *(const f32x4*)(tb + pos * 32 + k0), sn = *(const f32x4*)(tb + pos * 32 + 16 + k0);
                    x = x * cs + ((q4 & 1) ? xp : -xp) * sn;
                }
                u32x2 w = {pk2(x[0], x[1]), pk2(x[2], x[3])}; *(u32x2*)(kr + (size_t)row * 64 + 4 * (lane - 32)) = w;
            }
        }
    }
}
DI void mla_rowop_a5(const Params& p, int j, bool latonly) {
    const int lane = TIDX() & 63, gw = BIDX() * NWAVES + (TIDX() >> 6), nw = GDIM() * NWAVES;
    const int hg = lane >> 3, l8 = lane & 7, q4 = l8 >> 1, k0 = 8 * (l8 & 1);
    bf16_t* qp = (bf16_t*)(p.ws + WS_T + T_QPRE); bf16_t* kv = (bf16_t*)(p.ws + WS_T + T_KVPRE);
    const float* tb = (const float*)(p.ws + WS_ROPE);
    const float* gqk = IN(p, 13) + j * 384;
    f32x4 gqn[4], gqr[2], gkn[4];
#pragma unroll
    for (int i = 0; i < 4; ++i) { gqn[i] = *(const f32x4*)(gqk + 16 * l8 + 4 * i); gkn[i] = *(const f32x4*)(gqk + 192 + 16 * l8 + 4 * i); }
    gqr[0] = *(const f32x4*)(gqk + 128 + 8 * l8); gqr[1] = *(const f32x4*)(gqk + 128 + 8 * l8 + 4);
    for (int r0 = gw * 2; r0 < MROWS; r0 += nw * 2) {
        const int b = r0 / RPB, rb0 = r0 - b * RPB; const bool isctx = rb0 < CTXL;
        const bool doq = !(latonly && isctx);
        u32x4 qn[2][2], qrp[2], kn[2][2];
#pragma unroll
        for (int rr = 0; rr < 2; ++rr) {
            const bf16_t* qr = qp + (size_t)(r0 + rr) * 1536 + hg * 192; const bf16_t* kr_ = kv + (size_t)(r0 + rr) * 2048 + hg * 256 + 16 * l8;
            if (doq) { qn[rr][0] = *(const u32x4*)(qr + 16 * l8); qn[rr][1] = *(const u32x4*)(qr + 16 * l8 + 8); qrp[rr] = *(const u32x4*)(qr + 128 + 8 * l8); }
            else { qn[rr][0] = qn[rr][1] = qrp[rr] = (u32x4){0, 0, 0, 0}; }
            kn[rr][0] = *(const u32x4*)kr_; kn[rr][1] = *(const u32x4*)(kr_ + 8);
        }
#pragma unroll
        for (int rr = 0; rr < 2; ++rr) {
            const int row = r0 + rr;
            float a[16], r[8], k[16];
#pragma unroll
            for (int i = 0; i < 4; ++i) { a[2 * i] = bflo(qn[rr][0][i]); a[2 * i + 1] = bfhi(qn[rr][0][i]); a[8 + 2 * i] = bflo(qn[rr][1][i]); a[8 + 2 * i + 1] = bfhi(qn[rr][1][i]);
                r[2 * i] = bflo(qrp[rr][i]); r[2 * i + 1] = bfhi(qrp[rr][i]);
                k[2 * i] = bflo(kn[rr][0][i]); k[2 * i + 1] = bfhi(kn[rr][0][i]); k[8 + 2 * i] = bflo(kn[rr][1][i]); k[8 + 2 * i + 1] = bfhi(kn[rr][1][i]); }
            float sa = 0.f, sr = 0.f, sk = 0.f;
#pragma unroll
            for (int i = 0; i < 16; ++i) { sa += a[i] * a[i]; sk += k[i] * k[i]; }
#pragma unroll
            for (int i = 0; i < 8; ++i) sr += r[i] * r[i];
            sa = sum8(sa); sr = sum8(sr); sk = sum8(sk);
            const float ia = rsqrtf(sa * (1.f / 128.f) + EPS) * QSCALE, ir = rsqrtf(sr * (1.f / 64.f) + EPS), ik = rsqrtf(sk * (1.f / 128.f) + EPS);
            if (doq) {
                bf16_t* qr = qp + (size_t)row * 1536 + hg * 192;
                u32x4 w0, w1;
#pragma unroll
                for (int i = 0; i < 4; ++i) { w0[i] = pk2(a[2 * i] * ia * gqn[i >> 1][(2 * i) & 3], a[2 * i + 1] * ia * gqn[i >> 1][(2 * i + 1) & 3]);
                    w1[i] = pk2(a[8 + 2 * i] * ia * gqn[2 + (i >> 1)][(2 * i) & 3], a[8 + 2 * i + 1] * ia * gqn[2 + (i >> 1)][(2 * i + 1) & 3]); }
                *(u32x4*)(qr + 16 * l8) = w0; *(u32x4*)(qr + 16 * l8 + 8) = w1;
                float x[8];
#pragma unroll
                for (int i = 0; i < 8; ++i) x[i] = r[i] * ir * gqr[i >> 2][i & 3];
                if (!isctx) {
                    const int t = rb0 + rr - CTXL, pos = q4 < 2 ? (t >> 6) : (t & 63);
                    const f32x4 c0 = *(const f32x4*)(tb + pos * 32 + k0), c1 = *(const f32x4*)(tb + pos * 32 + k0 + 4), s0 = *(const f32x4*)(tb + pos * 32 + 16 + k0), s1 = *(const f32x4*)(tb + pos * 32 + 16 + k0 + 4);
#pragma unroll
                    for (int i = 0; i < 8; ++i) { const float xp = __shfl_xor(x[i], 2); const float cs = i < 4 ? c0[i & 3] : c1[i & 3], sn = i < 4 ? s0[i & 3] : s1[i & 3];
                        x[i] = x[i] * cs + ((q4 & 1) ? xp : -xp) * sn; }
                }
                u32x4 wr_;
#pragma unroll
                for (int i = 0; i < 4; ++i) wr_[i] = pk2(x[2 * i] * QSCALE, x[2 * i + 1] * QSCALE);
                *(u32x4*)(qr + 128 + 8 * l8) = wr_;
            }
            bf16_t* kr_ = kv + (size_t)row * 2048 + hg * 256 + 16 * l8;
            u32x4 k0w, k1w;
#pragma unroll
            for (int i = 0; i < 4; ++i) { k0w[i] = pk2(k[2 * i] * ik * gkn[i >> 1][(2 * i) & 3], k[2 * i + 1] * ik * gkn[i >> 1][(2 * i + 1) & 3]);
                k1w[i] = pk2(k[8 + 2 * i] * ik * gkn[2 + (i >> 1)][(2 * i) & 3], k[8 + 2 * i + 1] * ik * gkn[2 + (i >> 1)][(2 * i + 1) & 3]); }
            *(u32x4*)kr_ = k0w; *(u32x4*)(kr_ + 8) = k1w;
        }
    }
}

namespace attn {
constexpr int LDQ = 1536, LDKN = 2048, LDKR = 64, LDO = 1024, KVBLK = 64;
constexpr int SHM_V = KVBLK * 128 * 2, SHM_KN = KVBLK * 128 * 2, SHM_KR = KVBLK * 64 * 2;
constexpr int OFF_V = 0, OFF_KN = 2 * SHM_V, OFF_KR = OFF_KN + 2 * SHM_KN, OFF_WS = OFF_KR + 2 * SHM_KR, OFF_QR = OFF_WS + NWAVES * 64 * 4, LDS_BYTES = OFF_QR + NWAVES * 4096;
constexpr float THRL = 8.f * 1.4426950408889634f;
#define KSWZ(row, colB) ((row) * 256 + ((colB) ^ (((row) & 7) << 4)))
#define RSWZ(row, colB) ((row) * 128 + ((colB) ^ ((((row) >> 1) & 7) << 4)))
#define SBAR() __builtin_amdgcn_sched_barrier(0)
DI int crow(int r, int hi) { return (r & 3) + 8 * (r >> 2) + 4 * hi; }
DI unsigned cvtpk(float lo, float hi) { unsigned r; asm volatile("v_cvt_pk_bf16_f32 %0, %1, %2" : "=v"(r) : "v"(lo), "v"(hi)); return r; }

DI void partialSM(f32x16& p0, f32x16& p1, float& m_reg, float& mn, float& alpha) {
    float pmax = p0[0];
#pragma unroll
    for (int r = 1; r < 16; ++r) pmax = fmaxf(pmax, p0[r]);
#pragma unroll
    for (int r = 0; r < 16; ++r) pmax = fmaxf(pmax, p1[r]);
    { auto rr = __builtin_amdgcn_permlane32_swap(__float_as_uint(pmax), __float_as_uint(pmax), false, false);
      pmax = fmaxf(__uint_as_float(rr[0]), __uint_as_float(rr[1])); }
    if (__builtin_expect(__all(pmax - m_reg <= THRL), 1)) { mn = m_reg; alpha = 1.f; }
    else { mn = fmaxf(m_reg, pmax); alpha = __builtin_amdgcn_exp2f(m_reg - mn); m_reg = mn; }
#pragma unroll
    for (int r = 0; r < 16; ++r) p0[r] = p0[r] - mn;
#pragma unroll
    for (int r = 0; r < 16; ++r) p1[r] = p1[r] - mn;
#pragma unroll
    for (int r = 0; r < 16; ++r) p0[r] = __builtin_amdgcn_exp2f(p0[r]);
}
DI void finishSM(f32x16& p0, f32x16& p1, float alpha, float& l_reg, bf16x8& pa0, bf16x8& pa1, bf16x8& pa2, bf16x8& pa3) {
#pragma unroll
    for (int r = 0; r < 16; ++r) p1[r] = __builtin_amdgcn_exp2f(p1[r]);
    float ps = 0;
#pragma unroll
    for (int r = 0; r < 16; ++r) ps += p0[r];
#pragma unroll
    for (int r = 0; r < 16; ++r) ps += p1[r];
    { auto rr = __builtin_amdgcn_permlane32_swap(__float_as_uint(ps), __float_as_uint(ps), false, false);
      ps = __uint_as_float(rr[0]) + __uint_as_float(rr[1]); }
    l_reg = l_reg * alpha + ps;
#define PK4(P, BASE, OUT) do { unsigned a0 = cvtpk(P[BASE + 0], P[BASE + 1]), a1 = cvtpk(P[BASE + 2], P[BASE + 3]);   \
    unsigned b0 = cvtpk(P[BASE + 4], P[BASE + 5]), b1 = cvtpk(P[BASE + 6], P[BASE + 7]);                              \
    auto r0 = __builtin_amdgcn_permlane32_swap(a0, b0, false, false); auto r1 = __builtin_amdgcn_permlane32_swap(a1, b1, false, false); \
    u32x4 w = {r0[0], r1[0], r0[1], r1[1]}; OUT = *reinterpret_cast<bf16x8*>(&w); } while (0)
    PK4(p0, 0, pa0); PK4(p0, 8, pa1); PK4(p1, 0, pa2); PK4(p1, 8, pa3);
#undef PK4
}
DI void qkt(f32x16& p0, f32x16& p1, const char* Kn, const char* Kr, const bf16x8* qr, const char* qrl, int r32, int hi) {
    p0 = f32x16{}; p1 = f32x16{};
#pragma unroll
    for (int d0 = 0; d0 < 8; ++d0) { const int cb = (d0 * 16 + hi * 8) * 2;
        const bf16x8 b0 = *reinterpret_cast<const bf16x8*>(Kn + KSWZ(r32, cb));
        const bf16x8 b1 = *reinterpret_cast<const bf16x8*>(Kn + KSWZ(32 + r32, cb));
        p0 = __builtin_amdgcn_mfma_f32_32x32x16_bf16(b0, qr[d0], p0, 0, 0, 0);
        p1 = __builtin_amdgcn_mfma_f32_32x32x16_bf16(b1, qr[d0], p1, 0, 0, 0); }
#pragma unroll
    for (int d0 = 0; d0 < 4; ++d0) { const int cb = (d0 * 16 + hi * 8) * 2;
        const bf16x8 b0 = *reinterpret_cast<const bf16x8*>(Kr + RSWZ(r32, cb));
        const bf16x8 b1 = *reinterpret_cast<const bf16x8*>(Kr + RSWZ(32 + r32, cb));
        const bf16x8 qf = *reinterpret_cast<const bf16x8*>(qrl + d0 * 1024);
        p0 = __builtin_amdgcn_mfma_f32_32x32x16_bf16(b0, qf, p0, 0, 0, 0);
        p1 = __builtin_amdgcn_mfma_f32_32x32x16_bf16(b1, qf, p1, 0, 0, 0); }
}
DI int v_st(int k, int c) { const int kk = (k & ~0xC) | ((k & 4) << 1) | ((k & 8) >> 1); return ((kk >> 3) * 4 + (c >> 5)) * 512 + ((kk & 7) * 32 + (c & 31)) * 2; }
DI int v_rd_base(int lane) { return ((lane & 3) << 3) | (((lane >> 2) & 3) << 6) | (((lane >> 4) & 1) << 5) | (((lane >> 5) & 1) << 8); }
constexpr int v_rd_off(int d0, int ks, int half) { return d0 * 512 + ks * 4096 + half * 2048; }
template <int OFF> DI s16x4 tr_read(int vb) { s16x4 r; asm volatile("ds_read_b64_tr_b16 %0, %1 offset:%2" : "=&v"(r) : "v"(vb), "i"(OFF) : "memory"); return r; }
template <int D0> DI void pv_one(f32x16& od, int vb, bf16x8 pa0, bf16x8 pa1, bf16x8 pa2, bf16x8 pa3) {
    const s16x4 l0 = tr_read<v_rd_off(D0, 0, 0)>(vb), h0 = tr_read<v_rd_off(D0, 0, 1)>(vb), l1 = tr_read<v_rd_off(D0, 1, 0)>(vb), h1 = tr_read<v_rd_off(D0, 1, 1)>(vb);
    const s16x4 l2 = tr_read<v_rd_off(D0, 2, 0)>(vb), h2 = tr_read<v_rd_off(D0, 2, 1)>(vb), l3 = tr_read<v_rd_off(D0, 3, 0)>(vb), h3 = tr_read<v_rd_off(D0, 3, 1)>(vb);
    asm volatile("s_waitcnt lgkmcnt(0)" ::: "memory"); SBAR();
#define PK(L, H) (bf16x8){L[0], L[1], L[2], L[3], H[0], H[1], H[2], H[3]}
    od = __builtin_amdgcn_mfma_f32_32x32x16_bf16(pa0, PK(l0, h0), od, 0, 0, 0);
    od = __builtin_amdgcn_mfma_f32_32x32x16_bf16(pa1, PK(l1, h1), od, 0, 0, 0);
    od = __builtin_amdgcn_mfma_f32_32x32x16_bf16(pa2, PK(l2, h2), od, 0, 0, 0);
    od = __builtin_amdgcn_mfma_f32_32x32x16_bf16(pa3, PK(l3, h3), od, 0, 0, 0);
#undef PK
}
DI void pv_d0(f32x16* o, int vb, bf16x8 pa0, bf16x8 pa1, bf16x8 pa2, bf16x8 pa3) {
    pv_one<0>(o[0], vb, pa0, pa1, pa2, pa3); pv_one<1>(o[1], vb, pa0, pa1, pa2, pa3); pv_one<2>(o[2], vb, pa0, pa1, pa2, pa3); pv_one<3>(o[3], vb, pa0, pa1, pa2, pa3);
}
DI void attn_unit(const bf16_t* __restrict__ Qb, const bf16_t* __restrict__ Knb, const bf16_t* __restrict__ Krb, const bf16_t* __restrict__ Vb, bf16_t* __restrict__ Ob, int seq, char* lds) {
    const int tid = TIDX(), wid = tid >> 6, lane = tid & 63, r32 = lane & 31, hi = lane >> 5;
    char* V_lds = lds + OFF_V; char* Kn_lds = lds + OFF_KN; char* Kr_lds = lds + OFF_KR;
    float* ws = (float*)(lds + OFF_WS) + wid * 64; float* li_l = ws; float* al_l = ws + 32;
    float m_reg = -1e30f, l_reg = 0; f32x16 o[4] = {}; bf16x8 qr[8];
    const bf16_t* Qw = Qb + (long)(wid * 32 + r32) * LDQ + hi * 8;
    char* qrl = lds + OFF_QR + wid * 4096 + lane * 16;
#pragma unroll
    for (int d0 = 0; d0 < 8; ++d0) qr[d0] = *reinterpret_cast<const bf16x8*>(Qw + d0 * 16);
#pragma unroll
    for (int d0 = 0; d0 < 4; ++d0) *reinterpret_cast<bf16x8*>(qrl + d0 * 1024) = *reinterpret_cast<const bf16x8*>(Qw + 128 + d0 * 16);
    const int sr = tid >> 4, sc = (tid & 15) * 8, vst0 = v_st(sr, sc), vst1 = v_st(32 + sr, sc);
    const int rr_ = tid >> 3, rc_ = (tid & 7) * 8;
    const int vb0 = (int)(uintptr_t)V_lds + v_rd_base(lane);
    struct { bf16x8 vs0, vs1, ks0, ks1, kr; } sr_[1];
#define SLOAD(i, k0) do { sr_[i].vs0 = *(const bf16x8*)(&Vb[(long)((k0) + sr) * LDKN + sc]); sr_[i].vs1 = *(const bf16x8*)(&Vb[(long)((k0) + 32 + sr) * LDKN + sc]); \
    sr_[i].ks0 = *(const bf16x8*)(&Knb[(long)((k0) + sr) * LDKN + sc]); sr_[i].ks1 = *(const bf16x8*)(&Knb[(long)((k0) + 32 + sr) * LDKN + sc]); \
    sr_[i].kr = *(const bf16x8*)(&Krb[(long)((k0) + rr_) * LDKR + rc_]); } while (0)
#define SWRITE(b, i) do { *(bf16x8*)(V_lds + (b) * SHM_V + vst0) = sr_[i].vs0; *(bf16x8*)(V_lds + (b) * SHM_V + vst1) = sr_[i].vs1; const int kc = sc * 2; \
    *(bf16x8*)(Kn_lds + (b) * SHM_KN + KSWZ(sr, kc)) = sr_[i].ks0; *(bf16x8*)(Kn_lds + (b) * SHM_KN + KSWZ(32 + sr, kc)) = sr_[i].ks1; \
    *(bf16x8*)(Kr_lds + (b) * SHM_KR + RSWZ(rr_, rc_ * 2)) = sr_[i].kr; } while (0)
#define SWAIT() asm volatile("s_waitcnt vmcnt(0)" ::: "memory")
#define RESC(a) do { if (__any((a) < 1.f)) { if (hi == 0) al_l[r32] = (a); asm volatile("s_waitcnt lgkmcnt(0)" ::: "memory"); \
    _Pragma("unroll") for (int d = 0; d < 4; ++d) _Pragma("unroll") for (int r = 0; r < 16; ++r) o[d][r] *= al_l[crow(r, hi)]; } } while (0)
    f32x16 pA0, pA1, pB0, pB1; float mnA, mnB, alA, alB; bf16x8 pa0, pa1, pa2, pa3; const int NT = seq / KVBLK;
    constexpr int SE = 0, SO = 0;
    SLOAD(SE, 0); asm volatile("s_waitcnt vmcnt(0)" ::: "memory"); SWRITE(0, SE); __syncthreads();
    qkt(pA0, pA1, Kn_lds, Kr_lds, qr, qrl, r32, hi); partialSM(pA0, pA1, m_reg, mnA, alA);
    SLOAD(SO, KVBLK);
    SWAIT(); SWRITE(1, SO); __syncthreads();
    for (int j = 1; j + 1 < NT; j += 2) {
        SBAR(); qkt(pB0, pB1, Kn_lds + SHM_KN, Kr_lds + SHM_KR, qr, qrl, r32, hi);
        finishSM(pA0, pA1, alA, l_reg, pa0, pa1, pa2, pa3); SBAR();
        SLOAD(SE, (j + 1) * KVBLK); SBAR();
        pv_d0(o, vb0, pa0, pa1, pa2, pa3); partialSM(pB0, pB1, m_reg, mnB, alB);
        __syncthreads(); SWAIT(); SWRITE(0, SE);
        RESC(alB); __syncthreads();
        SBAR(); qkt(pA0, pA1, Kn_lds, Kr_lds, qr, qrl, r32, hi);
        finishSM(pB0, pB1, alB, l_reg, pa0, pa1, pa2, pa3); SBAR();
        SLOAD(SO, (j + 2) * KVBLK); SBAR();
        pv_d0(o, vb0 + SHM_V, pa0, pa1, pa2, pa3); partialSM(pA0, pA1, m_reg, mnA, alA);
        __syncthreads(); SWAIT(); SWRITE(1, SO);
        RESC(alA); __syncthreads();
    }
    SBAR(); qkt(pB0, pB1, Kn_lds + SHM_KN, Kr_lds + SHM_KR, qr, qrl, r32, hi);
    finishSM(pA0, pA1, alA, l_reg, pa0, pa1, pa2, pa3); SBAR();
    pv_d0(o, vb0, pa0, pa1, pa2, pa3); partialSM(pB0, pB1, m_reg, mnB, alB);
    __syncthreads(); RESC(alB);
    finishSM(pB0, pB1, alB, l_reg, pa0, pa1, pa2, pa3); SBAR();
    pv_d0(o, vb0 + SHM_V, pa0, pa1, pa2, pa3);
    if (hi == 0) li_l[r32] = l_reg; asm volatile("s_waitcnt lgkmcnt(0)" ::: "memory");
    float rli[16];
#pragma unroll
    for (int r = 0; r < 16; ++r) rli[r] = __builtin_amdgcn_rcpf(li_l[crow(r, hi)]);
    bf16_t* Ow = Ob + (long)(wid * 32) * LDO;
#pragma unroll
    for (int r = 0; r < 16; ++r) { const int orow = crow(r, hi);
#pragma unroll
        for (int d0 = 0; d0 < 4; ++d0) Ow[(long)orow * LDO + d0 * 32 + r32] = (bf16_t)f2bf(o[d0][r] * rli[r]); }
    __syncthreads();
#undef SLOAD
#undef SWRITE
#undef SWAIT
#undef RESC
}
}
DI void attn_phase(const Params& p, bool need_ctx, char* lds) {
    const bf16_t* qp = (const bf16_t*)(p.ws + WS_T + T_QPRE); const bf16_t* kv = (const bf16_t*)(p.ws + WS_T + T_KVPRE); const bf16_t* kr = (const bf16_t*)(p.ws + WS_T + T_KR);
    bf16_t* O = hbuf(p);
    const int G = GDIM(), bx = BIDX(), vcu = (G % 8 == 0) ? (bx % 8) * (G / 8) + bx / 8 : bx;
    const int nun = 512 + (need_ctx ? 32 : 0);
    for (int u = vcu; u < nun; u += G) {
        int b, h, qrow0, nkeys;
        if (u < 512) { const int bh = u >> 4, qb = u & 15; b = bh >> 3; h = bh & 7; qrow0 = b * RPB + CTXL + qb * 256; nkeys = RPB; }
        else { const int bh = u - 512; b = bh >> 3; h = bh & 7; qrow0 = b * RPB; nkeys = CTXL; }
        const size_t krow0 = (size_t)b * RPB;
        attn::attn_unit(qp + (size_t)qrow0 * 1536 + h * 192, kv + krow0 * 2048 + h * 256, kr + krow0 * 64, kv + krow0 * 2048 + h * 256 + 128,
                        O + (size_t)qrow0 * 1024 + h * 128, nkeys, lds);
    }
}

constexpr size_t S5_ABAR = 0, S5_A128 = 65536, S5_BFRAG = 131072, S5_CFRAG = 131072 + 1048576;
constexpr int S5_CH = 128, S5_NCH = RPB / S5_CH;
DI f32x2 cmul(f32x2 a, f32x2 b) { return (f32x2){a.x * b.x - a.y * b.y, a.x * b.y + a.y * b.x}; }
DI void s5_prep(const Params& p) {
    const int gt = BIDX() * NTHREADS + TIDX(), ntot = GDIM() * NTHREADS;
    unsigned char* base = p.ws + WS_S5C;
    for (int idx = gt; idx < 2 * 64 * 64; idx += ntot) {
        const int dir = idx >> 12, g = (idx >> 6) & 63, s = idx & 63;
        const float are = IN(p, 15)[idx], aim = IN(p, 16)[idx], dt = expf(IN(p, 17)[dir * 64 + g]);
        float sn, cs; sincosf(aim * dt, &sn, &cs); const float er = expf(are * dt);
        const f32x2 ab = {er * cs, er * sn};
        sincosf(aim * dt * (float)S5_CH, &sn, &cs); const float er2 = expf(are * dt * (float)S5_CH);
        ((f32x2*)(base + S5_ABAR))[idx] = ab; ((f32x2*)(base + S5_A128))[idx] = (f32x2){er2 * cs, er2 * sn};
    }
    for (int idx = gt; idx < 2 * 64 * 8 * 64; idx += ntot) {
        const int lane = idx & 63, blk = (idx >> 6) & 7, g = (idx >> 9) & 63, dir = idx >> 15;
        const int kp = 16 * blk + (lane & 15), q = lane >> 4, s = kp >> 1;
        u32x4 w = {0, 0, 0, 0};
        if (q < 2) {
            const int ai = (dir * 64 + g) * 64 + s;
            const float are = IN(p, 15)[ai], aim = IN(p, 16)[ai], dt = expf(IN(p, 17)[dir * 64 + g]);
            float sn, cs; sincosf(aim * dt, &sn, &cs); const float er = expf(are * dt);
            const f32x2 num = {er * cs - 1.f, er * sn}; const float den = are * are + aim * aim;
            const f32x2 coef = {(num.x * are + num.y * aim) / den, (num.y * are - num.x * aim) / den};
            float vals[8];
#pragma unroll
            for (int jj = 0; jj < 8; ++jj) { const int i = 8 * q + jj; const size_t bi = ((size_t)(dir * 64 + g) * 64 + s) * 16 + i;
                const f32x2 bb = cmul(coef, (f32x2){IN(p, 18)[bi], IN(p, 19)[bi]}); vals[jj] = (kp & 1) == 0 ? bb.x : bb.y; }
            w = (u32x4){pk2(vals[0], vals[1]), pk2(vals[2], vals[3]), pk2(vals[4], vals[5]), pk2(vals[6], vals[7])};
        }
        ((u32x4*)(base + S5_BFRAG))[idx] = w;
    }
    for (int idx = gt; idx < 2 * 64 * 4 * 64; idx += ntot) {
        const int lane = idx & 63, ks = (idx >> 6) & 3, g = (idx >> 8) & 63, dir = idx >> 14;
        const int i = lane & 15, q = lane >> 4; float vals[8];
#pragma unroll
        for (int jj = 0; jj < 8; ++jj) { const int kp = 32 * ks + 8 * q + jj, s = kp >> 1; const size_t ci = ((size_t)(dir * 64 + g) * 16 + i) * 64 + s;
            vals[jj] = (kp & 1) == 0 ? IN(p, 20)[ci] : -IN(p, 21)[ci]; }
        ((u32x4*)(base + S5_CFRAG))[idx] = (u32x4){pk2(vals[0], vals[1]), pk2(vals[2], vals[3]), pk2(vals[4], vals[5]), pk2(vals[6], vals[7])};
    }
}
constexpr int S5_L1S = 132, S5_L2S = 136, S5_WLDS = 12800;
template <bool PROJ, bool REV>
DI void s5_sub(const bf16x8 uf, const bf16x8 (&bf)[8], const bf16x8 (&cf)[4], f32x2 ab, f32x2& st, f32x4& yacc, char* wl, int lane) {
    float* L1 = (float*)wl; bf16_t* L2 = (bf16_t*)(wl + 8448);
    const int t = lane & 15, q = lane >> 4;
    const float zf = ZF(); const f32x4 zero4 = {zf, zf, zf, zf};
    LDS_FENCE();
#pragma unroll
    for (int blk = 0; blk < 8; ++blk) {
        const f32x4 d = __builtin_amdgcn_mfma_f32_16x16x32_bf16(bf[blk], uf, zero4, 0, 0, 0);
        *(f32x4*)(L1 + t * S5_L1S + 16 * blk + 4 * q) = d;
    }
    LDS_FENCE();
    f32x2 bu[16];
#pragma unroll
    for (int s = 0; s < 16; ++s) bu[s] = *(const f32x2*)(L1 + s * S5_L1S + 2 * lane);
#pragma unroll
    for (int s = 0; s < 16; ++s) {
        const int tt = REV ? 15 - s : s;
        const f32x2 b_ = bu[tt];
        const f32x2 n = {ab.x * st.x - ab.y * st.y + b_.x, ab.x * st.y + ab.y * st.x + b_.y};
        st = n;
        if (PROJ) ((unsigned*)L2)[tt * (S5_L2S / 2) + lane] = pk2(n.x, n.y);
    }
    if (PROJ) {
        LDS_FENCE();
#pragma unroll
        for (int ks = 0; ks < 4; ++ks) {
            const bf16x8 sf = *(const bf16x8*)(L2 + t * S5_L2S + 32 * ks + 8 * q);
            yacc = __builtin_amdgcn_mfma_f32_16x16x32_bf16(sf, cf[ks], yacc, 0, 0, 0);
        }
    }
}
DI void s5_load_frags(const Params& p, int dir, int g, int lane, bf16x8 (&bf)[8], bf16x8 (&cf)[4], f32x2& ab, f32x2& a128) {
    const unsigned char* base = p.ws + WS_S5C;
#pragma unroll
    for (int blk = 0; blk < 8; ++blk) bf[blk] = ((const bf16x8*)(base + S5_BFRAG))[((dir * 64 + g) * 8 + blk) * 64 + lane];
#pragma unroll
    for (int ks = 0; ks < 4; ++ks) cf[ks] = ((const bf16x8*)(base + S5_CFRAG))[((dir * 64 + g) * 4 + ks) * 64 + lane];
    ab = ((const f32x2*)(base + S5_ABAR))[(dir * 64 + g) * 64 + lane]; a128 = ((const f32x2*)(base + S5_A128))[(dir * 64 + g) * 64 + lane];
}
DI void s5_load_u(const bf16_t* h, int row0, int g, int lane, bf16x8 (&uf)[8]) {
    const int t = lane & 15, q = lane >> 4;
#pragma unroll
    for (int sb = 0; sb < 8; ++sb) { uf[sb] = (bf16x8){0, 0, 0, 0, 0, 0, 0, 0}; if (q < 2) uf[sb] = *(const bf16x8*)(h + (size_t)(row0 + 16 * sb + t) * DM + 16 * g + 8 * q); }
}
DI void s5_pass1(const Params& p, char* lds) {
    const int lane = TIDX() & 63, wave = TIDX() >> 6, gw = BIDX() * NWAVES + wave, nw = GDIM() * NWAVES;
    char* wl = lds + wave * S5_WLDS;
    const bf16_t* h = hbuf(p);
    f32x2* E = (f32x2*)(p.ws + WS_T + T_S5E);
    for (int task = gw; task < NB * S5_NCH * 64; task += nw) {
        const int g = task & 63, bc = task >> 6, c = bc % S5_NCH, b = bc / S5_NCH;
        const int row0 = b * RPB + c * S5_CH;
        bf16x8 uf[8]; s5_load_u(h, row0, g, lane, uf);
        for (int dir = 0; dir < 2; ++dir) {
            bf16x8 bf[8], cf[4]; f32x2 ab, a128; s5_load_frags(p, dir, g, lane, bf, cf, ab, a128);
            f32x2 st = {0.f, 0.f}; f32x4 dummy = {0, 0, 0, 0};
            if (dir == 0) {
#pragma unroll
                for (int sb = 0; sb < 8; ++sb) s5_sub<false, false>(uf[sb], bf, cf, ab, st, dummy, wl, lane);
            } else {
#pragma unroll
                for (int sb = 0; sb < 8; ++sb) s5_sub<false, true>(uf[7 - sb], bf, cf, ab, st, dummy, wl, lane);
            }
            E[(((size_t)(b * 64 + g) * 2 + dir) * S5_NCH + c) * 64 + lane] = st;
        }
    }
}
template <int DIR> DI void s5_chain(const f32x2* Eb, f32x2* Sb, f32x2 a128) {
    f32x2 e[S5_NCH];
#pragma unroll
    for (int k = 0; k < S5_NCH; ++k) e[k] = Eb[k * 64];
    float zz = 0.f; asm volatile("" : "+v"(zz));
    f32x2 st = {zz, zz};
#pragma unroll
    for (int k = 0; k < S5_NCH; ++k) {
        const int c = DIR == 0 ? k : (k < 2 ? 1 - k : S5_NCH + 1 - k);
        Sb[c * 64] = st;
        st = cmul(a128, st); st.x += e[c].x; st.y += e[c].y;
    }
}
DI void s5_carry(const Params& p) {
    const int lane = TIDX() & 63, gw = BIDX() * NWAVES + (TIDX() >> 6), nw = GDIM() * NWAVES;
    for (int w = gw; w < NB * 64 * 2; w += nw) {
        const int dir = w & 1, g = (w >> 1) & 63;
        const f32x2 a128 = ((const f32x2*)(p.ws + WS_S5C + S5_A128))[(dir * 64 + g) * 64 + lane];
        const f32x2* Eb = (const f32x2*)(p.ws + WS_T + T_S5E) + (size_t)w * S5_NCH * 64 + lane;
        f32x2* Sb = (f32x2*)(p.ws + WS_T + T_S5S) + (size_t)w * S5_NCH * 64 + lane;
        if (dir == 0) s5_chain<0>(Eb, Sb, a128); else s5_chain<1>(Eb, Sb, a128);
    }
}
DI void s5_pass3(const Params& p, int j, bool latonly, char* lds) {
    const int lane = TIDX() & 63, wave = TIDX() >> 6, gw = BIDX() * NWAVES + wave, nw = GDIM() * NWAVES;
    char* wl = lds + wave * S5_WLDS;
    const bf16_t* h = hbuf(p);
    const f32x2* S = (const f32x2*)(p.ws + WS_T + T_S5S);
    bf16_t* z = (bf16_t*)(p.ws + WS_T + T_Z);
    const float* dd = IN(p, 22) + j * 1024;
    for (int task = gw; task < NB * S5_NCH * 64; task += nw) {
        const int g = task & 63, bc = task >> 6, c = bc % S5_NCH, b = bc / S5_NCH;
        if (latonly && c < 2) continue;
        const int row0 = b * RPB + c * S5_CH;
        bf16x8 uf[8]; s5_load_u(h, row0, g, lane, uf);
        f32x4 yacc[8];
#pragma unroll
        for (int i = 0; i < 8; ++i) { const float z = ZF(); yacc[i] = (f32x4){z, z, z, z}; }
        for (int dir = 0; dir < 2; ++dir) {
            bf16x8 bf[8], cf[4]; f32x2 ab, a128; s5_load_frags(p, dir, g, lane, bf, cf, ab, a128);
            f32x2 st = S[(((size_t)(b * 64 + g) * 2 + dir) * S5_NCH + c) * 64 + lane];
            if (dir == 0) {
#pragma unroll
                for (int sb = 0; sb < 8; ++sb) s5_sub<true, false>(uf[sb], bf, cf, ab, st, yacc[sb], wl, lane);
            } else {
#pragma unroll
                for (int sb = 0; sb < 8; ++sb) s5_sub<true, true>(uf[7 - sb], bf, cf, ab, st, yacc[7 - sb], wl, lane);
            }
        }
        const int i = lane & 15, q = lane >> 4; const float dv = dd[16 * g + i];
#pragma unroll
        for (int sb = 0; sb < 8; ++sb)
#pragma unroll
            for (int r = 0; r < 4; ++r) {
                const size_t off = (size_t)(row0 + 16 * sb + 4 * q + r) * DM + 16 * g + i;
                const float y = bf2f(h[off]) * dv + yacc[sb][r];
                z[off] = (bf16_t)f2bf(gelu_tanh(y));
            }
    }
}


#ifndef S5_PROBE
#define S5_PROBE 0
#endif
#ifndef S5_REPS
#define S5_REPS 1
#endif
namespace s5v2 {
constexpr size_t C_APOW = 0, C_A128 = 589824, C_COEF = C_A128 + 65536;
constexpr size_t T_XS = 40 * MiB;
constexpr int L_WE = 0, L_CA = 0, L_TEND = 69632, L_CARRY = 69632  , L_BBAR = 69632  , L_KP = 104448, L_PW = 120832, L_APOW = 137216, L_C = 146432, RS = 136;
DI f32x2 cexp_(float re, float im) { float sn, cs; sincosf(im, &sn, &cs); const float e = expf(re); return (f32x2){e * cs, e * sn}; }
DI void prep(const Params& p) {
    const int gt = BIDX() * NTHREADS + TIDX(), ntot = GDIM() * NTHREADS;
    unsigned char* base = p.ws + WS_S5C;
    for (int idx = gt; idx < 2 * 64 * 64; idx += ntot) {
        const int dg = idx >> 6, s = idx & 63;
        const float are = IN(p, 15)[idx], aim = IN(p, 16)[idx], dt = expf(IN(p, 17)[dg]);
        for (int e = 0; e < 9; ++e) ((f32x2*)(base + C_APOW))[(dg * 9 + e) * 64 + s] = cexp_(are * dt * (float)e, aim * dt * (float)e);
        ((f32x2*)(base + C_A128))[idx] = cexp_(are * dt * 128.f, aim * dt * 128.f);
        const f32x2 ab = cexp_(are * dt, aim * dt); const f32x2 num = {ab.x - 1.f, ab.y}; const float den = are * are + aim * aim;
        ((f32x2*)(base + C_COEF))[idx] = (f32x2){(num.x * are + num.y * aim) / den, (num.y * are - num.x * aim) / den};
    }
}
template <int CTRL> DI float dppf(float v) { return __int_as_float(__builtin_amdgcn_update_dpp(0, __float_as_int(v), CTRL, 0xf, 0xf, false)); }
template <int DIR, int D> DI void scan_step(f32x4 (&e)[8], const char* lds, int q) {
    constexpr int CTRL = (DIR == 0 ? 0x110 : 0x100) + D;
    const f32x4* mk = (const f32x4*)(lds + L_PW) + (DIR * 16 + D) * 32;
#pragma unroll
    for (int blk = 0; blk < 8; ++blk) {
        const f32x4 m = mk[4 * blk + q];
        f32x4 sh; sh[0] = dppf<CTRL>(e[blk][0]); sh[1] = dppf<CTRL>(e[blk][1]); sh[2] = dppf<CTRL>(e[blk][2]); sh[3] = dppf<CTRL>(e[blk][3]);
        e[blk][0] += m[0] * sh[0] - m[1] * sh[1]; e[blk][1] += m[0] * sh[1] + m[1] * sh[0];
        e[blk][2] += m[2] * sh[2] - m[3] * sh[3]; e[blk][3] += m[2] * sh[3] + m[3] * sh[2];
    }
}
template <int DIR> DI void tile_stage1(const Params& p, int wgi, int g, int J, const bf16x8 (&uf)[4], char* lds, int lane) {
    const int n = lane & 15, q = lane >> 4;
    f32x4 e[8];
#pragma unroll
    for (int blk = 0; blk < 8; ++blk) { const float z = ZF(); e[blk] = (f32x4){z, z, z, z}; }
    const bf16_t* WE = (const bf16_t*)(lds + L_WE) + DIR * 128 * RS;
#pragma unroll
    for (int ks = 0; ks < 4; ++ks) {
        bf16x8 af[8];
#pragma unroll
        for (int blk = 0; blk < 8; ++blk) af[blk] = *(const bf16x8*)(WE + (16 * blk + n) * RS + 32 * ks + 8 * q);
        __builtin_amdgcn_sched_barrier(0);
#pragma unroll
        for (int blk = 0; blk < 8; ++blk) e[blk] = __builtin_amdgcn_mfma_f32_16x16x32_bf16(af[blk], uf[ks], e[blk], 0, 0, 0);
        __builtin_amdgcn_sched_barrier(0);
    }
    scan_step<DIR, 1>(e, lds, q); scan_step<DIR, 2>(e, lds, q); scan_step<DIR, 4>(e, lds, q); scan_step<DIR, 8>(e, lds, q);
    if (n == (DIR == 0 ? 15 : 0)) {
        float* te = (float*)(lds + L_TEND) + (DIR * 34 + J) * 128;
#pragma unroll
        for (int blk = 0; blk < 8; ++blk) *(f32x4*)(te + 16 * blk + 4 * q) = e[blk];
    }
    u32x4* xs = (u32x4*)(p.ws + WS_T + T_XS) + ((size_t)((wgi * 2 + DIR) * 34 + J) * 4) * 64 + lane;
    constexpr int C1 = (DIR == 0 ? 0x110 : 0x100) + 1;
#pragma unroll
    for (int ks = 0; ks < 4; ++ks) {
        u32x4 w;
#pragma unroll
        for (int hh = 0; hh < 2; ++hh) { const f32x4 v = e[2 * ks + hh];
            w[2 * hh] = pk2(dppf<C1>(v[0]), dppf<C1>(v[1])); w[2 * hh + 1] = pk2(dppf<C1>(v[2]), dppf<C1>(v[3])); }
        xs[ks * 64] = w;
    }
}
DI void load_u(const bf16_t* h, int row0, int g, int lane, bf16x8 (&uf)[4]) {
    const int n = lane & 15, q = lane >> 4;
#pragma unroll
    for (int ks = 0; ks < 4; ++ks) uf[ks] = *(const bf16x8*)(h + (size_t)(row0 + 8 * n + 2 * ks + (q >> 1)) * DM + 16 * g + 8 * (q & 1));
}
template <int DIR> DI void tile_stage3(const Params& p, int wgi, int J, const bf16x8 (&uf)[4], f32x4 (&Y)[8], char* lds, int lane) {
    const int n = lane & 15, q = lane >> 4;
    const u32x4* xs = (const u32x4*)(p.ws + WS_T + T_XS) + ((size_t)((wgi * 2 + DIR) * 34 + J) * 4) * 64 + lane;
    const f32x4* pw = (const f32x4*)(lds + L_PW) + (DIR * 16 + (DIR == 0 ? n : 15 - n)) * 32;
    const f32x4* cr = (const f32x4*)(lds + L_CARRY) + (DIR * 34 + J) * 32;
    bf16x8 sf[4];
#pragma unroll
    for (int ks = 0; ks < 4; ++ks) {
        const u32x4 xw = xs[ks * 64]; u32x4 w;
#pragma unroll
        for (int hh = 0; hh < 2; ++hh) {
            const int blk = 2 * ks + hh;
            const f32x4 a = pw[4 * blk + q], c = cr[4 * blk + q];
            const float s0 = bflo(xw[2 * hh]) + a[0] * c[0] - a[1] * c[1], s1 = bfhi(xw[2 * hh]) + a[0] * c[1] + a[1] * c[0];
            const float s2 = bflo(xw[2 * hh + 1]) + a[2] * c[2] - a[3] * c[3], s3 = bfhi(xw[2 * hh + 1]) + a[2] * c[3] + a[3] * c[2];
            w[2 * hh] = pk2(s0, s1); w[2 * hh + 1] = pk2(s2, s3);
        }
        sf[ks] = __builtin_bit_cast(bf16x8, w);
    }
    const bf16_t* CA = (const bf16_t*)(lds + L_CA) + DIR * 128 * RS;
    const bf16_t* KP = (const bf16_t*)(lds + L_KP) + DIR * 8 * 512;
#pragma unroll
    for (int t = 0; t < 8; ++t) {
        bf16x8 af[4], kf[4];
#pragma unroll
        for (int ks = 0; ks < 4; ++ks) {
            af[ks] = *(const bf16x8*)(CA + (16 * t + n) * RS + 32 * ks + 8 * q);
            const int idx = DIR == 0 ? t - 2 * ks : 2 * ks + 1 - t;
            if (idx >= 0) kf[ks] = *(const bf16x8*)(KP + idx * 512 + n * 32 + 8 * q);
        }
        __builtin_amdgcn_sched_barrier(0);
#pragma unroll
        for (int ks = 0; ks < 4; ++ks) {
            Y[t] = __builtin_amdgcn_mfma_f32_16x16x32_bf16(af[ks], sf[ks], Y[t], 0, 0, 0);
            const int idx = DIR == 0 ? t - 2 * ks : 2 * ks + 1 - t;
            if (idx >= 0) Y[t] = __builtin_amdgcn_mfma_f32_16x16x32_bf16(kf[ks], uf[ks], Y[t], 0, 0, 0);
        }
        __builtin_amdgcn_sched_barrier(0);
    }
}
DI void phase(const Params& p, int jl, char* lds) {
    const bf16_t* h = hbuf(p); bf16_t* z = (bf16_t*)(p.ws + WS_T + T_Z);
    const unsigned char* cb = p.ws + WS_S5C;
    for (int wg0 = BIDX(); wg0 < NB * 64; wg0 += GDIM()) {
        const int tid = TIDX(), lane = tid & 63, wave = __builtin_amdgcn_readfirstlane(tid >> 6);
        const int wgi = (GDIM() == NB * 64) ? (wg0 & 7) * 32 + (wg0 >> 3) : wg0;
        const int b = wgi >> 6, g = wgi & 63;
        f32x2* Lap = (f32x2*)(lds + L_APOW); f32x2* Lbb = (f32x2*)(lds + L_BBAR); f32x2* Lc = (f32x2*)(lds + L_C);
        for (int rep3 = 0; rep3 < (S5_PROBE == 3 ? S5_REPS : 1); ++rep3) {
        for (int idx = tid; idx < 2 * 9 * 64; idx += NTHREADS) { const int dir = idx / 576, r = idx - dir * 576; Lap[idx] = ((const f32x2*)(cb + C_APOW))[(dir * 64 + g) * 576 + r]; }
        for (int idx = tid; idx < 2 * 1024; idx += NTHREADS) {
            const int dir = idx >> 10, r = idx & 1023;
            const size_t gi = (size_t)(dir * 64 + g) * 1024 + r;
            Lbb[idx] = cmul(((const f32x2*)(cb + C_COEF))[(dir * 64 + g) * 64 + (r >> 4)], (f32x2){IN(p, 18)[gi], IN(p, 19)[gi]});
            Lc[idx] = (f32x2){IN(p, 20)[gi], IN(p, 21)[gi]};
        }
        __syncthreads();
        for (int idx = tid; idx < 2 * 128 * 64; idx += NTHREADS) {
            const int dir = idx >> 13, kp = (idx >> 6) & 127, c2 = (idx & 63) * 2, pp = kp >> 1, part = kp & 1, t = c2 >> 4, i = c2 & 15;
            const f32x2 ap = Lap[(dir * 9 + (dir == 0 ? 7 - t : t)) * 64 + pp];
            const f32x2 b0 = cmul(ap, Lbb[(dir * 64 + pp) * 16 + i]), b1 = cmul(ap, Lbb[(dir * 64 + pp) * 16 + i + 1]);
            *(unsigned*)((bf16_t*)(lds + L_WE) + (dir * 128 + kp) * RS + c2) = part == 0 ? pk2(b0.x, b1.x) : pk2(b0.y, b1.y);
        }
        {
            const int dir = tid >> 8, ip = (tid >> 4) & 15, i = tid & 15;
            float acc[8];
#pragma unroll
            for (int t = 0; t < 8; ++t) acc[t] = 0.f;
#pragma unroll 4
            for (int pp = 0; pp < 64; ++pp) {
                const f32x2 a1 = Lap[(dir * 9 + 1) * 64 + pp];
                f32x2 w = cmul(Lc[(dir * 16 + ip) * 64 + pp], Lbb[(dir * 64 + pp) * 16 + i]);
#pragma unroll
                for (int t = 0; t < 8; ++t) { acc[t] += w.x; w = cmul(w, a1); }
            }
            bf16_t* KP = (bf16_t*)(lds + L_KP) + dir * 8 * 512;
#pragma unroll
            for (int t = 0; t < 8; ++t) {
                const bf16_t v = (bf16_t)f2bf(acc[t]);
                if (dir == 0) { KP[t * 512 + ip * 32 + i] = v; if (t < 7) KP[(t + 1) * 512 + ip * 32 + 16 + i] = v; }
                else { KP[t * 512 + ip * 32 + 16 + i] = v; if (t < 7) KP[(t + 1) * 512 + ip * 32 + i] = v; }
            }
            if (dir == 0) KP[0 * 512 + ip * 32 + 16 + i] = 0; else KP[0 * 512 + ip * 32 + i] = 0;
            if (tid < 128) {
                const int d2 = tid >> 6, s = tid & 63; const f32x2 a8 = Lap[(d2 * 9 + 8) * 64 + s];
                f32x2 w = {1.f, 0.f}; f32x2* pwt = (f32x2*)(lds + L_PW) + d2 * 16 * 64 + s;
#pragma unroll 1
                for (int nn = 0; nn < 16; ++nn) { pwt[nn * 64] = w; w = cmul(w, a8); }
            }
        }
        __syncthreads();
        }
        for (int rep = 0; rep < (S5_PROBE == 1 ? S5_REPS : 1); ++rep)
        for (int J = wave; J < 34; J += NWAVES) {
            const int ln = TIDX() & 63;
            bf16x8 uf[4]; load_u(h, b * RPB + 128 * J, g, ln, uf);
            tile_stage1<0>(p, wgi, g, J, uf, lds, ln);
            __builtin_amdgcn_sched_barrier(0);
            tile_stage1<1>(p, wgi, g, J, uf, lds, ln);
            __builtin_amdgcn_sched_barrier(0);
        }
        __syncthreads();
        if (wave < 2) {
            const int dir = wave;
            const f32x2 a128 = ((const f32x2*)(cb + C_A128))[(dir * 64 + g) * 64 + lane];
            f32x2* cr = (f32x2*)(lds + L_CARRY) + dir * 34 * 64 + lane;
            float zz = ZF(); f32x2 c = {zz, zz};
#pragma unroll 1
            for (int k = 0; k < 34; ++k) { const int J = dir == 0 ? k : (k < 2 ? 1 - k : 35 - k); const f32x2 e = cr[J * 64]; cr[J * 64] = c; c = cmul(a128, c); c.x += e.x; c.y += e.y; }
        } else {
            for (int idx = tid - 128; idx < 2 * 128 * 64; idx += NTHREADS - 128) {
                const int dir = idx >> 13, r = (idx >> 6) & 127, kpos = (idx & 63) * 2, t = r >> 4, ip = r & 15;
                const int ks = kpos >> 5, q = (kpos >> 3) & 3, jj = kpos & 7, kk = 32 * ks + 16 * (jj >> 2) + 4 * q + (jj & 3), pp = kk >> 1;
                const f32x2 cc = cmul(Lc[(dir * 16 + ip) * 64 + pp], Lap[(dir * 9 + (dir == 0 ? t + 1 : 8 - t)) * 64 + pp]);
                *(unsigned*)((bf16_t*)(lds + L_CA) + (dir * 128 + r) * RS + kpos) = pk2(cc.x, -cc.y);
            }
        }
        __syncthreads();
        const float* dd = IN(p, 22) + jl * 1024;
        for (int rep = 0; rep < (S5_PROBE == 2 ? S5_REPS : 1); ++rep)
        for (int J = wave; J < 34; J += NWAVES) {
            const int lane = TIDX() & 63;
            const int row0 = b * RPB + 128 * J;
            bf16x8 uf[4]; load_u(h, row0, g, lane, uf);
            f32x4 Y[8];
#pragma unroll
            for (int t = 0; t < 8; ++t) { const float zf = ZF(); Y[t] = (f32x4){zf, zf, zf, zf}; }
            tile_stage3<0>(p, wgi, J, uf, Y, lds, lane);
            __builtin_amdgcn_sched_barrier(0);
            tile_stage3<1>(p, wgi, J, uf, Y, lds, lane);
            __builtin_amdgcn_sched_barrier(0);
            const int n = lane & 15, q = lane >> 4; const f32x4 dv = *(const f32x4*)(dd + 16 * g + 4 * q);
#pragma unroll
            for (int t = 0; t < 8; ++t) {
                const size_t off = (size_t)(row0 + 8 * n + t) * DM + 16 * g + 4 * q;
                const u32x2 hw = *(const u32x2*)(h + off);
                const float y0 = bflo(hw[0]) * dv[0] + Y[t][0], y1 = bfhi(hw[0]) * dv[1] + Y[t][1], y2 = bflo(hw[1]) * dv[2] + Y[t][2], y3 = bfhi(hw[1]) * dv[3] + Y[t][3];
                u32x2 w = {pk2(gelu_tanh(y0), gelu_tanh(y1)), pk2(gelu_tanh(y2), gelu_tanh(y3))};
                *(u32x2*)(z + off) = w;
            }
        }
        __syncthreads();
    }
}
}

DI void lru_conv(const Params& p, int j) {
    const int lane = TIDX() & 63, gw = BIDX() * NWAVES + (TIDX() >> 6), nw = GDIM() * NWAVES;
    const bf16_t* xp = (const bf16_t*)(p.ws + WS_T + T_XPRE); bf16_t* xr = (bf16_t*)(p.ws + WS_T + T_XR);
    const float* cw = IN(p, 25) + j * 4 * LRUW; const float* cb = IN(p, 26) + j * LRUW;
    for (int task = gw; task < NB * 68 * 5; task += nw) {
        const int strip = task % 5, chk = task / 5, c = chk % 68, b = chk / 68;
        const int cc = strip * 256 + lane * 4;
        const bool first = (c == 0 || c == 4), last = (c == 3 || c == 67);
        const bf16_t* src = xp + (size_t)(b * RPB + c * 64) * LRUW + cc; bf16_t* dst = xr + (size_t)(b * RPB + c * 64) * LRUW + cc;
        const f32x4 w0 = *(const f32x4*)(cw + cc), w1 = *(const f32x4*)(cw + LRUW + cc), w2 = *(const f32x4*)(cw + 2 * LRUW + cc), w3 = *(const f32x4*)(cw + 3 * LRUW + cc), bias = *(const f32x4*)(cb + cc);
        const u32x2 zz = {0u, 0u};
        const u32x2 pm1 = first ? zz : *(const u32x2*)(src - LRUW), p0 = *(const u32x2*)src, p1 = *(const u32x2*)(src + LRUW);
        f32x4 xa = {bflo(pm1[0]), bfhi(pm1[0]), bflo(pm1[1]), bfhi(pm1[1])}, xb = {bflo(p0[0]), bfhi(p0[0]), bflo(p0[1]), bfhi(p0[1])}, xc = {bflo(p1[0]), bfhi(p1[0]), bflo(p1[1]), bfhi(p1[1])};
#pragma unroll 1
        for (int t0 = 0; t0 < 64; t0 += 16) {
            u32x2 nx[16];
#pragma unroll
            for (int u = 0; u < 16; ++u) { const int tt = t0 + u + 2; nx[u] = (tt < 64 || !last) ? *(const u32x2*)(src + (size_t)tt * LRUW) : zz; }
#pragma unroll
            for (int u = 0; u < 16; ++u) {
                const f32x4 xd = {bflo(nx[u][0]), bfhi(nx[u][0]), bflo(nx[u][1]), bfhi(nx[u][1])};
                const f32x4 acc = bias + w0 * xa + w1 * xb + w2 * xc + w3 * xd;
                const u32x2 o = {pk2(acc[0], acc[1]), pk2(acc[2], acc[3])};
                *(u32x2*)(dst + (size_t)(t0 + u) * LRUW) = o;
                xa = xb; xb = xc; xc = xd;
            }
        }
    }
}
constexpr int LR_CH = 64, LR_NCH = RPB / LR_CH;
DI int lr_chain_chunk(int dir, int k) { return dir == 0 ? k : (k < 4 ? 3 - k : 71 - k); }
DI int lr_chain_pos(int dir, int c) { return dir == 0 ? c : (c < 4 ? 3 - c : 71 - c); }
DI void lru_pass1(const Params& p) {
    const int gt = BIDX() * NTHREADS + TIDX(), ntot = GDIM() * NTHREADS;
    float* P = (float*)(p.ws + WS_T + T_LP); float* E = (float*)(p.ws + WS_T + T_LE);
    for (int it = gt; it < NB * 2 * LR_NCH * 160; it += ntot) {
        const int c8 = it % 160, r1 = it / 160, c = r1 % LR_NCH, r2 = r1 / LR_NCH, dir = r2 & 1, b = r2 >> 1;
        const bf16_t* la = (const bf16_t*)(p.ws + WS_T + T_LA + dir * LRU_DIRSTRIDE) + (size_t)(b * RPB + c * LR_CH) * LRUW + c8 * 8;
        const bf16_t* bb = (const bf16_t*)(p.ws + WS_T + T_BB + dir * LRU_DIRSTRIDE) + (size_t)(b * RPB + c * LR_CH) * LRUW + c8 * 8;
        float s[8], ps[8];
#pragma unroll
        for (int e = 0; e < 8; ++e) { s[e] = 0.f; ps[e] = 0.f; }
        for (int k0 = 0; k0 < LR_CH; k0 += 8) {
            u32x4 lw[8], bw[8];
#pragma unroll
            for (int u = 0; u < 8; ++u) { const int t = dir ? LR_CH - 1 - (k0 + u) : k0 + u; lw[u] = *(const u32x4*)(la + (size_t)t * LRUW); bw[u] = *(const u32x4*)(bb + (size_t)t * LRUW); }
#pragma unroll
            for (int u = 0; u < 8; ++u)
#pragma unroll
                for (int e = 0; e < 4; ++e) {
                    const float l0 = bflo(lw[u][e]), l1 = bfhi(lw[u][e]);
                    ps[2 * e] += l0; ps[2 * e + 1] += l1;
                    s[2 * e] = __expf(l0) * s[2 * e] + bflo(bw[u][e]); s[2 * e + 1] = __expf(l1) * s[2 * e + 1] + bfhi(bw[u][e]);
                }
        }
        const size_t o = ((size_t)((b * 2 + dir) * LR_NCH + c)) * LRUW + c8 * 8;
        *(f32x4*)(P + o) = (f32x4){ps[0], ps[1], ps[2], ps[3]}; *(f32x4*)(P + o + 4) = (f32x4){ps[4], ps[5], ps[6], ps[7]};
        *(f32x4*)(E + o) = (f32x4){s[0], s[1], s[2], s[3]}; *(f32x4*)(E + o + 4) = (f32x4){s[4], s[5], s[6], s[7]};
    }
}
DI void lru_carry(const Params& p) {
    const int gt = BIDX() * NTHREADS + TIDX(), ntot = GDIM() * NTHREADS;
    const float* P = (const float*)(p.ws + WS_T + T_LP); const float* E = (const float*)(p.ws + WS_T + T_LE); float* S = (float*)(p.ws + WS_T + T_LS);
    for (int it = gt; it < NB * 2 * LRUW; it += ntot) {
        const int ch = it % LRUW, bd = it / LRUW, dir = bd & 1;
        const size_t base = (size_t)bd * LR_NCH * LRUW + ch;
        float s = 0.f;
        for (int k0 = 0; k0 < LR_NCH; k0 += 17) {
            float pv[17], ev[17];
#pragma unroll
            for (int u = 0; u < 17; ++u) { const size_t o = base + (size_t)lr_chain_chunk(dir, k0 + u) * LRUW; pv[u] = P[o]; ev[u] = E[o]; }
#pragma unroll
            for (int u = 0; u < 17; ++u) { S[base + (size_t)lr_chain_chunk(dir, k0 + u) * LRUW] = s; s = __expf(pv[u]) * s + ev[u]; }
        }
    }
}
DI void lru_pass3(const Params& p, bool latonly) {
    const int gt = BIDX() * NTHREADS + TIDX(), ntot = GDIM() * NTHREADS;
    const float* S = (const float*)(p.ws + WS_T + T_LS);
    const bf16_t* gx = (const bf16_t*)(p.ws + WS_T + T_GX); bf16_t* gh = (bf16_t*)(p.ws + WS_T + T_GH);
    for (int it = gt; it < NB * LR_NCH * 640; it += ntot) {
        const int c2 = it % 640, r1 = it / 640, c = r1 % LR_NCH, b = r1 / LR_NCH;
        if (latonly && c < 4) continue;
        const size_t rowoff = (size_t)(b * RPB + c * LR_CH) * LRUW + c2 * 2;
        f32x2 fw[LR_CH];
        {
            const size_t o = ((size_t)((b * 2 + 0) * LR_NCH + c)) * LRUW + c2 * 2;
            f32x2 s = *(const f32x2*)(S + o);
            const bf16_t* la = (const bf16_t*)(p.ws + WS_T + T_LA) + rowoff; const bf16_t* bb = (const bf16_t*)(p.ws + WS_T + T_BB) + rowoff;
#pragma unroll
            for (int k0 = 0; k0 < LR_CH; k0 += 16) {
                unsigned lw[16], bw[16];
#pragma unroll
                for (int u = 0; u < 16; ++u) { lw[u] = *(const unsigned*)(la + (size_t)(k0 + u) * LRUW); bw[u] = *(const unsigned*)(bb + (size_t)(k0 + u) * LRUW); }
#pragma unroll
                for (int u = 0; u < 16; ++u) { s.x = __expf(bflo(lw[u])) * s.x + bflo(bw[u]); s.y = __expf(bfhi(lw[u])) * s.y + bfhi(bw[u]); fw[k0 + u] = s; }
            }
        }
        {
            const size_t o = ((size_t)((b * 2 + 1) * LR_NCH + c)) * LRUW + c2 * 2;
            f32x2 s = *(const f32x2*)(S + o);
            const bf16_t* la = (const bf16_t*)(p.ws + WS_T + T_LA + LRU_DIRSTRIDE) + rowoff; const bf16_t* bb = (const bf16_t*)(p.ws + WS_T + T_BB + LRU_DIRSTRIDE) + rowoff;
#pragma unroll
            for (int k0 = 0; k0 < LR_CH; k0 += 16) {
                unsigned lw[16], bw[16], gw_[16];
#pragma unroll
                for (int u = 0; u < 16; ++u) { const int t = LR_CH - 1 - (k0 + u); lw[u] = *(const unsigned*)(la + (size_t)t * LRUW); bw[u] = *(const unsigned*)(bb + (size_t)t * LRUW); gw_[u] = *(const unsigned*)(gx + rowoff + (size_t)t * LRUW); }
#pragma unroll
                for (int u = 0; u < 16; ++u) { const int t = LR_CH - 1 - (k0 + u);
                    s.x = __expf(bflo(lw[u])) * s.x + bflo(bw[u]); s.y = __expf(bfhi(lw[u])) * s.y + bfhi(bw[u]);
                    *(unsigned*)(gh + rowoff + (size_t)t * LRUW) = pk2(bflo(gw_[u]) * (fw[t].x + s.x), bfhi(gw_[u]) * (fw[t].y + s.y)); }
            }
        }
    }
}

#define XB_TMO      128
#define XB_XCNT(j)  (256  + 64 * (j))
#define XB_XSUB(j)  (1280 + 64 * (j))
#define XB_XGEN(j)  (2304 + 64 * (j))
#define XB_TOP      3328
#define XB_TOPGEN   3392
#define XCD_BAR_WORDS 3456
#define XB_SPIN_CAP (1u << 24)
DI unsigned xb_ld(unsigned* p)              { return __hip_atomic_load(p, __ATOMIC_RELAXED, __HIP_MEMORY_SCOPE_AGENT); }
DI unsigned xb_add(unsigned* p, unsigned v) { return __hip_atomic_fetch_add(p, v, __ATOMIC_RELAXED, __HIP_MEMORY_SCOPE_AGENT); }
DI unsigned xb_xcc_id() { return (unsigned)__builtin_amdgcn_s_getreg((3 << 11) | 20) & 0xFu; }
#define XB_SPIN(cond, bar) do { unsigned _sp = 0; while (cond) { __builtin_amdgcn_s_sleep(1); \
    if ((++_sp & 255u) == 0u) { if (xb_ld(&(bar)[XB_TMO])) break; if (_sp > XB_SPIN_CAP) { atomicAdd(&(bar)[XB_TMO], 1u); break; } } } } while (0)
struct XcdBarrier { unsigned* bar; unsigned x; volatile LAS unsigned* st; };
DI XcdBarrier xcd_barrier_post(unsigned* bar, volatile LAS unsigned* st) {
    XcdBarrier b; b.bar = bar; b.x = xb_xcc_id(); b.st = st;
    if (threadIdx.x == 0) (void)xb_add(&bar[XB_XCNT(b.x)], 1u);
    return b;
}
DI void xcd_barrier_complete(unsigned* bar, unsigned x, unsigned& nloc, unsigned& nx) {
    const unsigned G = gridDim.x * gridDim.y * gridDim.z;
    unsigned sum, cnt, mine, sp = 0u;
    for (;;) {
        sum = 0u; cnt = 0u; mine = 0u;
#pragma unroll
        for (unsigned j = 0; j < 16; ++j) { const unsigned c = xb_ld(&bar[XB_XCNT(j)]); sum += c; cnt += (c > 0u) ? 1u : 0u; mine = (j == x) ? c : mine; }
        if (sum == G) break;
        __builtin_amdgcn_s_sleep(1);
        if ((++sp & 255u) == 0u) { if (xb_ld(&bar[XB_TMO])) break; if (sp > XB_SPIN_CAP) { atomicAdd(&bar[XB_TMO], 1u); break; } }
    }
    nloc = mine > 0u ? mine : 1u; nx = cnt > 0u ? cnt : 1u;
}
DI void xcd_barrier(const XcdBarrier& b) {
    asm volatile("s_waitcnt vmcnt(0)" ::: "memory");
    __syncthreads();
    if (threadIdx.x == 0) {
        unsigned* bar = b.bar;
        __builtin_amdgcn_s_waitcnt(0);
        unsigned nloc = b.st[0], nx = b.st[1];
        if (nloc == 0u) { xcd_barrier_complete(bar, b.x, nloc, nx); b.st[0] = nloc; b.st[1] = nx; }
        const unsigned old = xb_add(&bar[XB_XSUB(b.x)], 1u);
        const unsigned gen = old / nloc;
        if (old + 1u == (gen + 1u) * nloc) {
            __builtin_amdgcn_fence(__ATOMIC_RELEASE, "agent");
            asm volatile("s_waitcnt vmcnt(0)" ::: "memory");
            const unsigned og = xb_add(&bar[XB_TOP], 1u);
            const unsigned tg = og / nx;
            if (og + 1u == (tg + 1u) * nx) xb_add(&bar[XB_TOPGEN], 1u);
            else XB_SPIN(xb_ld(&bar[XB_TOPGEN]) == tg, bar);
            __builtin_amdgcn_fence(__ATOMIC_ACQUIRE, "agent");
            xb_add(&bar[XB_XGEN(b.x)], 1u);
            asm volatile("s_waitcnt vmcnt(0)" ::: "memory");
        } else {
            XB_SPIN(xb_ld(&bar[XB_XGEN(b.x)]) == gen, bar);
            __builtin_amdgcn_fence(__ATOMIC_ACQUIRE, "agent");
            asm volatile("s_waitcnt vmcnt(0)" ::: "memory");
        }
    }
    __syncthreads();
}

enum { ST_INIT = 0, ST_NORM0, ST_NORM1, ST_GEMM, ST_A3, ST_A5, ST_ATTN, ST_S5P1, ST_S5P3, ST_CONV, ST_LRU1, ST_LRU3, ST_S5C, ST_LRUC, ST_S5 };
enum { G_DQKV = 0, G_UQ, G_UKV, G_WO, G_GLU, G_WX, G_WG, G_GATES, G_WOUT, G_W1, G_W2 };
struct Step { unsigned char type, layer, gid, ng; };
#define MLA_STEPS(L) {ST_NORM0, L, 0, 0}, {ST_GEMM, L, G_DQKV, 1}, {ST_GEMM, L, G_UQ, 2}, {ST_ATTN, L, 0, 0}, {ST_GEMM, L, G_WO, 1}, \
                     {ST_NORM1, L, 0, 0}, {ST_GEMM, L, G_W1, 1}, {ST_GEMM, L, G_W2, 1}
#define S5_STEPS(L)  {ST_NORM0, L, 0, 0}, {ST_S5, L, 0, 0}, {ST_GEMM, L, G_GLU, 1}, {ST_NORM1, L, 0, 0}, {ST_GEMM, L, G_W1, 1}, {ST_GEMM, L, G_W2, 1}
#define LRU_STEPS(L) {ST_NORM0, L, 0, 0}, {ST_GEMM, L, G_WX, 2}, {ST_CONV, L, 0, 0}, {ST_GEMM, L, G_GATES, 1}, {ST_LRU1, L, 0, 0}, {ST_LRUC, L, 0, 0}, {ST_LRU3, L, 0, 0}, {ST_GEMM, L, G_WOUT, 1}, \
                     {ST_NORM1, L, 0, 0}, {ST_GEMM, L, G_W1, 1}, {ST_GEMM, L, G_W2, 1}
__constant__ Step PROGRAM[] = { {ST_INIT, 0, 0, 0}, MLA_STEPS(0), S5_STEPS(1), LRU_STEPS(2), MLA_STEPS(3) };
constexpr int NSTEPS = 1 + 8 + 6 + 11 + 8;

#ifndef PROBE_MASK
#define PROBE_MASK 0
#endif
#ifndef PROBE_GMASK
#define PROBE_GMASK 0
#endif
#ifndef PROBE_REPS
#define PROBE_REPS 2
#endif
DI GemmD make_gemm(const Params& p, int gid, int layer, bool dry) {
    unsigned char* ws = p.ws; unsigned char* T = ws + WS_T; unsigned char* wm = ws + WS_WMIX;
    const bf16_t* H = hbuf(p); const float* modv = (const float*)(ws + WS_MOD);
    const int lo = layer < 3 ? 0 : 1, j = layer / 3;
    GemmD g; g.koff_shift = 30; g.koff_mul = 0; g.kb_mul = 0; g.out = nullptr; g.ldc = 0; g.gate = modv; g.gate_off = 2 * 1024; g.layer = layer; g.aux0 = nullptr; g.aux1 = nullptr; g.aux2 = nullptr; g.out2 = nullptr; g.latonly = lo; g.rev = 0; g.splitk = 0; g.slab = nullptr; g.res_x = nullptr; g.final = 0; g.perm = 1;
    switch (gid) {
        case G_DQKV: g.A = H; g.lda = 1024; g.Bt = (const bf16_t*)(wm + WM_D); g.ldb = 1024; g.K = 1024; g.nN = 3; g.latonly = 0; g.kind = EPI_DQKV; g.aux0 = IN(p, 11) + j * 256; g.aux1 = IN(p, 13) + j * 384 + 192 + 128; break;
        case G_UQ: g.A = (const bf16_t*)(T + T_CQ); g.lda = 384; g.Bt = (const bf16_t*)(wm + WM_UQ); g.ldb = 384; g.K = 384; g.nN = 6; g.kind = EPI_QN; g.out = T + T_QPRE; g.ldc = 1536; g.aux0 = IN(p, 13) + j * 384; break;
        case G_UKV: g.A = (const bf16_t*)(T + T_CKV); g.lda = 256; g.Bt = (const bf16_t*)(wm + WM_UKV); g.ldb = 256; g.K = 256; g.nN = 8; g.latonly = 0; g.rev = 1; g.kind = EPI_KVN; g.out = T + T_KVPRE; g.ldc = 2048; g.aux0 = IN(p, 13) + j * 384 + 192; break;
        case G_WO: if (layer == 0) g.res_x = IN(p, 0); g.A = H; g.lda = 1024; g.Bt = (const bf16_t*)(wm + WM_O); g.ldb = 1024; g.K = 1024; g.nN = 4; g.kind = EPI_RES; g.splitk = 4; g.slab = (float*)(T + T_SLAB_A); break;
        case G_GLU: g.A = (const bf16_t*)(T + T_Z); g.lda = 1024; g.Bt = (const bf16_t*)(wm + WM_GLU); g.ldb = 1024; g.K = 1024; g.nN = 8; g.kind = EPI_GLU; g.splitk = 4; g.slab = (float*)(T + T_SLAB_A); break;
        case G_WX: g.A = H; g.lda = 1024; g.Bt = (const bf16_t*)(wm + WM_X); g.ldb = 1024; g.K = 1024; g.nN = 5; g.latonly = 0; g.kind = EPI_BF16; g.out = T + T_XPRE; g.ldc = LRUW; break;
        case G_GATES: g.A = (const bf16_t*)(T + T_XR); g.lda = LRUW; g.Bt = (const bf16_t*)(wm + WM_GATE); g.ldb = 256; g.K = 128; g.nN = 20; g.latonly = 0; g.kind = EPI_GATES; g.koff_shift = 1; g.koff_mul = 128; g.kb_mul = 128;
            g.out = T + T_LA; g.out2 = T + T_BB; g.aux0 = IN(p, 28) + j * 4 * LRUW; g.aux1 = IN(p, 29) + j * 2 * LRUW; g.aux2 = T + T_XR; break;
        case G_WG: g.A = H; g.lda = 1024; g.Bt = (const bf16_t*)(wm + WM_G); g.ldb = 1024; g.K = 1024; g.nN = 5; g.latonly = 0; g.rev = 1; g.kind = EPI_GELUMUL; g.out = T + T_GX; g.ldc = LRUW; break;
        case G_WOUT: g.A = (const bf16_t*)(T + T_GH); g.lda = LRUW; g.Bt = (const bf16_t*)(wm + WM_OUT); g.ldb = LRUW; g.K = LRUW; g.nN = 4; g.kind = EPI_RES; g.splitk = 5; g.slab = (float*)(T + T_SLAB_A_LRU); break;
        case G_W1: g.A = H; g.lda = 1024; g.Bt = mlp_wbuf(p, layer); g.ldb = 1024; g.K = 1024; g.nN = 16; g.kind = EPI_RELU2; g.out = T + T_HID; g.ldc = 4096; break;
        default: g.A = (const bf16_t*)(T + T_HID); g.lda = 4096; g.Bt = mlp_wbuf(p, layer) + (size_t)4096 * 1024; g.ldb = 4096; g.K = 4096; g.nN = 4; g.kind = EPI_RES; g.gate_off = 5 * 1024; g.splitk = 16; g.slab = (float*)(T + T_SLAB_M); g.final = layer == 3; break;
    }
    if (dry && (g.kind == EPI_RES || g.kind == EPI_GLU)) { g.kind = EPI_RELU2; g.out = T + 204 * MiB; g.ldc = 1024; }
    return g;
}
constexpr int LDS_BYTES = 163840;

__global__ void __launch_bounds__(NTHREADS, 2) hybrid_fwd(KArgs ka) {
    extern __shared__ __attribute__((aligned(16))) unsigned char lds_raw[];
    char* lds = (char*)lds_raw;
    LAS unsigned char* ldsl = (LAS unsigned char*)lds_raw;
    if (threadIdx.x < 33) ((LAS unsigned long long*)(ldsl + PTAB_OFF))[threadIdx.x] = (unsigned long long)ka.in[threadIdx.x];
    if (threadIdx.x < 4) ((LAS unsigned*)(ldsl + PTAB_OFF + 512))[threadIdx.x] = 0u;
    __syncthreads();
    const XcdBarrier xbar = xcd_barrier_post((unsigned*)ka.ws, (volatile LAS unsigned*)(ldsl + PTAB_OFF + 512));
    for (int step = 0; step < NSTEPS; ++step) {
        Params p; p.tab = (const LAS unsigned long long*)(ldsl + PTAB_OFF);
        { unsigned long long oi = (unsigned long long)ka.out, wi = (unsigned long long)ka.ws;
          asm volatile("" : "+s"(oi), "+s"(wi));
          p.out = (float*)(__attribute__((address_space(1))) float*)oi; p.ws = (unsigned char*)(__attribute__((address_space(1))) unsigned char*)wi; }
        const Step st = PROGRAM[step];
        const int layer = st.layer, j = layer / 3; const bool need_ctx = layer < 3;
        const int nrep = (PROBE_MASK != 0 && ((PROBE_MASK >> st.type) & 1) && (st.type != ST_GEMM || ((PROBE_GMASK >> st.gid) & 1))) ? PROBE_REPS : 1;
        for (int rr = 0; rr < nrep; ++rr) {
        switch (st.type) {
#ifndef NO_INIT
            case ST_INIT: rope_table(p); s5v2::prep(p); { const int fb = GDIM() == 256 ? 64 : 0; if (BIDX() >= fb) { prep_mixer(p, 0, lds, fb); prep_mlp(p, 0, lds, fb); } } break;
#endif
#ifndef NO_NORM
            case ST_NORM0: norm_phase(p, layer, 0, layer == 0, false, (layer > 0 && rr == 0) ? 16 : 0, (const float*)(p.ws + WS_T + T_SLAB_M), (const float*)(p.ws + WS_MOD) + (size_t)(4 * 4 + layer - 1) * 6144 + 5 * 1024, false, lds); break;
            case ST_NORM1: norm_phase(p, layer, 1, false, !need_ctx, (need_ctx && rr == 0) ? (layer % 3 == 2 ? 5 : 4) : 0, (const float*)(p.ws + WS_T + (layer % 3 == 2 ? T_SLAB_A_LRU : T_SLAB_A)), (const float*)(p.ws + WS_MOD) + (size_t)(4 * 4 + layer) * 6144 + 2 * 1024, layer % 3 == 1, lds); break;
#endif
#ifndef NO_GEMM
            case ST_GEMM: for (int gi = 0; gi < st.ng; ++gi) { const GemmD g = make_gemm(p, st.gid + gi, layer, rr != 0); gemm_phase(p, ldsl, g, st.gid + gi, layer, rr != 0); }
                if (st.gid == G_W1 && layer < 3 && rr == 0 && BIDX() >= 64) { prep_mixer(p, layer + 1, lds, 64); prep_mlp(p, layer + 1, lds, 64); }
                break;
#endif
#ifndef NO_ROWOP
            case ST_A3: mla_rowop_a3(p, j); break;
            case ST_A5: mla_rowop_a5(p, j, !need_ctx); break;
#endif
#ifndef NO_ATTN
            case ST_ATTN: attn_phase(p, need_ctx, lds); break;
#endif
#ifndef NO_S5
            case ST_S5: s5v2::phase(p, j, lds); break;
#endif
#ifndef NO_LRU
            case ST_CONV: lru_conv(p, j); break;
            case ST_LRU1: lru_pass1(p); break;
            case ST_LRUC: lru_carry(p); break;
            case ST_LRU3: lru_pass3(p, false); break;
#endif
            default: break;
        }
        if (rr == 0) {
            int ml0 = 0, ml1 = 0, rank = BIDX(), nr = GDIM(); const int bx = BIDX();
            if (GDIM() != 256) { if (st.type == ST_INIT) ml1 = 4; }
            else if (st.type == ST_INIT) { nr = 64; ml1 = bx < 64 ? 1 : 0; }
            else if (layer == 0 && st.type == ST_GEMM && st.gid == G_DQKV) { ml0 = 1; rank = bx - 204; nr = 64; ml1 = rank >= 0 ? 2 : 0; }
            else if (layer == 0 && st.type == ST_GEMM && st.gid == G_UQ) { ml0 = 1; rank = 52 + bx - 152; nr = 64; ml1 = (bx >= 152 && bx < 164) ? 2 : 0; }
            else if (layer == 0 && st.type == ST_ATTN) { ml0 = 2; rank = bx - (bx >> 3) - 1; nr = 224; ml1 = (bx & 7) ? 3 : 0; }
            else if (layer == 2 && st.type == ST_GEMM && st.gid == G_GATES) { ml0 = 3; rank = bx - 80; nr = 64; ml1 = (rank >= 0 && rank < 64) ? 4 : 0; }
            for (int ml = ml0; ml < ml1; ++ml) mod_phase(p, lds, ml, rank, nr);
        }
        if (step + 1 < NSTEPS) xcd_barrier(xbar);
        }
    }
}

extern "C" void kernel_launch(void* const* d_in, const int* in_sizes, int n_in, void* d_out, int out_size, void* d_ws, size_t ws_size, hipStream_t stream) {
    static int grid_blocks = 0;
    if (grid_blocks == 0) {
        if (n_in != 33 || out_size != NB * SEQ * DM || ws_size < WS_END) { fprintf(stderr, "kernel_launch: unexpected shapes n_in %d out %d ws %zu (need %zu)\n", n_in, out_size, ws_size, (size_t)WS_END); grid_blocks = -1; return; }
        int dev = 0, cus = 0, per_cu = 0;
        hipGetDevice(&dev);
        hipDeviceGetAttribute(&cus, hipDeviceAttributeMultiprocessorCount, dev);
        if (hipFuncSetAttribute((const void*)hybrid_fwd, hipFuncAttributeMaxDynamicSharedMemorySize, LDS_BYTES) != hipSuccess) { fprintf(stderr, "kernel_launch: hipFuncSetAttribute failed\n"); grid_blocks = -1; return; }
        if (hipOccupancyMaxActiveBlocksPerMultiprocessor(&per_cu, (const void*)hybrid_fwd, NTHREADS, LDS_BYTES) != hipSuccess || per_cu < 1) { fprintf(stderr, "kernel_launch: occupancy query failed (%d)\n", per_cu); per_cu = 1; (void)hipGetLastError(); }
        if (per_cu > 1) per_cu = 1;
        grid_blocks = cus * per_cu;
    }
    if (grid_blocks < 0) return;
    KArgs p{};
    for (int i = 0; i < 33; ++i) p.in[i] = (const float*)d_in[i];
    p.out = (float*)d_out; p.ws = (unsigned char*)d_ws;
    if (hipMemsetAsync(d_ws, 0, 16384, stream) != hipSuccess) { fprintf(stderr, "kernel_launch: memset of the barrier words failed\n"); return; }
    void* args[] = {&p};
    hipError_t e = hipLaunchCooperativeKernel((const void*)hybrid_fwd, dim3(grid_blocks), dim3(NTHREADS), args, LDS_BYTES, stream);
    if (e != hipSuccess) fprintf(stderr, "cooperative launch failed: %s (grid %d)\n", hipGetErrorString(e), grid_blocks);
}
```
